# Optimizing an MI355X kernel written in HIP

```python
import math
import jax
import jax.numpy as jnp
from jax import lax
import numpy as np

D_MODEL = 1024
BATCH = 16
SEQ = 256
DEPTH = 4
DEC_BATCH = 8
DEC_SEQ = 2048
PAST_LEN = 256

GRID_W = 64
EPS = 1e-6
POOL_WIDTH = D_MODEL // 4
MLA_WIDTH = D_MODEL // 2
GMLP_WIDTH = D_MODEL // 4
MIX_WIDTH = POOL_WIDTH + MLA_WIDTH + GMLP_WIDTH
POOL_WINDOWS = (2, 4, 8, 16)
POOL_GROUPS = len(POOL_WINDOWS)
POOL_GDIM = POOL_WIDTH // POOL_GROUPS
QK_NOPE = 128
QK_ROPE = 64
V_DIM = 128
MLA_HEADS = MLA_WIDTH // V_DIM
Q_RANK = 3 * D_MODEL // 8
KV_RANK = D_MODEL // 4
ROPE_THETA = 10000.0
ATTN_BLOCK = 128
CHUNK = 128
GMLP_GROUPS = 4
GMLP_GDIM = GMLP_WIDTH // GMLP_GROUPS
D_FF = 4 * D_MODEL
OFF_Q = POOL_WIDTH
OFF_KV = OFF_Q + Q_RANK
OFF_R = OFF_KV + KV_RANK
OFF_G = OFF_R + QK_ROPE
IN_WIDTH = OFF_G + 2 * GMLP_WIDTH

kernel_name = 'hybrid_pool_mla_gmlp_diffusion_step'


def rmsnorm(x, g):
    xf = x.astype(jnp.float32)
    y = xf * lax.rsqrt(jnp.mean(xf * xf, axis=-1, keepdims=True) + EPS)
    return (y * g.astype(jnp.float32)).astype(x.dtype)


def pool_mix(h, w_pool, pool_scale):
    B, L, _ = h.shape
    hf = h.astype(jnp.float32)
    csum = jnp.concatenate([jnp.zeros((B, 1, POOL_WIDTH), jnp.float32),
                            lax.cumsum(hf, axis=1)], axis=1)
    t = jnp.arange(L)
    groups = []
    for gi, w in enumerate(POOL_WINDOWS):
        lo = jnp.clip(t - w // 2, 0, L)
        hi = jnp.clip(t + (w - w // 2), 0, L)
        cnt = (hi - lo).astype(jnp.float32)[None, :, None]
        sl = slice(gi * POOL_GDIM, (gi + 1) * POOL_GDIM)
        win = csum[:, hi, sl] - csum[:, lo, sl]
        groups.append(win / cnt - hf[:, :, sl])
    pooled = jnp.stack(groups, axis=2)
    y = jnp.einsum('blgc,gcd->blgd', pooled, w_pool.astype(jnp.float32)).reshape(B, L, POOL_WIDTH)
    return (y * pool_scale.astype(jnp.float32)).astype(h.dtype)


def axial_rope(L):
    rows = L // GRID_W
    row = jnp.repeat(jnp.arange(rows, dtype=jnp.float32), GRID_W)
    col = jnp.tile(jnp.arange(GRID_W, dtype=jnp.float32), rows)
    n_freq = QK_ROPE // 4
    inv = 1.0 / (ROPE_THETA ** (jnp.arange(n_freq, dtype=jnp.float32) / n_freq))
    ang = jnp.concatenate([row[:, None] * inv, col[:, None] * inv], axis=-1)
    return jnp.cos(ang), jnp.sin(ang)


def apply_rope(x, cos, sin):
    xf = x.astype(jnp.float32)
    x1, x2 = xf[..., :QK_ROPE // 2], xf[..., QK_ROPE // 2:]
    return jnp.concatenate([x1 * cos - x2 * sin, x2 * cos + x1 * sin], axis=-1).astype(x.dtype)


def expand_kv(ckv, w_ukv):
    B, L, _ = ckv.shape
    kv = (ckv @ w_ukv).reshape(B, L, MLA_HEADS, QK_NOPE + V_DIM)
    return kv[..., :QK_NOPE], kv[..., QK_NOPE:]


def block_attention(qn, qr, kn, kr, v):
    B, Lq, H, _ = qn.shape
    nb = Lq // ATTN_BLOCK
    scale = 1.0 / math.sqrt(QK_NOPE + QK_ROPE)

    def to_blocks(a):
        return a.reshape((B, nb, ATTN_BLOCK) + a.shape[2:]).swapaxes(0, 1)

    def one_block(qs):
        qn_b, qr_b = qs
        s = (jnp.einsum('bqhd,bkhd->bhqk', qn_b, kn, preferred_element_type=jnp.float32)
             + jnp.einsum('bqhr,bkr->bhqk', qr_b, kr, preferred_element_type=jnp.float32)) * scale
        p = jax.nn.softmax(s, axis=-1).astype(v.dtype)
        return jnp.einsum('bhqk,bkhd->bqhd', p, v)

    o = lax.map(one_block, (to_blocks(qn), to_blocks(qr)))
    return o.swapaxes(0, 1).reshape(B, Lq, H * V_DIM)


def chunk_gmlp(u, v, w_s, b_s):
    B, L, _ = u.shape
    n = L // CHUNK
    vr = v.reshape(B, n, CHUNK, GMLP_GROUPS, GMLP_GDIM)
    mixed = jnp.einsum('gpq,bnqgc->bnpgc', w_s, vr) + b_s.T[:, :, None]
    return u * mixed.reshape(B, L, GMLP_WIDTH)


def mixer(hn, p, rope, ctx):
    B, L, _ = hn.shape
    proj = hn @ p['w_in']
    hp = proj[..., :OFF_Q]
    cq = proj[..., OFF_Q:OFF_KV]
    ckv_raw = proj[..., OFF_KV:OFF_R]
    kr = proj[..., OFF_R:OFF_G]
    uv = proj[..., OFF_G:]
    y_pool = pool_mix(hp, p['w_pool'], p['pool_scale'])
    q = (rmsnorm(cq, p['g_q']) @ p['w_uq']).reshape(B, L, MLA_HEADS, QK_NOPE + QK_ROPE)
    qn, qr = q[..., :QK_NOPE], q[..., QK_NOPE:]
    ckv = rmsnorm(ckv_raw, p['g_kv'])
    kn, v = expand_kv(ckv, p['w_ukv'])
    kr_keys = kr
    if rope is not None:
        cos, sin = rope
        qr = apply_rope(qr, cos[:, None, :], sin[:, None, :])
        kr_keys = apply_rope(kr, cos, sin)
    if ctx is not None:
        ckv_c, kr_c = ctx
        kn_c, v_c = expand_kv(ckv_c, p['w_ukv'])
        kn = jnp.concatenate([kn_c, kn], axis=1)
        v = jnp.concatenate([v_c, v], axis=1)
        kr_keys = jnp.concatenate([kr_c, kr_keys], axis=1)
    y_mla = block_attention(qn, qr, kn, kr_keys, v)
    uv = jax.nn.gelu(uv)
    u, vg = uv[..., :GMLP_WIDTH], uv[..., GMLP_WIDTH:]
    y_g = chunk_gmlp(u, rmsnorm(vg, p['g_sgu']), p['w_s'], p['b_s'])
    y = jnp.concatenate([y_pool, y_mla, y_g], axis=-1) @ p['w_out']
    return y, ckv, kr


def trunk_layer(x, mod, p, rope, ctx):
    sh1, sc1, g1, sh2, sc2, g2 = jnp.split(mod, 6, axis=-1)
    h = rmsnorm(x, p['g_mix']) * (1 + sc1) + sh1
    y, ckv, kr = mixer(h, p, rope, ctx)
    x = x + g1 * y
    h = rmsnorm(x, p['g_ffn']) * (1 + sc2) + sh2
    f = jnp.square(jax.nn.relu(h @ p['w_ff1'])) @ p['w_ff2']
    return x + g2 * f, ckv, kr


def setup_inputs(seed: int = 0) -> dict:
    key = jax.random.key(seed)
    ks = jax.random.split(key, 24)
    f32 = jnp.float32

    def nrm(k, shape, scale=1.0):
        return jax.random.normal(k, shape, f32) * scale

    def gain(k, shape):
        return 1.0 + 0.02 * jax.random.normal(k, shape, f32)

    return {
        'x_prompt': nrm(ks[0], (BATCH, SEQ, D_MODEL)),
        'x_sample': nrm(ks[1], (DEC_BATCH, DEC_SEQ, D_MODEL)),
        'cache_ckv': nrm(ks[2], (DEC_BATCH, DEPTH, PAST_LEN, KV_RANK)),
        'cache_krope': nrm(ks[3], (DEC_BATCH, DEPTH, PAST_LEN, QK_ROPE)),
        'c': nrm(ks[4], (DEC_BATCH, D_MODEL)),
        'c_ctx': nrm(ks[5], (D_MODEL,)),
        'w_ada': nrm(ks[6], (DEPTH, D_MODEL, 6 * D_MODEL), 0.5 * D_MODEL ** -0.5),
        'b_ada': nrm(ks[7], (DEPTH, 6 * D_MODEL), 0.01),
        'g_mix': gain(ks[8], (DEPTH, D_MODEL)),
        'w_in': nrm(ks[9], (DEPTH, D_MODEL, IN_WIDTH), D_MODEL ** -0.5),
        'w_pool': nrm(ks[10], (DEPTH, POOL_GROUPS, POOL_GDIM, POOL_GDIM), POOL_GDIM ** -0.5),
        'pool_scale': gain(ks[11], (DEPTH, POOL_WIDTH)),
        'g_q': gain(ks[12], (DEPTH, Q_RANK)),
        'w_uq': nrm(ks[13], (DEPTH, Q_RANK, MLA_HEADS * (QK_NOPE + QK_ROPE)), Q_RANK ** -0.5),
        'g_kv': gain(ks[14], (DEPTH, KV_RANK)),
        'w_ukv': nrm(ks[15], (DEPTH, KV_RANK, MLA_HEADS * (QK_NOPE + V_DIM)), KV_RANK ** -0.5),
        'g_sgu': gain(ks[16], (DEPTH, GMLP_WIDTH)),
        'w_s': nrm(ks[17], (DEPTH, GMLP_GROUPS, CHUNK, CHUNK), CHUNK ** -0.5),
        'b_s': nrm(ks[18], (DEPTH, GMLP_GROUPS, CHUNK), 0.01),
        'w_out': nrm(ks[19], (DEPTH, MIX_WIDTH, D_MODEL), MIX_WIDTH ** -0.5),
        'g_ffn': gain(ks[20], (DEPTH, D_MODEL)),
        'w_ff1': nrm(ks[21], (DEPTH, D_MODEL, D_FF), D_MODEL ** -0.5),
        'w_ff2': nrm(ks[22], (DEPTH, D_FF, D_MODEL), D_FF ** -0.5),
        'g_final': gain(ks[23], (D_MODEL,)),
    }


def reference(x_prompt, x_sample, cache_ckv, cache_krope, c, c_ctx, w_ada, b_ada, g_mix,
              w_in, w_pool, pool_scale, g_q, w_uq, g_kv, w_ukv, g_sgu, w_s, b_s, w_out,
              g_ffn, w_ff1, w_ff2, g_final):
    rope = axial_rope(x_sample.shape[1])
    s_ctx = jax.nn.silu(c_ctx)
    s_lat = jax.nn.silu(c)
    xp, xs = x_prompt, x_sample
    ckv_list, kr_list = [], []
    for l in range(DEPTH):
        p = {
            'g_mix': g_mix[l], 'w_in': w_in[l], 'w_pool': w_pool[l], 'pool_scale': pool_scale[l],
            'g_q': g_q[l], 'w_uq': w_uq[l], 'g_kv': g_kv[l], 'w_ukv': w_ukv[l],
            'g_sgu': g_sgu[l], 'w_s': w_s[l], 'b_s': b_s[l], 'w_out': w_out[l],
            'g_ffn': g_ffn[l], 'w_ff1': w_ff1[l], 'w_ff2': w_ff2[l],
        }
        mod_ctx = (s_ctx @ w_ada[l] + b_ada[l])[None, None, :]
        mod_lat = (s_lat @ w_ada[l] + b_ada[l])[:, None, :]
        xp, ckv, kr = trunk_layer(xp, mod_ctx, p, None, None)
        ckv_list.append(ckv)
        kr_list.append(kr)
        xs, _, _ = trunk_layer(xs, mod_lat, p, rope, (cache_ckv[:, l], cache_krope[:, l]))
    y_prompt = rmsnorm(xp, g_final)
    y_sample = rmsnorm(xs, g_final)
    state_ckv = jnp.stack(ckv_list, axis=1)
    state_krope = jnp.stack(kr_list, axis=1)
    return (y_prompt, y_sample, state_ckv, state_krope)
```

```cpp
#include <hip/hip_runtime.h>
#include <cstdio>
#include <cstdint>

#define LAS __attribute__((address_space(3)))
#if defined(__HIP_DEVICE_COMPILE__)
#define GAS __attribute__((address_space(1)))
#else
#define GAS
#endif
typedef unsigned short bf16_t;
typedef short bf16x8 __attribute__((ext_vector_type(8)));
typedef short s16x4 __attribute__((ext_vector_type(4)));
typedef float f32x2 __attribute__((ext_vector_type(2)));
typedef float f32x4 __attribute__((ext_vector_type(4)));
typedef float f32x16 __attribute__((ext_vector_type(16)));
typedef unsigned u32x4 __attribute__((ext_vector_type(4)));
typedef unsigned u32x2 __attribute__((ext_vector_type(2)));
typedef GAS unsigned gu32;

#ifndef PROBE_PHASE
#define PROBE_PHASE -1
#endif
#ifndef PROBE_REP
#define PROBE_REP 0
#endif
#ifndef PROBE_FLUSH
#define PROBE_FLUSH 0
#endif
#ifndef MK_PER_PHASE
#define MK_PER_PHASE 0
#endif
#define FUSE_FINAL (!MK_PER_PHASE)
#ifndef DEFER_FF
#define DEFER_FF 1
#endif

constexpr int DM = 1024, DEPTH = 4, NCTXB = 16, LCTX = 256, NLATB = 8, LLAT = 2048, PAST = 256;
constexpr int NCTX = NCTXB * LCTX  , NLAT = NLATB * LLAT  , MROWS = NCTX + NLAT  ;
constexpr int NSLOT = 9, MODW = 6 * DM;
constexpr int INW = 1472, INP = 1536, QRANK = 384, KVRANK = 256, QW = 768, KVW = 1024, DFF = 4096, NH = 4;
constexpr int LKEY = PAST + LLAT  ;
constexpr float EPS = 1e-6f;
constexpr float C2 = 0.07216878364870322f * 1.4426950408889634f;
constexpr int NTM = MROWS / 256;

constexpr size_t OUT_X = 0, OUT_CKV = (size_t)MROWS * DM, OUT_KR = OUT_CKV + (size_t)NCTXB * DEPTH * LCTX * KVRANK, OUT_END = OUT_KR + (size_t)NCTXB * DEPTH * LCTX * 64;

constexpr size_t al256(size_t x) { return (x + 255) / 256 * 256; }
constexpr size_t WS_CTL = 0, CTL_ZERO_BYTES = 1u << 20;
constexpr size_t WS_MODP = CTL_ZERO_BYTES;
constexpr size_t WS_SH1 = WS_MODP + al256((size_t)16 * NSLOT * DEPTH * MODW * 4);
constexpr size_t MODV = al256((size_t)DEPTH * NSLOT * DM * 4);
constexpr size_t WS_GM1 = WS_SH1 + MODV, WS_G1 = WS_GM1 + MODV, WS_SH2 = WS_G1 + MODV, WS_GM2 = WS_SH2 + MODV, WS_G2 = WS_GM2 + MODV;
constexpr size_t WS_SHW1 = WS_G2 + MODV;
constexpr size_t WS_SHW2 = WS_SHW1 + al256((size_t)DEPTH * NSLOT * INP * 4);
constexpr size_t WS_ROPE = WS_SHW2 + al256((size_t)DEPTH * NSLOT * DFF * 4);
constexpr size_t WS_ST1 = WS_ROPE + al256(64 * 16 * 8);
constexpr size_t WS_ST2 = WS_ST1 + al256((size_t)MROWS * 16 * 4);
constexpr size_t WS_STQ = WS_ST2 + al256((size_t)MROWS * 16 * 4);
constexpr size_t WS_STKV = WS_STQ + al256((size_t)MROWS * 8 * 4);
constexpr size_t WS_STG = WS_STKV + al256((size_t)MROWS * 4 * 4);
constexpr size_t WS_WIN = WS_STG + al256((size_t)MROWS * 4 * 4);
constexpr size_t WS_WUQ = WS_WIN + al256((size_t)DEPTH * INP * DM * 2);
constexpr size_t WS_WKVF = WS_WUQ + al256((size_t)DEPTH * QW * QRANK * 2);
constexpr size_t WS_WKVC = WS_WKVF + al256((size_t)DEPTH * KVW * KVRANK * 2);
constexpr size_t WS_WOUT = WS_WKVC + al256((size_t)DEPTH * KVW * KVRANK * 2);
constexpr size_t WS_WF1 = WS_WOUT + al256((size_t)DEPTH * DM * DM * 2);
constexpr size_t WS_WF2 = WS_WF1 + al256((size_t)DEPTH * DFF * DM * 2);
constexpr size_t WS_WPT = WS_WF2 + al256((size_t)DEPTH * DM * DFF * 2);
constexpr size_t WS_WSB = WS_WPT + al256((size_t)DEPTH * 4 * 64 * 64 * 2);
constexpr size_t WS_CCKV = WS_WSB + al256((size_t)DEPTH * 4 * 128 * 128 * 2);
constexpr size_t WS_XG = WS_CCKV + al256((size_t)DEPTH * NLATB * PAST * KVRANK * 2);
constexpr size_t cmax(size_t a, size_t b) { return a > b ? a : b; }
constexpr size_t LB(size_t base, size_t w) { return base - (size_t)NCTX * w * 2; }
constexpr size_t WS_XB = WS_XG + al256((size_t)MROWS * DM * 2);
constexpr size_t WS_RC = WS_XB + al256((size_t)MROWS * DM * 2);
constexpr size_t HP_C = WS_RC, CKVR_C = HP_C + (size_t)NCTX * 256 * 2, U_C = CKVR_C + (size_t)NCTX * 256 * 2, GL_C = U_C + (size_t)NCTX * 256 * 2;
constexpr size_t CQ_C = GL_C + (size_t)NCTX * 256 * 2, Q_C = CQ_C + (size_t)NCTX * QRANK * 2, WS_KC = Q_C + (size_t)NCTX * QW * 2;
constexpr size_t WS_VC = WS_KC + (size_t)NCTXB * NH * LCTX * 192 * 2, YCAT_C = WS_VC + (size_t)NCTXB * NH * LCTX * 128 * 2;
constexpr size_t HID_C = WS_RC;
constexpr size_t WS_RL = al256(cmax(YCAT_C + (size_t)NCTX * DM * 2, HID_C + (size_t)NCTX * DFF * 2));
constexpr size_t HP_L0 = WS_RL, CKVR_L0 = HP_L0 + (size_t)NLAT * 256 * 2, U_L0 = CKVR_L0 + (size_t)NLAT * 256 * 2, GL_L0 = U_L0 + (size_t)NLAT * 256 * 2;
constexpr size_t CQ_L0 = GL_L0 + (size_t)NLAT * 256 * 2, Q_L0 = CQ_L0 + (size_t)NLAT * QRANK * 2, WS_KL = Q_L0 + (size_t)NLAT * QW * 2;
constexpr size_t WS_VL = WS_KL + (size_t)NLATB * NH * LKEY * 192 * 2, YCAT_L0 = WS_VL + (size_t)NLATB * NH * LKEY * 128 * 2;
constexpr size_t HID_L0 = WS_RL;
constexpr size_t HP_L = LB(HP_L0, 256), CKVR_L = LB(CKVR_L0, 256), U_L = LB(U_L0, 256), GL_L = LB(GL_L0, 256), CQ_L = LB(CQ_L0, QRANK), Q_L = LB(Q_L0, QW), YCAT_L = LB(YCAT_L0, DM), HID_L = LB(HID_L0, DFF);
constexpr size_t WS_OVL = WS_RC;
constexpr size_t WS_END = al256(cmax(YCAT_L0 + (size_t)NLAT * DM * 2, HID_L0 + (size_t)NLAT * DFF * 2));
#define SPLIT(isctx, NAME) ((isctx) ? NAME##_C : NAME##_L)

constexpr int CW_BAR = 4096;
constexpr int CW_FIN = 16384;
constexpr int CW_XCC = 8192;

constexpr int RING_BYTES = 131072, MISC_OFF = RING_BYTES + 320, LDS_BYTES = 147456;

#define RLX_AGENT __ATOMIC_RELAXED, __HIP_MEMORY_SCOPE_AGENT
#define LDS_WAIT() asm volatile("s_waitcnt lgkmcnt(0)" ::: "memory")
#define VM_WAIT() asm volatile("s_waitcnt vmcnt(0)" ::: "memory")
#define SBAR() __builtin_amdgcn_sched_barrier(0)
__device__ __forceinline__ unsigned cvt_pk_bf16(float lo, float hi) { unsigned r; asm volatile("v_cvt_pk_bf16_f32 %0, %1, %2" : "=v"(r) : "v"(lo), "v"(hi)); return r; }
__device__ __forceinline__ float bf_lo(unsigned w) { return __uint_as_float(w << 16); }
__device__ __forceinline__ float bf_hi(unsigned w) { return __uint_as_float(w & 0xffff0000u); }
__device__ __forceinline__ float bf1(bf16_t h) { return __uint_as_float(((unsigned)h) << 16); }
__device__ __forceinline__ bf16_t f2bf(float f) { return (bf16_t)(cvt_pk_bf16(f, 0.f) & 0xffffu); }
__device__ __forceinline__ float fast_rsqrt(float x) { return __builtin_amdgcn_rsqf(x); }
__device__ __forceinline__ float gelu_tanh(float x) {
    const float z = x * (1.0f + 0.044715f * x * x);
    const float e = __builtin_amdgcn_exp2f(z * (-2.0f * 0.7978845608028654f * 1.4426950408889634f));
    return x * __builtin_amdgcn_rcpf(1.0f + e);
}
__device__ __forceinline__ float wave_sum(float v) {
#pragma unroll
    for (int o = 1; o < 64; o <<= 1) v += __shfl_xor(v, o);
    return v;
}
__device__ __forceinline__ float fq_sum(float q) {
    { auto r = __builtin_amdgcn_permlane16_swap(__float_as_uint(q), __float_as_uint(q), false, false); q = __uint_as_float(r[0]) + __uint_as_float(r[1]); }
    { auto r = __builtin_amdgcn_permlane32_swap(__float_as_uint(q), __float_as_uint(q), false, false); q = __uint_as_float(r[0]) + __uint_as_float(r[1]); }
    return q;
}
__device__ __forceinline__ int slot_of_tile(int pm) { return pm < 16 ? 0 : 1 + ((pm - 16) >> 3); }

#define XB_TMO      128
#define XB_XCNT(j)  (256  + 64 * (j))
#define XB_XSUB(j)  (1280 + 64 * (j))
#define XB_XGEN(j)  (2304 + 64 * (j))
#define XB_TOP      3328
#define XB_TOPGEN   3392
#define XCD_BAR_WORDS 3456
#define XB_SPIN_CAP (1u << 18)
__device__ __forceinline__ unsigned xb_ld(unsigned* p)              { return __hip_atomic_load(p, __ATOMIC_RELAXED, __HIP_MEMORY_SCOPE_AGENT); }
__device__ __forceinline__ unsigned xb_add(unsigned* p, unsigned v) { return __hip_atomic_fetch_add(p, v, __ATOMIC_RELAXED, __HIP_MEMORY_SCOPE_AGENT); }
__device__ __forceinline__ unsigned xb_xcc_id() { return (unsigned)__builtin_amdgcn_s_getreg((3 << 11) | 20) & 0xFu; }
#define XB_SPIN(cond, bar) do { unsigned _sp = 0; while (cond) { __builtin_amdgcn_s_sleep(1); \
    if ((++_sp & 255u) == 0u) { if (xb_ld(&(bar)[XB_TMO])) break; if (_sp > XB_SPIN_CAP) { atomicAdd(&(bar)[XB_TMO], 1u); break; } } } } while (0)
struct XcdBarrier { unsigned* bar; unsigned x; volatile LAS unsigned* st; };
__device__ __forceinline__ XcdBarrier xcd_barrier_post(unsigned* bar, volatile LAS unsigned* st) {
    XcdBarrier b; b.bar = bar; b.x = xb_xcc_id(); b.st = st;
    if (threadIdx.x == 0) (void)xb_add(&bar[XB_XCNT(b.x)], 1u);
    return b;
}
__device__ __forceinline__ void xcd_barrier_complete(unsigned* bar, unsigned x, unsigned& nloc, unsigned& nx) {
    const unsigned G = gridDim.x * gridDim.y * gridDim.z;
    unsigned sum, cnt, mine, sp = 0u;
    for (;;) {
        sum = 0u; cnt = 0u; mine = 0u;
#pragma unroll
        for (unsigned j = 0; j < 16; ++j) { const unsigned c = xb_ld(&bar[XB_XCNT(j)]); sum += c; cnt += (c > 0u) ? 1u : 0u; mine = (j == x) ? c : mine; }
        if (sum == G) break;
        __builtin_amdgcn_s_sleep(1);
        if ((++sp & 255u) == 0u) { if (xb_ld(&bar[XB_TMO])) break; if (sp > XB_SPIN_CAP) { atomicAdd(&bar[XB_TMO], 1u); break; } }
    }
    nloc = mine > 0u ? mine : 1u; nx = cnt > 0u ? cnt : 1u;
}
__device__ __forceinline__ void xcd_barrier(const XcdBarrier& b) {
    asm volatile("s_waitcnt vmcnt(0)" ::: "memory");
    __syncthreads();
    if (threadIdx.x == 0) {
        unsigned* bar = b.bar;
        __builtin_amdgcn_s_waitcnt(0);
        unsigned nloc = b.st[0], nx = b.st[1];
        if (nloc == 0u) { xcd_barrier_complete(bar, b.x, nloc, nx); b.st[0] = nloc; b.st[1] = nx; }
        const unsigned old = xb_add(&bar[XB_XSUB(b.x)], 1u);
        const unsigned gen = old / nloc;
        if (old + 1u == (gen + 1u) * nloc) {
            if (b.st[2] == 0u) __builtin_amdgcn_fence(__ATOMIC_RELEASE, "agent");
            asm volatile("s_waitcnt vmcnt(0)" ::: "memory");
            const unsigned og = xb_add(&bar[XB_TOP], 1u);
            const unsigned tg = og / nx;
            if (og + 1u == (tg + 1u) * nx) xb_add(&bar[XB_TOPGEN], 1u);
            else XB_SPIN(xb_ld(&bar[XB_TOPGEN]) == tg, bar);
            __builtin_amdgcn_fence(__ATOMIC_ACQUIRE, "agent");
            xb_add(&bar[XB_XGEN(b.x)], 1u);
            asm volatile("s_waitcnt vmcnt(0)" ::: "memory");
        } else {
            XB_SPIN(xb_ld(&bar[XB_XGEN(b.x)]) == gen, bar);
            __builtin_amdgcn_fence(__ATOMIC_ACQUIRE, "agent");
            asm volatile("s_waitcnt vmcnt(0)" ::: "memory");
        }
    }
    __syncthreads();
}

struct Args { const float* in[24]; float* out; unsigned char* ws; int ph_lo, ph_hi; };

struct Ctx {
    const Args* a; GAS float* out; GAS unsigned char* ws;
    LAS unsigned char* lds;
    int tid, lane, wave, G, vcu;
};
template <class T> __device__ __forceinline__ GAS T* wsp(const Ctx& F, size_t off) { return (GAS T*)(F.ws + off); }
#define GIN(k) ((const GAS float*)F.a->in[k])

constexpr int BK = 64, HALF = 128, HTB = HALF * BK * 2;
__host__ __device__ __forceinline__ int lds_byte(int r, int c) { const int st = (r >> 4) * 2 + (c >> 5), rr = r & 15, cc = c & 31, ob = rr * 64 + cc * 2; return st * 1024 + (ob ^ (((ob >> 9) & 1) << 5)); }
__host__ __device__ __forceinline__ void stage_rc(int b, int& R, int& C) { const int st = b / 1024, sb = b % 1024, swz = sb ^ (((sb >> 9) & 1) << 5); R = (st >> 1) * 16 + swz / 64; C = (st & 1) * 32 + (swz % 64) / 2; }
__host__ __device__ __forceinline__ int perm32(int rho) { const int n = rho >> 4, i = rho & 15; return 8 * (i >> 2) + 4 * n + (i & 3); }

struct GUnit { unsigned A, B; int K, pm, pn, kind, l; };
__device__ __forceinline__ void map_unit(int L, int nM, int nN, int& pm, int& pn) {
    const int nwg = nM * nN; int wgid = L;
    { const int q = nwg / 8, r = nwg % 8, xcd = wgid % 8, off = wgid / 8; wgid = (xcd < r ? xcd * (q + 1) : r * (q + 1) + (xcd - r) * q) + off; }
    const int nig = 8 * nN, gid = wgid / nig, fm = gid * 8, gsz = (nM - fm) < 8 ? (nM - fm) : 8;
    pm = fm + ((wgid % nig) % gsz); pn = (wgid % nig) / gsz;
}

typedef f32x4 Acc[2][2][4][2];

template <class Sched, class Epi>
__device__ __forceinline__ void gemm_phase(LAS unsigned char* lds, const Sched& S, const Epi& E) {
    int tid_ = threadIdx.x; asm volatile("" : "+v"(tid_));
    const int tid = tid_, wid = __builtin_amdgcn_readfirstlane(tid >> 6), lane = tid & 63, wr = wid >> 2, wc = wid & 3, fr = lane & 15, fq = lane >> 4;
    int sR[2], sRb[2], sC[2];
#define PG8_LANECONST(t_) do { _Pragma("unroll") for (int i = 0; i < 2; ++i) { int R, C; stage_rc((t_) * 16 + i * 8192, R, C); sR[i] = R; sRb[i] = (R & ~31) + perm32(R & 31); sC[i] = C; } } while (0)
    PG8_LANECONST(tid);
    const unsigned kstep = (unsigned)(BK * 2);
    const GAS unsigned char* gws = S.ws;
    const unsigned ldsw = (unsigned)wid * 1024u;
    int aoff = lds_byte(wr * 64 + fr, fq * 8), boff = lds_byte(wc * 32 + fr, fq * 8);
#define PG8_SA(b, h) (((b) * 2 + (h)) * HTB)
#define PG8_SB(b, h) ((4 + (b) * 2 + (h)) * HTB)
#define PG8_STAGE(bufoff, goff, v0, v1) do { \
        __builtin_amdgcn_global_load_lds((const GAS unsigned*)(gws + (size_t)((goff) + (v0))), (LAS unsigned*)(lds + (bufoff) + ldsw), 16, 0, 0); \
        __builtin_amdgcn_global_load_lds((const GAS unsigned*)(gws + (size_t)((goff) + (v1))), (LAS unsigned*)(lds + (bufoff) + ldsw + 8192), 16, 0, 0); } while (0)
#define PG8_LDA(dst, b, h) do { _Pragma("unroll") for (int m = 0; m < 4; ++m) _Pragma("unroll") for (int k = 0; k < 2; ++k) dst[m][k] = *(const LAS bf16x8*)(lds + PG8_SA(b, h) + aoff + m * 2048 + k * 1024); } while (0)
#define PG8_LDB(dst, b, h) do { _Pragma("unroll") for (int n = 0; n < 2; ++n) _Pragma("unroll") for (int k = 0; k < 2; ++k) dst[n][k] = *(const LAS bf16x8*)(lds + PG8_SB(b, h) + boff + n * 2048 + k * 1024); } while (0)
#define PG8_MMA(ai, bj, At, Bt) do { __builtin_amdgcn_s_setprio(1); _Pragma("unroll") for (int m = 0; m < 4; ++m) _Pragma("unroll") for (int n = 0; n < 2; ++n) _Pragma("unroll") for (int k = 0; k < 2; ++k) \
        acc[ai][bj][m][n] = __builtin_amdgcn_mfma_f32_16x16x32_bf16(Bt[n][k], At[m][k], acc[ai][bj][m][n], 0, 0, 0); __builtin_amdgcn_s_setprio(0); } while (0)
#define PG8_WAIT_V(n) asm volatile("s_waitcnt vmcnt(" #n ")" ::: "memory")
#define PG8_WAIT_L(n) asm volatile("s_waitcnt lgkmcnt(" #n ")" ::: "memory")
#define PG8_BAR __builtin_amdgcn_s_barrier()
#define PG8_SCHED __builtin_amdgcn_sched_barrier(0)
    GUnit cur, nxt; int ui = 0;
    if (!S.next(0, cur)) return;
    Acc acc;
#pragma unroll
    for (int a = 0; a < 2; ++a)
#pragma unroll
        for (int b = 0; b < 2; ++b)
#pragma unroll
            for (int m = 0; m < 4; ++m)
#pragma unroll
                for (int n = 0; n < 2; ++n) acc[a][b][m][n] = (f32x4){0.f, 0.f, 0.f, 0.f};
    bf16x8 At[4][2], B0[2][2], B1[2][2];
    unsigned vA0 = (unsigned)(sR[0] * cur.K + sC[0]) * 2u, vA1 = (unsigned)(sR[1] * cur.K + sC[1]) * 2u;
    unsigned vB0 = (unsigned)(sRb[0] * cur.K + sC[0]) * 2u, vB1 = (unsigned)(sRb[1] * cur.K + sC[1]) * 2u;
    unsigned hs = (unsigned)HALF * cur.K * 2;
    unsigned cA = cur.A, cB = cur.B;
    PG8_STAGE(PG8_SB(0, 0), cB, vB0, vB1); PG8_STAGE(PG8_SB(0, 1), cB + hs, vB0, vB1); PG8_STAGE(PG8_SA(0, 0), cA, vA0, vA1); PG8_STAGE(PG8_SA(0, 1), cA + hs, vA0, vA1);
    if (wr == 1) PG8_BAR;
    PG8_WAIT_V(2); PG8_BAR;
    PG8_STAGE(PG8_SB(1, 0), cB + kstep, vB0, vB1); PG8_STAGE(PG8_SA(1, 0), cA + kstep, vA0, vA1); PG8_STAGE(PG8_SB(1, 1), cB + hs + kstep, vB0, vB1);
    PG8_WAIT_V(6); PG8_BAR;
    for (;;) {
        { int tq = tid; asm volatile("" : "+v"(tq)); PG8_LANECONST(tq); const int fr_ = tq & 15, fq_ = (tq & 63) >> 4; aoff = lds_byte(wr * 64 + fr_, fq_ * 8); boff = lds_byte(wc * 32 + fr_, fq_ * 8);
          vA0 = (unsigned)(sR[0] * cur.K + sC[0]) * 2u; vA1 = (unsigned)(sR[1] * cur.K + sC[1]) * 2u; vB0 = (unsigned)(sRb[0] * cur.K + sC[0]) * 2u; vB1 = (unsigned)(sRb[1] * cur.K + sC[1]) * 2u; }
        const bool has_next = S.next(ui + 1, nxt);
        if (!has_next) nxt = cur;
        const unsigned nvA0 = (unsigned)(sR[0] * nxt.K + sC[0]) * 2u, nvA1 = (unsigned)(sR[1] * nxt.K + sC[1]) * 2u;
        const unsigned nvB0 = (unsigned)(sRb[0] * nxt.K + sC[0]) * 2u, nvB1 = (unsigned)(sRb[1] * nxt.K + sC[1]) * 2u;
        const unsigned nhs = (unsigned)HALF * nxt.K * 2;
        const unsigned nA = nxt.A, nB = nxt.B;
        const int nt = cur.K >> 6;
        for (int t = 0; t < nt; t += 2) {
            const bool last = (t == nt - 2);
            const unsigned a1 = cA + (unsigned)(t + 1) * kstep;
            const unsigned a2 = last ? nA : cA + (unsigned)(t + 2) * kstep, b2 = last ? nB : cB + (unsigned)(t + 2) * kstep;
            const unsigned a3 = a2 + kstep, b3 = b2 + kstep;
            const unsigned wA0 = last ? nvA0 : vA0, wA1 = last ? nvA1 : vA1, wB0 = last ? nvB0 : vB0, wB1 = last ? nvB1 : vB1;
            const unsigned hs2 = last ? nhs : hs;
            PG8_LDB(B0, 0, 0); PG8_LDB(B1, 0, 1); PG8_SCHED; PG8_LDA(At, 0, 0); PG8_STAGE(PG8_SA(1, 1), a1 + hs, vA0, vA1);
            PG8_WAIT_V(8); PG8_WAIT_L(0); PG8_BAR; PG8_MMA(0, 0, At, B0); PG8_MMA(0, 1, At, B1); PG8_BAR; PG8_SCHED;
            PG8_LDA(At, 0, 1); PG8_STAGE(PG8_SB(0, 0), b2, wB0, wB1); PG8_STAGE(PG8_SB(0, 1), b2 + hs2, wB0, wB1); PG8_STAGE(PG8_SA(0, 0), a2, wA0, wA1);
            PG8_WAIT_V(8); PG8_WAIT_L(0); PG8_BAR; PG8_MMA(1, 0, At, B0); PG8_MMA(1, 1, At, B1); PG8_BAR; PG8_SCHED;
            PG8_LDB(B0, 1, 0); PG8_LDB(B1, 1, 1); PG8_SCHED; PG8_LDA(At, 1, 0); PG8_STAGE(PG8_SA(0, 1), a2 + hs2, wA0, wA1);
            PG8_WAIT_V(8); PG8_WAIT_L(0); PG8_BAR; PG8_MMA(0, 0, At, B0); PG8_MMA(0, 1, At, B1); PG8_BAR; PG8_SCHED;
            PG8_LDA(At, 1, 1); PG8_STAGE(PG8_SB(1, 0), b3, wB0, wB1); PG8_STAGE(PG8_SB(1, 1), b3 + hs2, wB0, wB1); PG8_STAGE(PG8_SA(1, 0), a3, wA0, wA1);
            PG8_WAIT_V(8); PG8_WAIT_L(0); PG8_BAR; PG8_MMA(1, 0, At, B0); PG8_MMA(1, 1, At, B1); PG8_BAR; PG8_SCHED;
        }
        if (wr == 0) PG8_BAR;
        E(acc, cur, wr, wc, fr, fq, tid, (LAS float*)(lds + RING_BYTES + 2048));
        if (!has_next) break;
#pragma unroll
        for (int a = 0; a < 2; ++a)
#pragma unroll
            for (int b = 0; b < 2; ++b)
#pragma unroll
                for (int m = 0; m < 4; ++m)
#pragma unroll
                    for (int n = 0; n < 2; ++n) acc[a][b][m][n] = (f32x4){0.f, 0.f, 0.f, 0.f};
        cur = nxt; cA = nA; cB = nB; hs = nhs; ++ui;
        if (wr == 1) PG8_BAR;
    }
    PG8_WAIT_V(0);
    PG8_BAR;
#undef PG8_SA
#undef PG8_LANECONST
#undef PG8_SB
#undef PG8_STAGE
#undef PG8_LDA
#undef PG8_LDB
#undef PG8_MMA
#undef PG8_WAIT_V
#undef PG8_WAIT_L
#undef PG8_BAR
#undef PG8_SCHED
}

enum Kind { K_HP = 0, K_CKV = 1, K_U = 2, K_VG = 3, K_CQ0 = 4, K_CQ1 = 5, K_Q = 6, K_KV = 7, K_KVC = 8, K_OUT = 9, K_FF1 = 10, K_FF2 = 11 };

__device__ __forceinline__ u32x4 pack8(const f32x4 a, const f32x4 b) { u32x4 w; w.x = cvt_pk_bf16(a[0], a[1]); w.y = cvt_pk_bf16(a[2], a[3]); w.z = cvt_pk_bf16(b[0], b[1]); w.w = cvt_pk_bf16(b[2], b[3]); return w; }
__device__ __forceinline__ float sum4(const f32x4 v) { return (v[0] + v[1]) + (v[2] + v[3]); }
__device__ __forceinline__ float sq8(const f32x4 a, const f32x4 b) { return (a[0] * a[0] + a[1] * a[1]) + (a[2] * a[2] + a[3] * a[3]) + (b[0] * b[0] + b[1] * b[1]) + (b[2] * b[2] + b[3] * b[3]); }

struct Epi {
    GAS unsigned char* ws; GAS float* out; const GAS float* xp; const GAS float* xs;
    bool dry;

    __device__ __forceinline__ void operator()(Acc& acc, const GUnit& u, int wr, int wc, int fr, int fq, int tid, LAS float* tab) const {
        int rowb_ = u.pm * 256 + wr * 64 + fr, colw_ = wc * 32 + 8 * fq;
        asm volatile("" : "+v"(rowb_), "+v"(colw_));
        const int rowb = rowb_, colw = colw_, s = slot_of_tile(u.pm), l = u.l;
        const bool isctx = u.pm < 16;
        GAS float* xout = out + OUT_X;
        const GAS float* stin = nullptr;
        if (u.kind <= K_CQ1) stin = (const GAS float*)(ws + WS_ST1);
        else if (u.kind == K_Q) stin = (const GAS float*)(ws + WS_STQ);
        else if (u.kind == K_KV) stin = (const GAS float*)(ws + WS_STKV);
        else if (u.kind == K_FF1) stin = (const GAS float*)(ws + WS_ST2);
        const int tagv = ((u.kind <= K_CQ1 ? 0 : u.kind) << 20) | (l << 12) | (u.pm << 2) | 1;
        const bool fresh = stin && __builtin_amdgcn_readfirstlane(*(volatile LAS int*)(tab + 256)) != tagv;
        if (fresh) {
            if (tid < 256) { const int row = u.pm * 256 + tid; float rs;
                if (u.kind == K_Q) { const GAS f32x4* sp = (const GAS f32x4*)(stin + (size_t)row * 8); rs = fast_rsqrt((sum4(sp[0]) + sum4(sp[1])) * (1.0f / QRANK) + EPS) * C2; }
                else if (u.kind == K_KV) { const f32x4 t0 = *(const GAS f32x4*)(stin + (size_t)row * 4); rs = fast_rsqrt(sum4(t0) * (1.0f / KVRANK) + EPS); }
                else { const GAS f32x4* sp = (const GAS f32x4*)(stin + (size_t)row * 16); rs = fast_rsqrt(((sum4(sp[0]) + sum4(sp[1])) + (sum4(sp[2]) + sum4(sp[3]))) * (1.0f / DM) + EPS); }
                tab[tid] = rs; }
            asm volatile("s_waitcnt lgkmcnt(0)" ::: "memory"); __builtin_amdgcn_s_barrier(); asm volatile("" ::: "memory");
            if (tid == 0) *(volatile LAS int*)(tab + 256) = tagv;
        }
        const int rl0 = wr * 64 + fr;
        switch (u.kind) {
        case K_HP: case K_CKV: case K_U: case K_VG: case K_CQ0: case K_CQ1: {
            const GAS float* shw = (const GAS float*)(ws + WS_SHW1) + (size_t)l * NSLOT * INP; const int ldshw = INP;
            const LAS f32x2* rope = (const LAS f32x2*)(tab + 512);
            f32x4 sw[2][2];
#pragma unroll
            for (int bj = 0; bj < 2; ++bj) { const float* p = shw + (size_t)s * ldshw + u.pn * 256 + bj * 128 + colw; sw[bj][0] = *(const f32x4*)p; sw[bj][1] = *(const f32x4*)(p + 4); }
            bf16_t* dst; int ldd, coff = 0; float* st = nullptr; int sto = 0, stw = 4;
            if (u.kind == K_HP) { dst = (bf16_t*)(ws + SPLIT(isctx, HP)); ldd = 256; }
            else if (u.kind == K_CKV) { dst = (bf16_t*)(ws + SPLIT(isctx, CKVR)); ldd = 256; st = (float*)(ws + WS_STKV); }
            else if (u.kind == K_U) { dst = (bf16_t*)(ws + SPLIT(isctx, U)); ldd = 256; }
            else if (u.kind == K_VG) { dst = (bf16_t*)(ws + SPLIT(isctx, GL)); ldd = 256; st = (float*)(ws + WS_STG); }
            else if (u.kind == K_CQ0) { dst = (bf16_t*)(ws + SPLIT(isctx, CQ)); ldd = QRANK; st = (float*)(ws + WS_STQ); stw = 8; }
            else { dst = (bf16_t*)(ws + SPLIT(isctx, CQ)); ldd = QRANK; coff = 256; st = (float*)(ws + WS_STQ); stw = 8; sto = 4; }
            const bool act = (u.kind == K_U || u.kind == K_VG);
#pragma unroll
            for (int ai = 0; ai < 2; ++ai)
#pragma unroll
                for (int m = 0; m < 4; ++m) {
                    asm volatile("" ::: "memory");
                    const int row = rowb + ai * 128 + m * 16;
                    const float rs = tab[rl0 + ai * 128 + m * 16];
                    f32x4 v[2][2];
#pragma unroll
                    for (int bj = 0; bj < 2; ++bj)
#pragma unroll
                        for (int n = 0; n < 2; ++n) { v[bj][n] = acc[ai][bj][m][n] * rs + sw[bj][n];
                            if (act) {
#pragma unroll
                                for (int j = 0; j < 4; ++j) v[bj][n][j] = gelu_tanh(v[bj][n][j]); } }
                    if (u.kind != K_CQ1) {
                        *(u32x4*)(dst + (size_t)row * ldd + coff + colw) = pack8(v[0][0], v[0][1]);
                        *(u32x4*)(dst + (size_t)row * ldd + coff + 128 + colw) = pack8(v[1][0], v[1][1]);
                        if (st) { float q = sq8(v[0][0], v[0][1]) + sq8(v[1][0], v[1][1]); q = fq_sum(q); if (fq == 0) st[(size_t)row * stw + sto + wc] = q; }
                        if (u.kind == K_CKV && isctx) {
                            float* o = out + OUT_CKV + ((size_t)(u.pm * DEPTH + l) * LCTX + (row & 255)) * KVRANK + colw;
                            *(f32x4*)o = v[0][0]; *(f32x4*)(o + 4) = v[0][1]; *(f32x4*)(o + 128) = v[1][0]; *(f32x4*)(o + 132) = v[1][1];
                        }
                    } else {
                        *(u32x4*)(dst + (size_t)row * ldd + coff + colw) = pack8(v[0][0], v[0][1]);
                        { float q = sq8(v[0][0], v[0][1]); q = fq_sum(q); if (fq == 0) st[(size_t)row * stw + sto + wc] = q; }
                        if (wc < 2) {
                            const int p0 = colw, i0 = p0 >> 1, t = row & 255;
                            float x[8] = {v[1][0][0], v[1][0][1], v[1][0][2], v[1][0][3], v[1][1][0], v[1][1][1], v[1][1][2], v[1][1][3]};
                            if (isctx) {
                                float* o = out + OUT_KR + ((size_t)(u.pm * DEPTH + l) * LCTX + t) * 64;
#pragma unroll
                                for (int j = 0; j < 4; ++j) { o[i0 + j] = x[2 * j]; o[32 + i0 + j] = x[2 * j + 1]; }
                                u32x4 w; w.x = cvt_pk_bf16(x[0], x[1]); w.y = cvt_pk_bf16(x[2], x[3]); w.z = cvt_pk_bf16(x[4], x[5]); w.w = cvt_pk_bf16(x[6], x[7]);
                                bf16_t* kd = (bf16_t*)(ws + WS_KC) + ((size_t)(u.pm * NH) * LCTX + t) * 192 + 128 + p0;
#pragma unroll
                                for (int h = 0; h < NH; ++h) *(u32x4*)(kd + (size_t)h * LCTX * 192) = w;
                            } else {
                                const int b = (u.pm - 16) >> 3, tl = ((u.pm - 16) & 7) * 256 + t;
                                const int pos = (wc == 0) ? (tl >> 6) : (tl & 63);
                                float y[8];
#pragma unroll
                                for (int j = 0; j < 4; ++j) { const f32x2 cs = rope[pos * 16 + ((i0 + j) & 15)]; y[2 * j] = x[2 * j] * cs.x - x[2 * j + 1] * cs.y; y[2 * j + 1] = x[2 * j + 1] * cs.x + x[2 * j] * cs.y; }
                                u32x4 w; w.x = cvt_pk_bf16(y[0], y[1]); w.y = cvt_pk_bf16(y[2], y[3]); w.z = cvt_pk_bf16(y[4], y[5]); w.w = cvt_pk_bf16(y[6], y[7]);
                                bf16_t* kd = (bf16_t*)(ws + WS_KL) + ((size_t)(b * NH) * LKEY + PAST + tl) * 192 + 128 + p0;
#pragma unroll
                                for (int h = 0; h < NH; ++h) *(u32x4*)(kd + (size_t)h * LKEY * 192) = w;
                            }
                        }
                    }
                }
        } break;
        case K_Q: {
            const LAS f32x2* rope = (const LAS f32x2*)(tab + 512);
            bf16_t* dst = (bf16_t*)(ws + SPLIT(isctx, Q));
#pragma unroll
            for (int ai = 0; ai < 2; ++ai)
#pragma unroll
                for (int m = 0; m < 4; ++m) {
                    asm volatile("" ::: "memory");
                    const int row = rowb + ai * 128 + m * 16;
                    const float rs = tab[rl0 + ai * 128 + m * 16];
#pragma unroll
                    for (int bj = 0; bj < 2; ++bj) {
                        const int c = u.pn * 256 + bj * 128 + colw, w192 = c % 192;
                        f32x4 v0 = acc[ai][bj][m][0] * rs, v1 = acc[ai][bj][m][1] * rs;
                        if (!isctx && w192 >= 128) {
                            const int i0 = (w192 - 128) >> 1, tl = ((u.pm - 16) & 7) * 256 + (row & 255);
                            const int pos = (i0 < 16) ? (tl >> 6) : (tl & 63);
                            float x[8] = {v0[0], v0[1], v0[2], v0[3], v1[0], v1[1], v1[2], v1[3]}, y[8];
#pragma unroll
                            for (int j = 0; j < 4; ++j) { const f32x2 cs = rope[pos * 16 + ((i0 + j) & 15)]; y[2 * j] = x[2 * j] * cs.x - x[2 * j + 1] * cs.y; y[2 * j + 1] = x[2 * j + 1] * cs.x + x[2 * j] * cs.y; }
                            v0 = (f32x4){y[0], y[1], y[2], y[3]}; v1 = (f32x4){y[4], y[5], y[6], y[7]};
                        }
                        *(u32x4*)(dst + (size_t)row * QW + c) = pack8(v0, v1);
                    }
                }
        } break;
        case K_KV: case K_KVC: {
            const int h = u.pn;
            bf16_t *kd, *vd; int ldrow;
            if (u.kind == K_KVC) { kd = (bf16_t*)(ws + WS_KL) + ((size_t)(u.pm * NH + h) * LKEY) * 192; vd = (bf16_t*)(ws + WS_VL) + ((size_t)(u.pm * NH + h) * LKEY) * 128; }
            else if (isctx) { kd = (bf16_t*)(ws + WS_KC) + ((size_t)(u.pm * NH + h) * LCTX) * 192; vd = (bf16_t*)(ws + WS_VC) + ((size_t)(u.pm * NH + h) * LCTX) * 128; }
            else { const int b = (u.pm - 16) >> 3, k0 = PAST + ((u.pm - 16) & 7) * 256; kd = (bf16_t*)(ws + WS_KL) + ((size_t)(b * NH + h) * LKEY + k0) * 192; vd = (bf16_t*)(ws + WS_VL) + ((size_t)(b * NH + h) * LKEY + k0) * 128; }
            (void)ldrow;
#pragma unroll
            for (int ai = 0; ai < 2; ++ai)
#pragma unroll
                for (int m = 0; m < 4; ++m) {
                    asm volatile("" ::: "memory");
                    const int row = rowb + ai * 128 + m * 16, rl = row & 255;
                    float rs = 1.0f;
                    if (u.kind == K_KV) rs = tab[rl0 + ai * 128 + m * 16];
                    *(u32x4*)(kd + (size_t)rl * 192 + colw) = pack8(acc[ai][0][m][0] * rs, acc[ai][0][m][1] * rs);
                    *(u32x4*)(vd + (size_t)rl * 128 + colw) = pack8(acc[ai][1][m][0] * rs, acc[ai][1][m][1] * rs);
                }
        } break;
        case K_OUT: case K_FF2: {
            const GAS float *gate, *gmn; GAS float* stout;
            if (u.kind == K_OUT) { gate = (const GAS float*)(ws + WS_G1) + (size_t)l * NSLOT * DM; gmn = (const GAS float*)(ws + WS_GM2) + (size_t)l * NSLOT * DM; stout = (GAS float*)(ws + WS_ST2); }
            else { gate = (const GAS float*)(ws + WS_G2) + (size_t)l * NSLOT * DM; gmn = (l + 1 < DEPTH) ? (const GAS float*)(ws + WS_GM1) + (size_t)(l + 1) * NSLOT * DM : nullptr; stout = (GAS float*)(ws + WS_ST1); }
            const bool in32 = (u.kind == K_OUT && l == 0);
            const GAS float* xin = isctx ? xp : xs - (size_t)NCTX * DM;
            GAS bf16_t* xb = (GAS bf16_t*)(ws + WS_XB);
            bf16_t* xg = (bf16_t*)(ws + WS_XG);
            const unsigned cb = (unsigned)(u.pn * 256 + colw);
            const float* gp = gate + (size_t)s * DM + cb; const float* mp_ = gmn ? gmn + (size_t)s * DM + cb : gp;
            if (!in32) {
                GAS unsigned char* const XBB = (GAS unsigned char*)xb; GAS unsigned char* const XGB = (GAS unsigned char*)xg;
                float qa[8];
#pragma unroll
                for (int bj = 0; bj < 2; ++bj) {
                    asm volatile("" ::: "memory");
                    const f32x4 gtA = *(const f32x4*)(gp + bj * 128), gtB = *(const f32x4*)(gp + bj * 128 + 4), gmA = *(const f32x4*)(mp_ + bj * 128), gmB = *(const f32x4*)(mp_ + bj * 128 + 4);
                    u32x4 rb[8];
#pragma unroll
                    for (int r = 0; r < 8; ++r) { const unsigned eb = ((unsigned)(rowb + (r >> 2) * 128 + (r & 3) * 16) * (unsigned)DM + cb + (unsigned)(bj * 128)) * 2u; rb[r] = *(const GAS u32x4*)(XBB + eb); }
                    asm volatile("" ::: "memory");
#pragma unroll
                    for (int r = 0; r < 8; ++r) { const int ai = r >> 2, m = r & 3; const unsigned eb = ((unsigned)(rowb + ai * 128 + m * 16) * (unsigned)DM + cb + (unsigned)(bj * 128)) * 2u;
                        const u32x4 b = rb[r];
                        const f32x4 x0 = (f32x4){bf_lo(b.x), bf_hi(b.x), bf_lo(b.y), bf_hi(b.y)} + gtA * acc[ai][bj][m][0], x1 = (f32x4){bf_lo(b.z), bf_hi(b.z), bf_lo(b.w), bf_hi(b.w)} + gtB * acc[ai][bj][m][1];
                        if (!dry) *(GAS u32x4*)(XBB + eb) = pack8(x0, x1);
                        if (gmn && !dry) *(GAS u32x4*)(XGB + eb) = pack8(x0 * gmA, x1 * gmB);
                        float q_ = sq8(x0, x1); asm volatile("" : "+v"(q_));
                        if (bj == 0) qa[r] = q_;
                        else { const float q = fq_sum(qa[r] + q_); if (fq == 0 && !dry) stout[(size_t)(rowb + ai * 128 + m * 16) * 16 + u.pn * 4 + wc] = q; }
                        asm volatile("" ::: "memory"); }
                }
            } else {
            const f32x4 gt00 = *(const f32x4*)gp, gt01 = *(const f32x4*)(gp + 4), gt10 = *(const f32x4*)(gp + 128), gt11 = *(const f32x4*)(gp + 132);
#pragma unroll
            for (int ai = 0; ai < 2; ++ai)
#pragma unroll
                for (int mp = 0; mp < 2; ++mp) {
                    asm volatile("" ::: "memory");
                    const unsigned e0 = (unsigned)(rowb + ai * 128 + (2 * mp) * 16) * (unsigned)DM + cb, e1 = e0 + 16u * DM;
                    f32x4 r000, r001, r010, r011, r100, r101, r110, r111;
                    if (in32) {
                        r000 = *(const GAS f32x4*)(xin + e0); r001 = *(const GAS f32x4*)(xin + e0 + 4); r010 = *(const GAS f32x4*)(xin + e0 + 128); r011 = *(const GAS f32x4*)(xin + e0 + 132);
                        r100 = *(const GAS f32x4*)(xin + e1); r101 = *(const GAS f32x4*)(xin + e1 + 4); r110 = *(const GAS f32x4*)(xin + e1 + 128); r111 = *(const GAS f32x4*)(xin + e1 + 132);
                    } else {
                        const u32x4 b00 = *(const GAS u32x4*)(xb + e0), b01 = *(const GAS u32x4*)(xb + e0 + 128), b10 = *(const GAS u32x4*)(xb + e1), b11 = *(const GAS u32x4*)(xb + e1 + 128);
                        r000 = (f32x4){bf_lo(b00.x), bf_hi(b00.x), bf_lo(b00.y), bf_hi(b00.y)}; r001 = (f32x4){bf_lo(b00.z), bf_hi(b00.z), bf_lo(b00.w), bf_hi(b00.w)};
                        r010 = (f32x4){bf_lo(b01.x), bf_hi(b01.x), bf_lo(b01.y), bf_hi(b01.y)}; r011 = (f32x4){bf_lo(b01.z), bf_hi(b01.z), bf_lo(b01.w), bf_hi(b01.w)};
                        r100 = (f32x4){bf_lo(b10.x), bf_hi(b10.x), bf_lo(b10.y), bf_hi(b10.y)}; r101 = (f32x4){bf_lo(b10.z), bf_hi(b10.z), bf_lo(b10.w), bf_hi(b10.w)};
                        r110 = (f32x4){bf_lo(b11.x), bf_hi(b11.x), bf_lo(b11.y), bf_hi(b11.y)}; r111 = (f32x4){bf_lo(b11.z), bf_hi(b11.z), bf_lo(b11.w), bf_hi(b11.w)};
                    }
                    const f32x4 gm00 = *(const f32x4*)mp_, gm01 = *(const f32x4*)(mp_ + 4), gm10 = *(const f32x4*)(mp_ + 128), gm11 = *(const f32x4*)(mp_ + 132);
                    {   const int m = 2 * mp;
                        const f32x4 x00 = r000 + gt00 * acc[ai][0][m][0], x01 = r001 + gt01 * acc[ai][0][m][1], x10 = r010 + gt10 * acc[ai][1][m][0], x11 = r011 + gt11 * acc[ai][1][m][1];
                        if (!dry) { *(GAS u32x4*)(xb + e0) = pack8(x00, x01); *(GAS u32x4*)(xb + e0 + 128) = pack8(x10, x11); }
                        if (gmn && !dry) { *(u32x4*)(xg + e0) = pack8(x00 * gm00, x01 * gm01); *(u32x4*)(xg + e0 + 128) = pack8(x10 * gm10, x11 * gm11); }
                        float q = sq8(x00, x01) + sq8(x10, x11); q = fq_sum(q);
                        if (fq == 0 && !dry) stout[(size_t)(rowb + ai * 128 + m * 16) * 16 + u.pn * 4 + wc] = q; }
                    {   const int m = 2 * mp + 1;
                        const f32x4 x00 = r100 + gt00 * acc[ai][0][m][0], x01 = r101 + gt01 * acc[ai][0][m][1], x10 = r110 + gt10 * acc[ai][1][m][0], x11 = r111 + gt11 * acc[ai][1][m][1];
                        if (!dry) { *(GAS u32x4*)(xb + e1) = pack8(x00, x01); *(GAS u32x4*)(xb + e1 + 128) = pack8(x10, x11); }
                        if (gmn && !dry) { *(u32x4*)(xg + e1) = pack8(x00 * gm00, x01 * gm01); *(u32x4*)(xg + e1 + 128) = pack8(x10 * gm10, x11 * gm11); }
                        float q = sq8(x00, x01) + sq8(x10, x11); q = fq_sum(q);
                        if (fq == 0 && !dry) stout[(size_t)(rowb + ai * 128 + m * 16) * 16 + u.pn * 4 + wc] = q; }
                }
            }
        } break;
        case K_FF1: {
            const GAS float* shw = (const GAS float*)(ws + WS_SHW2) + (size_t)l * NSLOT * DFF; const int ldshw = DFF;
            f32x4 sw[2][2];
#pragma unroll
            for (int bj = 0; bj < 2; ++bj) { const float* p = shw + (size_t)s * ldshw + u.pn * 256 + bj * 128 + colw; sw[bj][0] = *(const f32x4*)p; sw[bj][1] = *(const f32x4*)(p + 4); }
            bf16_t* dst = (bf16_t*)(ws + SPLIT(isctx, HID));
#pragma unroll
            for (int ai = 0; ai < 2; ++ai)
#pragma unroll
                for (int m = 0; m < 4; ++m) {
                    asm volatile("" ::: "memory");
                    const int row = rowb + ai * 128 + m * 16;
                    const float rs = tab[rl0 + ai * 128 + m * 16];
#pragma unroll
                    for (int bj = 0; bj < 2; ++bj) {
                        f32x4 v0 = acc[ai][bj][m][0] * rs + sw[bj][0], v1 = acc[ai][bj][m][1] * rs + sw[bj][1];
#pragma unroll
                        for (int j = 0; j < 4; ++j) { const float a = fmaxf(v0[j], 0.f), b = fmaxf(v1[j], 0.f); v0[j] = a * a; v1[j] = b * b; }
                        *(u32x4*)(dst + (size_t)row * DFF + u.pn * 256 + bj * 128 + colw) = pack8(v0, v1);
                    }
                }
        } break;
        default: break;
        }
    }
};

struct GList { size_t aoff, boff; int K, nM, nN, pm0, kind, l, n0, q0, q1; };
#define GL_(ao, bo, K_, nM_, nN_, pm0_, kind_, l_, n0_, q0_, q1_) do { g.aoff = (ao); g.boff = (bo); g.K = (K_); g.nM = (nM_); g.nN = (nN_); g.pm0 = (pm0_); g.kind = (kind_); g.l = (l_); g.n0 = (n0_); g.q0 = (q0_); g.q1 = (q1_); return true; } while (0)
__device__ __forceinline__ bool slot_list(int sub, int j, int l, GList& g) {
    const size_t oWIN = WS_WIN + (size_t)l * INP * DM * 2, oWUQ = WS_WUQ + (size_t)l * QW * QRANK * 2, oWKVF = WS_WKVF + (size_t)l * KVW * KVRANK * 2, oWKVC = WS_WKVC + (size_t)l * KVW * KVRANK * 2;
    const size_t oWOUT = WS_WOUT + (size_t)l * DM * DM * 2, oWF1 = WS_WF1 + (size_t)l * DFF * DM * 2, oWF2 = WS_WF2 + (size_t)l * DM * DFF * 2;
    switch (sub) {
    case -1: if (j == 0) GL_(WS_XG, oWIN, DM, 16, 6, 0, -1, 0, 12, 1, 0); break;
    case 0:  if (j == 0) GL_(WS_XG, oWIN, DM, 64, 6, 16, -1, l, 16, 2, 1);
             if (j == 1) GL_(CQ_C, oWUQ, QRANK, 16, 3, 0, K_Q, l, 16, 0, 1);
             if (j == 2) GL_(CKVR_C, oWKVF, KVRANK, 16, 4, 0, K_KV, l, 22, 0, 1); break;
    case 1:  if (j == 0) GL_(CQ_L, oWUQ, QRANK, 64, 3, 16, K_Q, l, 24, 1, 0);
             if (j == 1) GL_(CKVR_L, oWKVF, KVRANK, 64, 4, 16, K_KV, l, 32, 1, 0);
             if (j == 2) GL_(WS_CCKV + (size_t)l * NLATB * PAST * KVRANK * 2, oWKVC, KVRANK, 8, 4, 0, K_KVC, l, 4, 1, 0); break;
    case 2:  if (j == 0) GL_(YCAT_C, oWOUT, DM, 16, 4, 0, K_OUT, l, 8, 1, 0); break;
    case 3:  if (j == 0) GL_(YCAT_L, oWOUT, DM, 64, 4, 16, K_OUT, l, 32, 1, 0);
             if (j == 1) GL_(WS_XG, oWF1, DM, 16, 16, 0, K_FF1, l, 32, 1, 0); break;
    case 4:  if (j == 0) GL_(HID_C, oWF2, DFF, 16, 4, 0, K_FF2, l, 8, 1, 0);
             if (j == 1) GL_(WS_XG, oWF1, DM, 64, 16, 16, K_FF1, l, 8, 1, -5); break;
    default: if (j == 0) GL_(HID_L, oWF2, DFF, 64, 4, 16, K_FF2, l, 32, 1, 0);
             if (j == 1 && l + 1 < DEPTH) GL_(WS_XG, oWIN + (size_t)INP * DM * 2, DM, 16, 6, 0, -1, l + 1, 12, 1, 0); break;
    }
    return false;
}
#undef GL_
struct SchedSlot {
    const GAS unsigned char* ws; int c, G, sub, l;
    __device__ __forceinline__ bool next(int i, GUnit& u) const {
        int k = i;
        const int x = c >> 5, li = c & 31;
#pragma unroll
        for (int j = 0; j < 3; ++j) {
            GList g; if (!slot_list(sub, (sub == 3 && (c & 1)) ? (j ^ 1) : j, l, g)) { if (sub == 3 && j < 2) continue; return false; }
            int pm, pn; bool hit = false;
            if (G == 256) {
                const int rM = g.nM >> 3, n = rM * g.nN;
                if (g.q1 < 0) {
                    const int qa = -g.q1, t = li - g.n0, qe = li < g.n0 ? g.q0 : qa;
                    if (k < qe) { pm = g.pm0 + rM * x + (li < g.n0 ? li % rM : t % rM); pn = li < g.n0 ? ((32 - g.n0) / rM) * qa + li / rM : (t / rM) * qa + k; hit = true; } else k -= qe;
                } else {
                const int q = li < g.n0 ? g.q0 : g.q1, start = li < g.n0 ? li * g.q0 : g.n0 * g.q0 + (li - g.n0) * g.q1;
                int qe = n - start; qe = qe < 0 ? 0 : (qe < q ? qe : q);
                if (k < qe) { const int lidx = start + k; pm = g.pm0 + rM * x + (lidx % rM); pn = lidx / rM; hit = true; } else k -= qe;
                }
            } else {
                const int n = g.nM * g.nN, q = (n + G - 1) / G, start = c * q;
                int qe = n - start; qe = qe < 0 ? 0 : (qe < q ? qe : q);
                if (k < qe) { const int idx = start + k; pm = g.pm0 + idx % g.nM; pn = idx / g.nM; hit = true; } else k -= qe;
            }
            if (hit) { u.A = (unsigned)(g.aoff + (size_t)pm * 256 * g.K * 2); u.B = (unsigned)(g.boff + (size_t)pn * 256 * g.K * 2); u.K = g.K; u.pm = pm; u.pn = pn; u.kind = g.kind < 0 ? pn : g.kind; u.l = g.l; return true; }
        }
        return false;
    }
};

#define KSWZ(row, colB) ((row) * 256 + ((colB) ^ (((row) & 15) << 4)))
#define KRSWZ(row, colB) ((row) * 128 + ((colB) ^ ((((row) >> 1) & 7) << 4)))
__device__ __forceinline__ int crow(int r, int hi) { return (r & 3) + 8 * (r >> 2) + 4 * hi; }
__device__ __forceinline__ int v_rd_base(int lane) { return ((lane & 3) << 3) | (((lane >> 2) & 3) << 6) | (((lane >> 4) & 1) << 5) | (((lane >> 5) & 1) << 8); }
constexpr int v_rd_off(int d0, int ks, int half) { return d0 * 512 + ks * 4096 + half * 2048; }
template <int OFF> __device__ __forceinline__ s16x4 tr_read(int vb) { s16x4 r; asm volatile("ds_read_b64_tr_b16 %0, %1 offset:%2" : "=&v"(r) : "v"(vb), "i"(OFF) : "memory"); return r; }
struct VFrag { s16x4 l0, h0, l1, h1, l2, h2, l3, h3; };
template <int D0> __device__ __forceinline__ void pv_read(VFrag& f, int vb) {
    f.l0 = tr_read<v_rd_off(D0, 0, 0)>(vb); f.h0 = tr_read<v_rd_off(D0, 0, 1)>(vb); f.l1 = tr_read<v_rd_off(D0, 1, 0)>(vb); f.h1 = tr_read<v_rd_off(D0, 1, 1)>(vb);
    f.l2 = tr_read<v_rd_off(D0, 2, 0)>(vb); f.h2 = tr_read<v_rd_off(D0, 2, 1)>(vb); f.l3 = tr_read<v_rd_off(D0, 3, 0)>(vb); f.h3 = tr_read<v_rd_off(D0, 3, 1)>(vb);
}
__device__ __forceinline__ void pv_wait(VFrag& f) {
    asm volatile("s_waitcnt lgkmcnt(0)" : "+v"(f.l0), "+v"(f.h0), "+v"(f.l1), "+v"(f.h1), "+v"(f.l2), "+v"(f.h2), "+v"(f.l3), "+v"(f.h3) :: "memory"); SBAR();
}
__device__ __forceinline__ void pv_mma(f32x16& od, const VFrag& f, bf16x8 pa0, bf16x8 pa1, bf16x8 pa2, bf16x8 pa3) {
#define PK(L, H) (bf16x8){L[0], L[1], L[2], L[3], H[0], H[1], H[2], H[3]}
    od = __builtin_amdgcn_mfma_f32_32x32x16_bf16(pa0, PK(f.l0, f.h0), od, 0, 0, 0);
    od = __builtin_amdgcn_mfma_f32_32x32x16_bf16(pa1, PK(f.l1, f.h1), od, 0, 0, 0);
    od = __builtin_amdgcn_mfma_f32_32x32x16_bf16(pa2, PK(f.l2, f.h2), od, 0, 0, 0);
    od = __builtin_amdgcn_mfma_f32_32x32x16_bf16(pa3, PK(f.l3, f.h3), od, 0, 0, 0);
#undef PK
}
constexpr int A_V = 0, A_KN = 32768, A_KR = 65536, A_WS = 81920, A_OST = 0;
constexpr float ATT_THR = 6.0f;
__device__ __forceinline__ void attn_unit(LAS unsigned char* ldsb, const GAS bf16_t* __restrict__ Qb, const GAS bf16_t* __restrict__ Kh, const GAS bf16_t* __restrict__ Vh, GAS bf16_t* __restrict__ Ob, int seq) {
    int tid_ = threadIdx.x; asm volatile("" : "+v"(tid_));
    const int tid = tid_, wid = __builtin_amdgcn_readfirstlane(tid >> 6), lane = tid & 63, r32 = lane & 31, hi = lane >> 5;
    char* lds = (char*)ldsb;
    char* Kn_lds = lds + A_KN; char* Kr_lds = lds + A_KR;
    float* wsf = (float*)(lds + A_WS) + wid * 64; float* li_l = wsf; float* al_l = wsf + 32;
    float m_reg = -1e30f, l_reg = 0.f; f32x16 o[4] = {}; bf16x8 qr[12];
    const GAS bf16_t* Qw = Qb + (size_t)(wid * 32 + r32) * QW + hi * 8;
#pragma unroll
    for (int d0 = 0; d0 < 12; ++d0) qr[d0] = *(const GAS bf16x8*)(Qw + d0 * 16);
#pragma unroll
    for (int d0 = 0; d0 < 12; ++d0) asm volatile("" : "+v"(qr[d0]));
    unsigned gk0, gk1, gkr, gv0, gv1;
    { int r = 4 * wid + (lane >> 4), c = (lane & 15) ^ (r & 15); gk0 = (unsigned)(r * 192 + c * 8);
      r = 4 * (wid + 8) + (lane >> 4); c = (lane & 15) ^ (r & 15); gk1 = (unsigned)(r * 192 + c * 8);
      r = 8 * wid + (lane >> 3); c = (lane & 7) ^ ((r >> 1) & 7); gkr = (unsigned)(r * 192 + 128 + c * 8);
      int p = wid, kk = (p >> 1) * 8 + ((lane & 31) >> 2), k = (kk & ~0xC) | ((kk & 4) << 1) | ((kk & 8) >> 1); gv0 = (unsigned)(k * 128 + (2 * (p & 1) + (lane >> 5)) * 32 + (lane & 3) * 8);
      p = wid + 8; kk = (p >> 1) * 8 + ((lane & 31) >> 2); k = (kk & ~0xC) | ((kk & 4) << 1) | ((kk & 8) >> 1); gv1 = (unsigned)(k * 128 + (2 * (p & 1) + (lane >> 5)) * 32 + (lane & 3) * 8); }
    const int vb0 = (int)(uintptr_t)(lds + A_V) + v_rd_base(lane);
#define ADMA(k0, b) do { const GAS bf16_t* kt = Kh + (size_t)(k0) * 192; const GAS bf16_t* vt = Vh + (size_t)(k0) * 128; \
        __builtin_amdgcn_global_load_lds((const GAS unsigned*)(kt + gk0), (LAS unsigned*)(ldsb + A_KN + (b) * 16384 + wid * 1024), 16, 0, 0); \
        __builtin_amdgcn_global_load_lds((const GAS unsigned*)(kt + gk1), (LAS unsigned*)(ldsb + A_KN + (b) * 16384 + (wid + 8) * 1024), 16, 0, 0); \
        __builtin_amdgcn_global_load_lds((const GAS unsigned*)(kt + gkr), (LAS unsigned*)(ldsb + A_KR + (b) * 8192 + wid * 1024), 16, 0, 0); \
        __builtin_amdgcn_global_load_lds((const GAS unsigned*)(vt + gv0), (LAS unsigned*)(ldsb + A_V + (b) * 16384 + wid * 1024), 16, 0, 0); \
        __builtin_amdgcn_global_load_lds((const GAS unsigned*)(vt + gv1), (LAS unsigned*)(ldsb + A_V + (b) * 16384 + (wid + 8) * 1024), 16, 0, 0); } while (0)
#define AWAITBAR() do { asm volatile("s_waitcnt vmcnt(0) lgkmcnt(0)" ::: "memory"); __builtin_amdgcn_s_barrier(); asm volatile("" ::: "memory"); } while (0)
    const int NT = seq / 64;
    ADMA(0, 0); AWAITBAR();
    for (int j = 0; j < NT; ++j) {
        const int cb = j & 1;
        if (j + 1 < NT) ADMA((j + 1) * 64, cb ^ 1);
        f32x16 p0 = {}, p1 = {};
        { const char* Kn = Kn_lds + cb * 16384; const char* Kr = Kr_lds + cb * 8192;
#define KFRAG(G, I, ROWOFF) ((G) < 4 ? *(const bf16x8*)(Kn + KSWZ((ROWOFF) + r32, ((2 * (G) + (I)) * 16 + hi * 8) * 2)) : *(const bf16x8*)(Kr + KRSWZ((ROWOFF) + r32, ((2 * ((G) - 4) + (I)) * 16 + hi * 8) * 2)))
#define KLOADG(G, X0, X1, Y0, Y1) do { X0 = KFRAG(G, 0, 0); Y0 = KFRAG(G, 0, 32); X1 = KFRAG(G, 1, 0); Y1 = KFRAG(G, 1, 32); } while (0)
#define KPIN(X0, X1, Y0, Y1) asm volatile("" : "+v"(X0), "+v"(Y0), "+v"(X1), "+v"(Y1))
#define KMMAG(G, X0, X1, Y0, Y1) do { \
              p0 = __builtin_amdgcn_mfma_f32_32x32x16_bf16(X0, qr[2 * (G)], p0, 0, 0, 0); p1 = __builtin_amdgcn_mfma_f32_32x32x16_bf16(Y0, qr[2 * (G)], p1, 0, 0, 0); \
              p0 = __builtin_amdgcn_mfma_f32_32x32x16_bf16(X1, qr[2 * (G) + 1], p0, 0, 0, 0); p1 = __builtin_amdgcn_mfma_f32_32x32x16_bf16(Y1, qr[2 * (G) + 1], p1, 0, 0, 0); } while (0)
          bf16x8 fa0, fa1, fb0, fb1, ga0, ga1, gb0, gb1;
          KLOADG(0, fa0, fa1, fb0, fb1); SBAR(); KPIN(fa0, fa1, fb0, fb1); SBAR();
          KLOADG(1, ga0, ga1, gb0, gb1); SBAR(); KMMAG(0, fa0, fa1, fb0, fb1); SBAR(); KPIN(ga0, ga1, gb0, gb1); SBAR();
          KLOADG(2, fa0, fa1, fb0, fb1); SBAR(); KMMAG(1, ga0, ga1, gb0, gb1); SBAR(); KPIN(fa0, fa1, fb0, fb1); SBAR();
          KLOADG(3, ga0, ga1, gb0, gb1); SBAR(); KMMAG(2, fa0, fa1, fb0, fb1); SBAR(); KPIN(ga0, ga1, gb0, gb1); SBAR();
          KLOADG(4, fa0, fa1, fb0, fb1); SBAR(); KMMAG(3, ga0, ga1, gb0, gb1); SBAR(); KPIN(fa0, fa1, fb0, fb1); SBAR();
          KLOADG(5, ga0, ga1, gb0, gb1); SBAR(); KMMAG(4, fa0, fa1, fb0, fb1); SBAR(); KPIN(ga0, ga1, gb0, gb1); SBAR();
          KMMAG(5, ga0, ga1, gb0, gb1); SBAR();
#undef KPIN
#undef KFRAG
#undef KLOADG
#undef KMMAG
        }
        float pmax = p0[0];
#pragma unroll
        for (int r = 1; r < 16; ++r) pmax = fmaxf(pmax, p0[r]);
#pragma unroll
        for (int r = 0; r < 16; ++r) pmax = fmaxf(pmax, p1[r]);
        { auto rr = __builtin_amdgcn_permlane32_swap(__float_as_uint(pmax), __float_as_uint(pmax), false, false); pmax = fmaxf(__uint_as_float(rr[0]), __uint_as_float(rr[1])); }
        float alpha = 1.f;
        if (!__all(pmax - m_reg <= ATT_THR)) { const float mn = fmaxf(m_reg, pmax); alpha = __builtin_amdgcn_exp2f(m_reg - mn); m_reg = mn; }
        float ps = 0.f;
#pragma unroll
        for (int r = 0; r < 16; ++r) { p0[r] = __builtin_amdgcn_exp2f(p0[r] - m_reg); p1[r] = __builtin_amdgcn_exp2f(p1[r] - m_reg); ps += p0[r] + p1[r]; }
        { auto rr = __builtin_amdgcn_permlane32_swap(__float_as_uint(ps), __float_as_uint(ps), false, false); ps = __uint_as_float(rr[0]) + __uint_as_float(rr[1]); }
        l_reg = l_reg * alpha + ps;
        bf16x8 pa0, pa1, pa2, pa3;
#define PK4(P, BASE, OUT) do { unsigned a0 = cvt_pk_bf16(P[BASE + 0], P[BASE + 1]), a1 = cvt_pk_bf16(P[BASE + 2], P[BASE + 3]);   \
        unsigned b0 = cvt_pk_bf16(P[BASE + 4], P[BASE + 5]), b1 = cvt_pk_bf16(P[BASE + 6], P[BASE + 7]);                              \
        auto r0 = __builtin_amdgcn_permlane32_swap(a0, b0, false, false); auto r1 = __builtin_amdgcn_permlane32_swap(a1, b1, false, false); \
        u32x4 w = {r0[0], r1[0], r0[1], r1[1]}; OUT = *reinterpret_cast<bf16x8*>(&w); } while (0)
        PK4(p0, 0, pa0); PK4(p0, 8, pa1); PK4(p1, 0, pa2); PK4(p1, 8, pa3);
#undef PK4
        if (__any(alpha < 1.f)) { if (hi == 0) al_l[r32] = alpha; LDS_WAIT();
#pragma unroll
            for (int d = 0; d < 4; ++d)
#pragma unroll
                for (int r = 0; r < 16; ++r) o[d][r] *= al_l[crow(r, hi)]; }
        { const int vb = vb0 + cb * 16384;
          VFrag va, vc;
          pv_read<0>(va, vb); pv_wait(va);
          pv_read<1>(vc, vb); SBAR(); pv_mma(o[0], va, pa0, pa1, pa2, pa3); SBAR(); pv_wait(vc);
          pv_read<2>(va, vb); SBAR(); pv_mma(o[1], vc, pa0, pa1, pa2, pa3); SBAR(); pv_wait(va);
          pv_read<3>(vc, vb); SBAR(); pv_mma(o[2], va, pa0, pa1, pa2, pa3); SBAR(); pv_wait(vc);
          pv_mma(o[3], vc, pa0, pa1, pa2, pa3); SBAR(); }
        AWAITBAR();
    }
#undef ADMA
#undef AWAITBAR
    if (hi == 0) li_l[r32] = l_reg; LDS_WAIT();
    float rli[16];
#pragma unroll
    for (int r = 0; r < 16; ++r) rli[r] = __builtin_amdgcn_rcpf(li_l[crow(r, hi)]);
    bf16_t* stg = (bf16_t*)(lds + A_OST) + wid * 4096;
#pragma unroll
    for (int r = 0; r < 16; ++r) { const int orow = crow(r, hi);
#pragma unroll
        for (int d0 = 0; d0 < 4; ++d0) stg[orow * 128 + d0 * 32 + r32] = f2bf(o[d0][r] * rli[r]); }
    LDS_WAIT();
#pragma unroll
    for (int i = 0; i < 8; ++i) { const int id = lane + 64 * i, row = id >> 4, ch = id & 15; const u32x4 v = *(const u32x4*)(stg + row * 128 + ch * 8); *(GAS u32x4*)(Ob + (size_t)(wid * 32 + row) * DM + ch * 8) = v; }
    LDS_WAIT();
    __syncthreads();
}

__device__ __forceinline__ void pool_unit(const Ctx& F, int l, int pm, int g0, int g1) {
    char* lds = (char*)F.lds;
    int tid_ = threadIdx.x; asm volatile("" : "+v"(tid_));
    const int tid = tid_, lane = tid & 63, wid = __builtin_amdgcn_readfirstlane(tid >> 6), fr = lane & 15, fq = lane >> 4;
    const bool isctx0 = pm < 16;
    const bf16_t* HP = wsp<const bf16_t>(F, SPLIT(isctx0, HP)); bf16_t* Y = wsp<bf16_t>(F, SPLIT(isctx0, YCAT));
    const bf16_t* WPT = wsp<const bf16_t>(F, WS_WPT) + (size_t)l * 4 * 4096;
    const float* pscale = GIN(11) + (size_t)l * 256;
    const int row0 = pm * 256; const bool isctx = pm < 16;
    const int L = isctx ? LCTX : LLAT, t0 = isctx ? 0 : ((pm - 16) & 7) * 256, seq0 = row0 - t0;
    bf16_t* hbuf = (bf16_t*)lds; bf16_t* abuf = (bf16_t*)(lds + 36864);
    for (int g = g0; g < g1; ++g) {
        const int w = 2 << g, hw = w >> 1;
        u32x4 hv[5];
#pragma unroll
        for (int i = 0; i < 5; ++i) { const int id = tid + 512 * i, rr = id >> 3, ch = id & 7, t = t0 - 8 + rr;
            hv[i] = (u32x4){0u, 0u, 0u, 0u}; if (id < 272 * 8 && t >= 0 && t < L) hv[i] = *(const u32x4*)(HP + (size_t)(seq0 + t) * 256 + g * 64 + ch * 8); }
        bf16x8 xa[2][4]; f32x4 psc[4];
#pragma unroll
        for (int ks = 0; ks < 2; ++ks)
#pragma unroll
            for (int nb = 0; nb < 4; ++nb) xa[ks][nb] = *(const bf16x8*)(WPT + (size_t)g * 4096 + (nb * 16 + fr) * 64 + ks * 32 + fq * 8);
#pragma unroll
        for (int nb = 0; nb < 4; ++nb) psc[nb] = *(const f32x4*)(pscale + g * 64 + nb * 16 + 4 * fq);
#pragma unroll
        for (int i = 0; i < 5; ++i) { const int id = tid + 512 * i, rr = id >> 3, ch = id & 7; if (id < 272 * 8) *(u32x4*)(hbuf + rr * 64 + ch * 8) = hv[i]; }
        __syncthreads();
#pragma unroll
        for (int it = 0; it < 4; ++it) { const int id = tid + 512 * it, tt = id >> 3, ch = id & 7, t = t0 + tt;
            const int lo = max(t - hw, 0), hiw = min(t + hw, L); float s[8] = {0, 0, 0, 0, 0, 0, 0, 0};
            for (int dq = -hw; dq < hw; ++dq) { const int q = t + dq; if (q >= lo && q < hiw) { const u32x4 v = *(const u32x4*)(hbuf + (tt + dq + 8) * 64 + ch * 8);
                s[0] += bf_lo(v.x); s[1] += bf_hi(v.x); s[2] += bf_lo(v.y); s[3] += bf_hi(v.y); s[4] += bf_lo(v.z); s[5] += bf_hi(v.z); s[6] += bf_lo(v.w); s[7] += bf_hi(v.w); } }
            const float ic = __builtin_amdgcn_rcpf((float)(hiw - lo)); const u32x4 c = *(const u32x4*)(hbuf + (tt + 8) * 64 + ch * 8);
            u32x4 o; o.x = cvt_pk_bf16(s[0] * ic - bf_lo(c.x), s[1] * ic - bf_hi(c.x)); o.y = cvt_pk_bf16(s[2] * ic - bf_lo(c.y), s[3] * ic - bf_hi(c.y));
            o.z = cvt_pk_bf16(s[4] * ic - bf_lo(c.z), s[5] * ic - bf_hi(c.z)); o.w = cvt_pk_bf16(s[6] * ic - bf_lo(c.w), s[7] * ic - bf_hi(c.w));
            *(u32x4*)(abuf + tt * 64 + ch * 8) = o; }
        __syncthreads();
        f32x4 acc[2][4];
#pragma unroll
        for (int mb = 0; mb < 2; ++mb)
#pragma unroll
            for (int nb = 0; nb < 4; ++nb) acc[mb][nb] = (f32x4){0.f, 0.f, 0.f, 0.f};
#pragma unroll
        for (int ks = 0; ks < 2; ++ks) {
            bf16x8 ya[2];
#pragma unroll
            for (int mb = 0; mb < 2; ++mb) ya[mb] = *(const bf16x8*)(abuf + (wid * 32 + mb * 16 + fr) * 64 + ks * 32 + fq * 8);
#pragma unroll
            for (int mb = 0; mb < 2; ++mb)
#pragma unroll
                for (int nb = 0; nb < 4; ++nb) acc[mb][nb] = __builtin_amdgcn_mfma_f32_16x16x32_bf16(xa[ks][nb], ya[mb], acc[mb][nb], 0, 0, 0);
        }
#pragma unroll
        for (int mb = 0; mb < 2; ++mb)
#pragma unroll
            for (int nb = 0; nb < 4; ++nb) { const int d = nb * 16 + 4 * fq; const f32x4 v = acc[mb][nb] * psc[nb];
                u32x2 o; o.x = cvt_pk_bf16(v[0], v[1]); o.y = cvt_pk_bf16(v[2], v[3]);
                *(u32x2*)(Y + (size_t)(row0 + wid * 32 + mb * 16 + fr) * DM + g * 64 + d) = o; }
        __syncthreads();
    }
}

__device__ __forceinline__ void gmlp_unit(const Ctx& F, int l, int chunk) {
    char* lds = (char*)F.lds;
    int tid_ = threadIdx.x; asm volatile("" : "+v"(tid_));
    const int tid = tid_, lane = tid & 63, wid = __builtin_amdgcn_readfirstlane(tid >> 6), fr = lane & 15, fq = lane >> 4;
    const bool isctx0 = chunk < 32;
    const bf16_t* GL = wsp<const bf16_t>(F, SPLIT(isctx0, GL)); const bf16_t* U = wsp<const bf16_t>(F, SPLIT(isctx0, U)); bf16_t* Y = wsp<bf16_t>(F, SPLIT(isctx0, YCAT));
    const float* STG = wsp<const float>(F, WS_STG);
    const bf16_t* WSB = wsp<const bf16_t>(F, WS_WSB) + (size_t)l * 4 * 16384;
    const float* gsgu = GIN(16) + (size_t)l * 256; const float* bs = GIN(18) + (size_t)l * 4 * 128;
    const int r0 = chunk * 128;
    float* rsg = (float*)lds; bf16_t* vT = (bf16_t*)(lds + 1024); constexpr int LDT = 136, VTG = 64 * LDT;
    u32x4 gv[4][2]; f32x4 g0v[4][2], g1v[4][2]; u32x2 uu[4][4]; float bp[4];
#pragma unroll
    for (int g = 0; g < 4; ++g)
#pragma unroll
        for (int i = 0; i < 2; ++i) { const int id = tid + 512 * i, q = id >> 3, cc = (id & 7) * 8;
            gv[g][i] = *(const u32x4*)(GL + (size_t)(r0 + q) * 256 + g * 64 + cc); g0v[g][i] = *(const f32x4*)(gsgu + g * 64 + cc); g1v[g][i] = *(const f32x4*)(gsgu + g * 64 + cc + 4); }
    const int p = wid * 16 + fr;
#pragma unroll
    for (int g = 0; g < 4; ++g) { bp[g] = bs[g * 128 + p];
#pragma unroll
        for (int nb = 0; nb < 4; ++nb) uu[g][nb] = *(const u32x2*)(U + (size_t)(r0 + p) * 256 + g * 64 + nb * 16 + 4 * fq); }
    if (tid < 128) { const f32x4 t = *(const f32x4*)(STG + (size_t)(r0 + tid) * 4); rsg[tid] = fast_rsqrt(sum4(t) * (1.0f / 256.0f) + EPS); }
    __syncthreads();
#pragma unroll
    for (int g = 0; g < 4; ++g)
#pragma unroll
        for (int i = 0; i < 2; ++i) { const int id = tid + 512 * i, q = id >> 3, cc = (id & 7) * 8; const float rs = rsg[q]; bf16_t* vt = vT + g * VTG; const u32x4 v = gv[g][i]; const f32x4 g0 = g0v[g][i], g1 = g1v[g][i];
            vt[(cc + 0) * LDT + q] = f2bf(bf_lo(v.x) * rs * g0[0]); vt[(cc + 1) * LDT + q] = f2bf(bf_hi(v.x) * rs * g0[1]);
            vt[(cc + 2) * LDT + q] = f2bf(bf_lo(v.y) * rs * g0[2]); vt[(cc + 3) * LDT + q] = f2bf(bf_hi(v.y) * rs * g0[3]);
            vt[(cc + 4) * LDT + q] = f2bf(bf_lo(v.z) * rs * g1[0]); vt[(cc + 5) * LDT + q] = f2bf(bf_hi(v.z) * rs * g1[1]);
            vt[(cc + 6) * LDT + q] = f2bf(bf_lo(v.w) * rs * g1[2]); vt[(cc + 7) * LDT + q] = f2bf(bf_hi(v.w) * rs * g1[3]); }
    __syncthreads();
#pragma unroll
    for (int g = 0; g < 4; ++g) {
        bf16x8 ya[4];
#pragma unroll
        for (int ks = 0; ks < 4; ++ks) ya[ks] = *(const bf16x8*)(WSB + (size_t)g * 16384 + (wid * 16 + fr) * 128 + ks * 32 + fq * 8);
        f32x4 acc[4];
#pragma unroll
        for (int nb = 0; nb < 4; ++nb) acc[nb] = (f32x4){0.f, 0.f, 0.f, 0.f};
#pragma unroll
        for (int ks = 0; ks < 4; ++ks)
#pragma unroll
            for (int nb = 0; nb < 4; ++nb) { const bf16x8 xa = *(const bf16x8*)(vT + g * VTG + (nb * 16 + fr) * LDT + ks * 32 + fq * 8);
                acc[nb] = __builtin_amdgcn_mfma_f32_16x16x32_bf16(xa, ya[ks], acc[nb], 0, 0, 0); }
#pragma unroll
        for (int nb = 0; nb < 4; ++nb) { const int c = nb * 16 + 4 * fq; const u32x2 u2 = uu[g][nb];
            u32x2 o; o.x = cvt_pk_bf16(bf_lo(u2.x) * (acc[nb][0] + bp[g]), bf_hi(u2.x) * (acc[nb][1] + bp[g])); o.y = cvt_pk_bf16(bf_lo(u2.y) * (acc[nb][2] + bp[g]), bf_hi(u2.y) * (acc[nb][3] + bp[g]));
            *(u32x2*)(Y + (size_t)(r0 + p) * DM + 768 + g * 64 + c) = o; }
    }
    __syncthreads();
}

enum MapKind { MAP_ID = 0, MAP_WIN = 1, MAP_WUQ = 2 };
__device__ __forceinline__ int colmap(int kind, int n) {
    if (kind == MAP_ID) return n;
    if (kind == MAP_WIN) {
        if (n < 256) return n;
        if (n < 512) return 640 + (n - 256);
        if (n < 768) return 960 + (n - 512);
        if (n < 1024) return 1216 + (n - 768);
        if (n < 1280) return 256 + (n - 1024);
        if (n < 1408) return 512 + (n - 1280);
        if (n < 1472) { const int p = n - 1408, i = p >> 1; return (p & 1) ? 896 + 32 + i : 896 + i; }
        return -1;
    }
    { const int hh = n / 192, w = n % 192; if (w < 128) return hh * 192 + w; const int p = w - 128, i = p >> 1; return hh * 192 + 128 + ((p & 1) ? 32 + i : i); }
}
template <bool WTHRU = false>
__device__ __forceinline__ void transpose_item(const float* W, int K, int Nsrc, int Ndst, bf16_t* WT, int mapk, const float* kscale, LAS float* scr, int item, int lane) {
    const int nblk = Ndst / 64, kb = item / nblk, nb = item % nblk, k0 = 64 * kb, n0 = 64 * nb;
    const int srcA = colmap(mapk, n0 + (lane & 31)), srcB = colmap(mapk, n0 + 32 + (lane & 31));
    float tvA[32], tvB[32];
    const int sa = srcA >= 0 ? srcA : 0, sb = srcB >= 0 ? srcB : 0;
#pragma unroll
    for (int i = 0; i < 32; ++i) { const int kk = 2 * i + (lane >> 5); tvA[i] = W[(size_t)(k0 + kk) * Nsrc + sa]; }
#pragma unroll
    for (int i = 0; i < 32; ++i) { const int kk = 2 * i + (lane >> 5); tvB[i] = W[(size_t)(k0 + kk) * Nsrc + sb]; }
    if (kscale) {
#pragma unroll
        for (int i = 0; i < 32; ++i) { const float ks = kscale[k0 + 2 * i + (lane >> 5)]; tvA[i] *= ks; tvB[i] *= ks; } }
    const int c = lane & 7;
#pragma unroll
    for (int h = 0; h < 2; ++h) {
#pragma unroll
        for (int i = 0; i < 32; ++i) { const int kk = 2 * i + (lane >> 5); scr[kk * 33 + (lane & 31)] = h == 0 ? (srcA >= 0 ? tvA[i] : 0.f) : (srcB >= 0 ? tvB[i] : 0.f); }
        LDS_WAIT(); asm volatile("" ::: "memory");
#pragma unroll
        for (int j = 0; j < 4; ++j) { const int n = (lane >> 3) + 8 * j; const LAS float* sp = scr + (8 * c) * 33 + n;
            u32x4 o; o.x = cvt_pk_bf16(sp[0 * 33], sp[1 * 33]); o.y = cvt_pk_bf16(sp[2 * 33], sp[3 * 33]); o.z = cvt_pk_bf16(sp[4 * 33], sp[5 * 33]); o.w = cvt_pk_bf16(sp[6 * 33], sp[7 * 33]);
            bf16_t* dp = WT + (size_t)(n0 + 32 * h + n) * K + k0 + 8 * c;
            if (WTHRU) asm volatile("global_store_dwordx4 %0, %1, off sc0 sc1" :: "v"((GAS u32x4*)dp), "v"(o) : "memory");
            else *(u32x4*)dp = o; }
        LDS_WAIT(); asm volatile("" ::: "memory");
    }
}
__device__ __forceinline__ float silu(float x) { return x / (1.0f + __expf(-x)); }

__device__ __forceinline__ void phase_p0a(const Ctx& F, int part = 0, int widx = 0) {
    LAS float* scr = (LAS float*)(F.lds + F.wave * 16384);
    const int gw = F.vcu * 8 + F.wave, NGW = F.G * 8, lane = F.lane;
    constexpr int I_WIN = (DM / 64) * (INP / 64), I_WUQ = (QRANK / 64) * (QW / 64), I_WKV = (KVRANK / 64) * (KVW / 64), I_WOUT = (DM / 64) * (DM / 64), I_WF1 = (DM / 64) * (DFF / 64), I_WF2 = (DFF / 64) * (DM / 64), I_WP = 1;
    constexpr int PER_L = I_WIN + I_WUQ + 2 * I_WKV + I_WOUT + I_WF1 + I_WF2 + 4 * I_WP;
    constexpr int N_T = DEPTH * PER_L, N_MOD = 96 * 16, N_WS = (DEPTH * 4 * 128 * 128) / 512, N_CK = (DEPTH * NLATB * PAST * KVRANK) / 512, N_ROPE = 16;
    constexpr int NITEMS = N_MOD + N_T + N_WS + N_CK + N_ROPE;
    const bool spread = (F.G == 256);
    volatile LAS unsigned* MISCq = (volatile LAS unsigned*)(F.lds + MISC_OFF);
    if (F.tid == 0) MISCq[40] = 0u;
    __syncthreads();
    constexpr int NB_L = I_WUQ + 2 * I_WKV + I_WOUT + 4 * I_WP, NB_G = I_WUQ + 2 * I_WKV + I_WOUT, NFF = I_WF1 + I_WF2, NFFL = DEFER_FF ? 1 : DEPTH;
    bool first = true;
    for (int it = gw; ; it += NGW) {
        int r;
        if (spread) {
            if (part == 0 && first && F.wave < 6) r = F.vcu * 6 + F.wave;
            else { unsigned j = 0u; if (lane == 0) j = __hip_atomic_fetch_add((LAS unsigned*)(F.lds + MISC_OFF) + 40, 1u, __ATOMIC_RELAXED, __HIP_MEMORY_SCOPE_WORKGROUP);
                   j = (unsigned)__builtin_amdgcn_readfirstlane((int)j);
                   int d = part == 0 ? F.vcu + (int)j * F.G : widx + (int)j * 160; r = -1;
                   if (part == 0) { if (d < DEPTH * I_WIN) r = N_MOD + (d / I_WIN) * PER_L + d % I_WIN; else if (d < DEPTH * I_WIN + N_ROPE) r = NITEMS - N_ROPE + (d - DEPTH * I_WIN); }
                   else { if (d < DEPTH * NB_L) { const int q = d % NB_L; r = N_MOD + (d / NB_L) * PER_L + I_WIN + (q < NB_G ? q : q + NFF); }
                          else if ((d -= DEPTH * NB_L) < NFFL * NFF) r = N_MOD + (d / NFF) * PER_L + I_WIN + NB_G + d % NFF;
                          else if ((d -= NFFL * NFF) < N_WS + N_CK) r = N_MOD + N_T + d; }
                   if (r < 0) break; }
            first = false;
        } else { if (part != 0) break; r = it; if (r >= NITEMS) break; }
        if (r < N_MOD) {
            const int cg = r >> 4, kc = r & 15, n = cg * 256 + lane * 4, l = n / MODW, nn = n % MODW;
            { float cv[NSLOT]; const int k = kc * 64 + lane;
#pragma unroll
              for (int s = 0; s < NSLOT; ++s) cv[s] = (s == 0) ? GIN(5)[k] : GIN(4)[(size_t)(s - 1) * DM + k];
#pragma unroll
              for (int s = 0; s < NSLOT; ++s) scr[s * 64 + lane] = silu(cv[s]); }
            LDS_WAIT(); asm volatile("" ::: "memory");
            f32x4 a[NSLOT];
#pragma unroll
            for (int s = 0; s < NSLOT; ++s) a[s] = (f32x4){0.f, 0.f, 0.f, 0.f};
            const float* wp = GIN(6) + ((size_t)l * DM + kc * 64) * MODW + nn;
#pragma unroll 32
            for (int kk = 0; kk < 64; ++kk) { const f32x4 w = *(const f32x4*)(wp + (size_t)kk * MODW);
#pragma unroll
                for (int s = 0; s < NSLOT; ++s) a[s] += w * scr[s * 64 + kk]; }
            float* mp = wsp<float>(F, WS_MODP);
#pragma unroll
            for (int s = 0; s < NSLOT; ++s) *(f32x4*)(mp + ((size_t)(kc * NSLOT + s)) * (DEPTH * MODW) + n) = a[s];
            LDS_WAIT(); asm volatile("" ::: "memory");
            continue;
        }
        r -= N_MOD;
        if (r < N_T) {
            const int l = r / PER_L; int q = r % PER_L;
            if (q < I_WIN) { transpose_item(GIN(9) + (size_t)l * DM * INW, DM, INW, INP, wsp<bf16_t>(F, WS_WIN) + (size_t)l * INP * DM, MAP_WIN, nullptr, scr, q, lane); continue; } q -= I_WIN;
            if (q < I_WUQ) { transpose_item(GIN(13) + (size_t)l * QRANK * QW, QRANK, QW, QW, wsp<bf16_t>(F, WS_WUQ) + (size_t)l * QW * QRANK, MAP_WUQ, GIN(12) + (size_t)l * QRANK, scr, q, lane); continue; } q -= I_WUQ;
            if (q < I_WKV) { transpose_item(GIN(15) + (size_t)l * KVRANK * KVW, KVRANK, KVW, KVW, wsp<bf16_t>(F, WS_WKVF) + (size_t)l * KVW * KVRANK, MAP_ID, GIN(14) + (size_t)l * KVRANK, scr, q, lane); continue; } q -= I_WKV;
            if (q < I_WKV) { transpose_item(GIN(15) + (size_t)l * KVRANK * KVW, KVRANK, KVW, KVW, wsp<bf16_t>(F, WS_WKVC) + (size_t)l * KVW * KVRANK, MAP_ID, nullptr, scr, q, lane); continue; } q -= I_WKV;
            if (q < I_WOUT) { transpose_item(GIN(19) + (size_t)l * DM * DM, DM, DM, DM, wsp<bf16_t>(F, WS_WOUT) + (size_t)l * DM * DM, MAP_ID, nullptr, scr, q, lane); continue; } q -= I_WOUT;
            if (DEFER_FF && spread && l >= 1 && q < I_WF1 + I_WF2) continue;
            if (q < I_WF1) { transpose_item(GIN(21) + (size_t)l * DM * DFF, DM, DFF, DFF, wsp<bf16_t>(F, WS_WF1) + (size_t)l * DFF * DM, MAP_ID, nullptr, scr, q, lane); continue; } q -= I_WF1;
            if (q < I_WF2) { transpose_item(GIN(22) + (size_t)l * DFF * DM, DFF, DM, DM, wsp<bf16_t>(F, WS_WF2) + (size_t)l * DM * DFF, MAP_ID, nullptr, scr, q, lane); continue; } q -= I_WF2;
            { const int g = q / I_WP, it2 = q % I_WP; transpose_item(GIN(10) + ((size_t)l * 4 + g) * 4096, 64, 64, 64, wsp<bf16_t>(F, WS_WPT) + ((size_t)l * 4 + g) * 4096, MAP_ID, nullptr, scr, it2, lane); continue; }
        }
        r -= N_T;
        if (r < N_WS) {
            const float* src = GIN(17) + (size_t)r * 512 + lane * 8; const f32x4 a = *(const f32x4*)src, b = *(const f32x4*)(src + 4);
            *(u32x4*)(wsp<bf16_t>(F, WS_WSB) + (size_t)r * 512 + lane * 8) = pack8(a, b); continue;
        }
        r -= N_WS;
        if (r < N_CK) {
            const size_t e = (size_t)r * 512 + lane * 8; const int c = (int)(e % 256), j = (int)((e / 256) % 256), l = (int)((e / 65536) % 4), b = (int)(e / 262144);
            const float* src = GIN(2) + e; const f32x4 a = *(const f32x4*)src, bb = *(const f32x4*)(src + 4);
            *(u32x4*)(wsp<bf16_t>(F, WS_CCKV) + ((size_t)(l * NLATB + b) * PAST + j) * KVRANK + c) = pack8(a, bb); continue;
        }
        r -= N_CK;
        { const int id = r * 64 + lane, pos = id >> 4, j = id & 15;
          const double inv = (double)__builtin_amdgcn_exp2f(-(float)j * (13.287712379549449f / 16.0f));
          const double ang = (double)pos * inv, rev = ang * 0.15915494309189535;
          const float fr_ = (float)(rev - (double)(long long)rev);
          wsp<f32x2>(F, WS_ROPE)[id] = (f32x2){__builtin_amdgcn_cosf(fr_), __builtin_amdgcn_sinf(fr_)}; }
    }
}
__device__ __forceinline__ void ff_convert(const Ctx& F, int l) {
    constexpr int I_WF1 = (DM / 64) * (DFF / 64), I_WF2 = (DFF / 64) * (DM / 64);
    const int li = F.vcu & 31, x = F.vcu >> 5; if (li < 12) return;
    asm volatile("s_waitcnt vmcnt(0)" ::: "memory"); __syncthreads();
    LAS float* scr = (LAS float*)(F.lds + F.wave * 16384);
    const int gw = (x * 20 + (li - 12)) * 8 + F.wave, NGW = 160 * 8, lane = F.lane;
    for (int it = gw; it < I_WF1 + I_WF2; it += NGW) {
        if (it < I_WF1) transpose_item<true>(GIN(21) + (size_t)l * DM * DFF, DM, DFF, DFF, wsp<bf16_t>(F, WS_WF1) + (size_t)l * DFF * DM, MAP_ID, nullptr, scr, it, lane);
        else transpose_item<true>(GIN(22) + (size_t)l * DFF * DM, DFF, DM, DM, wsp<bf16_t>(F, WS_WF2) + (size_t)l * DM * DFF, MAP_ID, nullptr, scr, it - I_WF1, lane);
    }
}
__device__ __forceinline__ void phase_p0b(const Ctx& F) {
    const int gt = F.vcu * 512 + F.tid, NT = F.G * 512;
    const float* mp = wsp<const float>(F, WS_MODP);
    for (int id = gt; id < DEPTH * NSLOT * MODW; id += NT) {
        const int nn = id % MODW, s = (id / MODW) % NSLOT, l = id / (MODW * NSLOT);
        float v = GIN(7)[(size_t)l * MODW + nn];
#pragma unroll
        for (int kc = 0; kc < 16; ++kc) v += mp[((size_t)(kc * NSLOT + s)) * (DEPTH * MODW) + (size_t)l * MODW + nn];
        const int part = nn >> 10, k = nn & 1023; const size_t o = ((size_t)l * NSLOT + s) * DM + k;
        if (part == 0) wsp<float>(F, WS_SH1)[o] = v;
        else if (part == 1) wsp<float>(F, WS_GM1)[o] = GIN(8)[(size_t)l * DM + k] * (1.0f + v);
        else if (part == 2) wsp<float>(F, WS_G1)[o] = v;
        else if (part == 3) wsp<float>(F, WS_SH2)[o] = v;
        else if (part == 4) wsp<float>(F, WS_GM2)[o] = GIN(20)[(size_t)l * DM + k] * (1.0f + v);
        else wsp<float>(F, WS_G2)[o] = v;
    }
}
template <bool WTHRU>
__device__ __forceinline__ void shw_item(const float* SH, const GAS bf16_t* WT, float* out, int ldo, int n0, int lane) {
    const int r16 = lane & 15, kg = lane >> 4; const bool live = r16 < NSLOT;
    f32x4 acc = (f32x4){0.f, 0.f, 0.f, 0.f};
    const GAS bf16_t* bp = WT + (size_t)(n0 + r16) * DM + kg * 8;
    const float* ap = SH + (size_t)(live ? r16 : 0) * DM + kg * 8;
    for (int k0 = 0; k0 < DM; k0 += 256) {
        u32x4 b[8]; f32x4 a0[8], a1[8];
#pragma unroll
        for (int j = 0; j < 8; ++j) { b[j] = *(const GAS u32x4*)(bp + k0 + 32 * j); a0[j] = *(const f32x4*)(ap + k0 + 32 * j); a1[j] = *(const f32x4*)(ap + k0 + 32 * j + 4); }
#pragma unroll
        for (int j = 0; j < 8; ++j) {
            u32x4 hi, lo;
            hi.x = cvt_pk_bf16(a0[j][0], a0[j][1]); hi.y = cvt_pk_bf16(a0[j][2], a0[j][3]); hi.z = cvt_pk_bf16(a1[j][0], a1[j][1]); hi.w = cvt_pk_bf16(a1[j][2], a1[j][3]);
            lo.x = cvt_pk_bf16(a0[j][0] - bf_lo(hi.x), a0[j][1] - bf_hi(hi.x)); lo.y = cvt_pk_bf16(a0[j][2] - bf_lo(hi.y), a0[j][3] - bf_hi(hi.y));
            lo.z = cvt_pk_bf16(a1[j][0] - bf_lo(hi.z), a1[j][1] - bf_hi(hi.z)); lo.w = cvt_pk_bf16(a1[j][2] - bf_lo(hi.w), a1[j][3] - bf_hi(hi.w));
            if (!live) { hi = (u32x4){0u, 0u, 0u, 0u}; lo = hi; }
            const bf16x8 bv = __builtin_bit_cast(bf16x8, b[j]);
            acc = __builtin_amdgcn_mfma_f32_16x16x32_bf16(__builtin_bit_cast(bf16x8, hi), bv, acc, 0, 0, 0);
            acc = __builtin_amdgcn_mfma_f32_16x16x32_bf16(__builtin_bit_cast(bf16x8, lo), bv, acc, 0, 0, 0);
        }
    }
#pragma unroll
    for (int r = 0; r < 4; ++r) { const int sr = 4 * kg + r;
        if (sr < NSLOT) { float* o = out + (size_t)sr * ldo + n0 + r16;
            if (WTHRU) __hip_atomic_store(o, acc[r], __ATOMIC_RELAXED, __HIP_MEMORY_SCOPE_AGENT); else *o = acc[r]; } }
}
__device__ __forceinline__ void shw2_deferred(const Ctx& F, int l) {
    const int li = F.vcu & 31, x = F.vcu >> 5; if (li < 4 || li >= 16) return;
    const int item = (x * 12 + (li - 4)) * 8 + F.wave;
    if (item < DFF / 16) shw_item<true>(wsp<const float>(F, WS_SH2) + (size_t)l * NSLOT * DM, wsp<const bf16_t>(F, WS_WF1) + (size_t)l * DFF * DM, wsp<float>(F, WS_SHW2) + (size_t)l * NSLOT * DFF, DFF, item * 16, F.lane);
}
__device__ __forceinline__ const float* xrow_in(const Ctx& F, int row) { return row < NCTX ? GIN(0) + (size_t)row * DM : GIN(1) + (size_t)(row - NCTX) * DM; }
__device__ __forceinline__ void phase_p0c(const Ctx& F) {
    const int lane = F.lane, wid = F.wave, tid = F.tid;
    {
        constexpr int I1 = INP / 16, I2 = DFF / 16;
        const bool defer = F.G == 256;
        const int n2 = defer ? 0 : DEPTH, total = DEPTH * I1 + n2 * I2;
        for (int it = F.vcu * 8 + wid; it < total; it += F.G * 8) {
            if (it < DEPTH * I1) { const int l = it / I1, c = it % I1;
                shw_item<false>(wsp<const float>(F, WS_SH1) + (size_t)l * NSLOT * DM, wsp<const bf16_t>(F, WS_WIN) + (size_t)l * INP * DM, wsp<float>(F, WS_SHW1) + (size_t)l * NSLOT * INP, INP, c * 16, lane); }
            else { const int q = it - DEPTH * I1, l = q / I2, c = q % I2;
                shw_item<false>(wsp<const float>(F, WS_SH2) + (size_t)l * NSLOT * DM, wsp<const bf16_t>(F, WS_WF1) + (size_t)l * DFF * DM, wsp<float>(F, WS_SHW2) + (size_t)l * NSLOT * DFF, DFF, c * 16, lane); }
        }
    }
    {
        const int gw = F.vcu * 8 + wid, NGW = F.G * 8;
        const float* GM = wsp<const float>(F, WS_GM1);
        bf16_t* XG = wsp<bf16_t>(F, WS_XG); float* ST1 = wsp<float>(F, WS_ST1);
        constexpr int RB = 10;
        for (int row0 = gw; row0 < MROWS; row0 += NGW * RB) {
            f32x4 v[RB][4];
#pragma unroll
            for (int i = 0; i < RB; ++i) { const int row = row0 + i * NGW; const f32x4* xr = (const f32x4*)xrow_in(F, row < MROWS ? row : row0) + lane;
#pragma unroll
                for (int j = 0; j < 4; ++j) v[i][j] = xr[64 * j]; }
#pragma unroll
            for (int i = 0; i < RB; ++i) { const int row = row0 + i * NGW;
                if (row < MROWS) {
                    const int s = slot_of_tile(row >> 8); const f32x4* gr = (const f32x4*)(GM + (size_t)s * DM) + lane;
                    float q = 0.f;
#pragma unroll
                    for (int j = 0; j < 4; ++j) { const f32x4 vv = v[i][j], g = gr[64 * j]; q += (vv[0] * vv[0] + vv[1] * vv[1]) + (vv[2] * vv[2] + vv[3] * vv[3]); const f32x4 y = vv * g;
                        u32x2 o; o.x = cvt_pk_bf16(y[0], y[1]); o.y = cvt_pk_bf16(y[2], y[3]); *(u32x2*)(XG + (size_t)row * DM + (64 * j + lane) * 4) = o; }
                    q = wave_sum(q);
                    if (lane < 16) ST1[(size_t)row * 16 + lane] = (lane == 0) ? q : 0.f;
                } }
        }
    }
}
__device__ __forceinline__ void final_tile(const Ctx& F, int pm, int pn) {
    asm volatile("s_waitcnt vmcnt(0)" ::: "memory");
    __syncthreads();
    if (F.tid == 0) {
        unsigned* bar = (unsigned*)((gu32*)(F.ws + WS_CTL) + CW_BAR); unsigned* cw = (unsigned*)((gu32*)(F.ws + WS_CTL) + CW_FIN + 32 * pm);
        __builtin_amdgcn_fence(__ATOMIC_RELEASE, "agent");
        asm volatile("s_waitcnt vmcnt(0)" ::: "memory");
        xb_add(cw, 1u);
        XB_SPIN(xb_ld(cw) < 4u, bar);
        __builtin_amdgcn_fence(__ATOMIC_ACQUIRE, "agent");
        asm volatile("s_waitcnt vmcnt(0)" ::: "memory");
    }
    __syncthreads();
    __builtin_amdgcn_fence(__ATOMIC_ACQUIRE, "workgroup");
    LAS float* S = (LAS float*)(F.lds + RING_BYTES + 2048);
    int t_ = F.tid; asm volatile("" : "+v"(t_));
    if (t_ == 0) *(volatile LAS int*)(S + 256) = 0;
    if (t_ < 256) { const GAS f32x4* sp = (const GAS f32x4*)(wsp<const float>(F, WS_ST1) + (size_t)(pm * 256 + t_) * 16);
        S[t_] = fast_rsqrt(((sum4(sp[0]) + sum4(sp[1])) + (sum4(sp[2]) + sum4(sp[3]))) * (1.0f / DM) + EPS); }
    __syncthreads();
    const int c16 = t_ & 31, r0 = t_ >> 5;
    const GAS float* gf = GIN(23) + pn * 256 + c16 * 8; const f32x4 g0 = *(const GAS f32x4*)gf, g1 = *(const GAS f32x4*)(gf + 4);
    const GAS bf16_t* xb = wsp<const bf16_t>(F, WS_XB) + (size_t)(pm * 256 + r0) * DM + pn * 256 + c16 * 8;
    GAS float* y = F.out + OUT_X + (size_t)(pm * 256 + r0) * DM + pn * 256 + c16 * 8;
    u32x4 b[16];
#pragma unroll
    for (int p = 0; p < 16; ++p) b[p] = *(const GAS u32x4*)(xb + (size_t)p * 16 * DM);
#pragma unroll
    for (int p = 0; p < 16; ++p) { const float rs = S[p * 16 + r0]; GAS float* yr = y + (size_t)p * 16 * DM; const u32x4 v = b[p];
        *(GAS f32x4*)yr = (f32x4){bf_lo(v.x), bf_hi(v.x), bf_lo(v.y), bf_hi(v.y)} * rs * g0; *(GAS f32x4*)(yr + 4) = (f32x4){bf_lo(v.z), bf_hi(v.z), bf_lo(v.w), bf_hi(v.w)} * rs * g1; }
}
__device__ __forceinline__ void phase_final(const Ctx& F) {
    const int gw = F.vcu * 8 + F.wave, NGW = F.G * 8, lane = F.lane;
    const float* ST1 = wsp<const float>(F, WS_ST1); const f32x4* gf = (const f32x4*)GIN(23) + lane;
    const GAS bf16_t* XB = wsp<const bf16_t>(F, WS_XB);
    for (int row = gw; row < MROWS; row += NGW) {
        const f32x4* sp = (const f32x4*)(ST1 + (size_t)row * 16);
        const float rs = fast_rsqrt(((sum4(sp[0]) + sum4(sp[1])) + (sum4(sp[2]) + sum4(sp[3]))) * (1.0f / DM) + EPS);
        const GAS u32x2* xr = (const GAS u32x2*)(XB + (size_t)row * DM) + lane;
        f32x4* yr = (f32x4*)(F.out + OUT_X + (size_t)row * DM) + lane;
#pragma unroll
        for (int j = 0; j < 4; ++j) { const u32x2 b = xr[64 * j]; const f32x4 v = (f32x4){bf_lo(b.x), bf_hi(b.x), bf_lo(b.y), bf_hi(b.y)}; yr[64 * j] = v * rs * gf[64 * j]; }
    }
}

#ifdef DIS_ATTN
#define ATTN_CALL(...) do {} while (0)
#else
#define ATTN_CALL(...) attn_unit(__VA_ARGS__)
#endif
#ifdef DIS_POOL
#define POOL_CALL(...) do {} while (0)
#else
#define POOL_CALL(...) pool_unit(__VA_ARGS__)
#endif
#ifdef DIS_GMLP
#define GMLP_CALL(...) do {} while (0)
#else
#define GMLP_CALL(...) gmlp_unit(__VA_ARGS__)
#endif
__device__ __forceinline__ void mix_fix(const Ctx& F, int l, int L, bool dry) {
    if (dry) return;
    const float* STKV = wsp<const float>(F, WS_STKV); const float* gkv = GIN(14) + (size_t)l * KVRANK;
    float* o = F.out + OUT_CKV + ((size_t)(L * DEPTH + l) * LCTX) * KVRANK;
    int tid0_ = threadIdx.x; asm volatile("" : "+v"(tid0_));
    const int c4 = (tid0_ & 63) * 4; const f32x4 g = *(const f32x4*)(gkv + c4);
    for (int t0 = tid0_ >> 6; t0 < LCTX; t0 += 64) {
        f32x4 st[8], v[8];
#pragma unroll
        for (int k = 0; k < 8; ++k) { const int t = t0 + 8 * k; st[k] = *(const f32x4*)(STKV + (size_t)(L * LCTX + t) * 4); v[k] = *(const f32x4*)(o + (size_t)t * KVRANK + c4); }
#pragma unroll
        for (int k = 0; k < 8; ++k) { const int t = t0 + 8 * k; const float rs = fast_rsqrt(sum4(st[k]) * (1.0f / KVRANK) + EPS); *(f32x4*)(o + (size_t)t * KVRANK + c4) = v[k] * rs * g; }
    }
}
__device__ __forceinline__ void mix_attn_ctx(const Ctx& F, int b, int h) {
    const GAS bf16_t* Q = wsp<const bf16_t>(F, Q_C); GAS bf16_t* Y = wsp<bf16_t>(F, YCAT_C);
    const int L = b * 4 + h; const size_t row0 = (size_t)b * LCTX;
    ATTN_CALL(F.lds, Q + row0 * QW + h * 192, wsp<const bf16_t>(F, WS_KC) + (size_t)L * LCTX * 192, wsp<const bf16_t>(F, WS_VC) + (size_t)L * LCTX * 128, Y + row0 * DM + 256 + h * 128, LCTX);
}
__device__ __forceinline__ void mix_ctx(const Ctx& F, int l, bool dry) {
    if (F.G == 256) { const int x = F.vcu >> 5, li = F.vcu & 31;
        if (li >= 16 && li < 24) { const int m = li - 16; mix_attn_ctx(F, 2 * x + (m >> 2), m & 3); }
        else if (li >= 24 && li < 28) { const int m = li - 24; POOL_CALL(F, l, 2 * x, m, m + 1); GMLP_CALL(F, l, 4 * x + m); }
        else if (li >= 28) { const int m = li - 28; POOL_CALL(F, l, 2 * x + 1, m, m + 1); if (m < 2) mix_fix(F, l, 2 * x + m, dry); }
    } else for (int j = F.vcu; j < 128; j += F.G) { const int x = j >> 4, m = j & 15;
        if (m < 2) POOL_CALL(F, l, 2 * x + m, 0, 4); else if (m < 10) mix_attn_ctx(F, 2 * x + ((m - 2) >> 2), (m - 2) & 3); else if (m < 14) GMLP_CALL(F, l, 4 * x + (m - 10)); else mix_fix(F, l, 2 * x + (m - 14), dry); }
}
__device__ __forceinline__ void mix_lat_attn(const Ctx& F) {
    const GAS bf16_t* Q = wsp<const bf16_t>(F, Q_L); GAS bf16_t* Y = wsp<bf16_t>(F, YCAT_L);
    for (int L = F.vcu; L < 256; L += F.G) {
        const int bh = L >> 3, qb = L & 7, b = bh >> 2, h = bh & 3; const size_t row0 = (size_t)NCTX + (size_t)b * LLAT + qb * 256;
        ATTN_CALL(F.lds, Q + row0 * QW + h * 192, wsp<const bf16_t>(F, WS_KL) + (size_t)bh * LKEY * 192, wsp<const bf16_t>(F, WS_VL) + (size_t)bh * LKEY * 128, Y + row0 * DM + 256 + h * 128, LKEY);
    }
}
__device__ __forceinline__ void mix_lat_small(const Ctx& F, int l) {
    if (F.G == 256) { const int x = F.vcu >> 5, li = F.vcu & 31;
        if (li >= 8 && li < 24) { const int m = li - 8; POOL_CALL(F, l, 16 + 8 * x + (m >> 1), 2 * (m & 1), 2 * (m & 1) + 2); }
        else if (li >= 24) { const int m = li - 24; GMLP_CALL(F, l, 32 + 16 * x + 2 * m); GMLP_CALL(F, l, 32 + 16 * x + 2 * m + 1); } }
    else for (int j = F.vcu; j < 192; j += F.G) { if (j < 64) POOL_CALL(F, l, 16 + j, 0, 4); else GMLP_CALL(F, l, 32 + (j - 64)); }
}

#ifdef DIS_GEMM
#define GEMM_CALL(a, b, c) do { (void)(b); (void)(c); } while (0)
#else
#define GEMM_CALL(a, b, c) gemm_phase(a, b, c)
#endif
constexpr int SL_P0A = 0, SL_P0B = 1, SL_P0C = 2, SL_PRE = 3, SL_L0 = 4, SL_PER_L = 6, SL_FINAL = SL_L0 + DEPTH * SL_PER_L, N_PHASES = SL_FINAL + 1;

__global__ void __launch_bounds__(512, 2) mega_fwd(const Args args) {
    extern __shared__ __attribute__((aligned(16))) unsigned char lds_raw[];
    Ctx F;
    F.a = &args; F.out = (GAS float*)args.out; F.ws = (GAS unsigned char*)args.ws; F.lds = (LAS unsigned char*)lds_raw;
    F.tid = threadIdx.x; F.lane = F.tid & 63; F.wave = __builtin_amdgcn_readfirstlane(F.tid >> 6);
    F.G = gridDim.x; { const int bx = blockIdx.x; F.vcu = (F.G % 8 == 0) ? (bx % 8) * (F.G / 8) + bx / 8 : bx; }
    volatile LAS unsigned* MISC = (volatile LAS unsigned*)(F.lds + MISC_OFF);
    for (int u = F.tid; u < (LDS_BYTES - RING_BYTES) / 4; u += 512) ((LAS unsigned*)(F.lds + RING_BYTES))[u] = 0u;
    __syncthreads();
    gu32* ctl = (gu32*)(F.ws + WS_CTL);
    XcdBarrier bar; bar.bar = (unsigned*)(ctl + CW_BAR); bar.x = 0; bar.st = nullptr;
#if !MK_PER_PHASE
    bar = xcd_barrier_post((unsigned*)(ctl + CW_BAR), MISC + 8);
    if (threadIdx.x == 0) __hip_atomic_store(ctl + CW_XCC + F.vcu, xb_xcc_id() + 1u, RLX_AGENT);
#endif
    const int lo = args.ph_lo, hi = (FUSE_FINAL && F.G == 256 && args.ph_hi == N_PHASES) ? (int)SL_FINAL : args.ph_hi;
    for (int ph = lo; ph < hi; ++ph) {
      int reps = 1;
      if (PROBE_PHASE >= 0) { const int key = ph == SL_P0A ? 10 : ph == SL_P0B ? 11 : ph == SL_P0C ? 12 : ph == SL_FINAL ? 13 : ph == SL_PRE ? 9 : (ph - SL_L0) % SL_PER_L; if (key == PROBE_PHASE) reps += PROBE_REP; }
      for (int rep = 0; rep < reps; ++rep) {
        const bool dry = rep > 0;
        if (PROBE_PHASE == 13 && dry) break;
#if PROBE_FLUSH && !MK_PER_PHASE
        if (dry) {
            GAS u32x4* z = (GAS u32x4*)(F.ws + WS_OVL); const size_t n16 = (size_t)180 * 1024 * 1024 / 16;
            for (size_t i = (size_t)F.vcu * 512 + threadIdx.x; i < n16; i += (size_t)F.G * 512) z[i] = (u32x4){0u, 0u, 0u, 0u};
            GAS u32x4* z2 = (GAS u32x4*)(F.out); const size_t m16 = (size_t)100 * 1024 * 1024 / 16;
            for (size_t i = (size_t)F.vcu * 512 + threadIdx.x; i < m16; i += (size_t)F.G * 512) z2[i] = (u32x4){0u, 0u, 0u, 0u};
            xcd_barrier(bar);
        }
#endif
        { int t_ = threadIdx.x; asm volatile("" : "+v"(t_)); F.tid = t_; F.lane = t_ & 63; F.wave = __builtin_amdgcn_readfirstlane(t_ >> 6);
          unsigned char* w_ = args.ws; asm volatile("" : "+s"(w_)); F.ws = (GAS unsigned char*)w_; float* o_ = args.out; asm volatile("" : "+s"(o_)); F.out = (GAS float*)o_; }
#ifndef DIS_P0
        if (ph == SL_P0A) phase_p0a(F);
        else if (ph == SL_P0B) { phase_p0b(F);
            { int t_ = threadIdx.x; asm volatile("" : "+v"(t_)); const GAS u32x4* src = (const GAS u32x4*)(F.ws + WS_ROPE); LAS u32x4* dl = (LAS u32x4*)(F.lds + RING_BYTES + 4096); dl[t_] = src[t_]; } }
        else if (ph == SL_P0C) phase_p0c(F);
        else if (ph == SL_FINAL) phase_final(F);
#else
        if (ph < SL_PRE || ph == SL_FINAL) {}
#endif
        else {
            Epi E; E.ws = F.ws; E.out = F.out; E.xp = GIN(0); E.xs = GIN(1); E.dry = dry;
            const int l = ph == SL_PRE ? 0 : (ph - SL_L0) / SL_PER_L, sub = ph == SL_PRE ? -1 : (ph - SL_L0) % SL_PER_L;
            if (sub == 1) {
                const GAS float* ck = GIN(3); GAS bf16_t* KL = wsp<bf16_t>(F, WS_KL);
                const bool loc = (F.G == 256);
                for (int id0 = loc ? (F.vcu & 31) * 512 + F.tid : F.vcu * 512 + F.tid; id0 < (loc ? PAST * 8 : NLATB * PAST * 8); id0 += (loc ? 32 : F.G) * 512) {
                    const int id = loc ? ((F.vcu >> 5) << 11) + id0 : id0;
                    const int ch = id & 7, j = (id >> 3) & 255, b = id >> 11, i0 = ch * 4;
                    const GAS float* src = ck + ((size_t)(b * DEPTH + l) * PAST + j) * 64;
                    const f32x4 a = *(const GAS f32x4*)(src + i0), c = *(const GAS f32x4*)(src + 32 + i0);
                    u32x4 w; w.x = cvt_pk_bf16(a[0], c[0]); w.y = cvt_pk_bf16(a[1], c[1]); w.z = cvt_pk_bf16(a[2], c[2]); w.w = cvt_pk_bf16(a[3], c[3]);
                    GAS bf16_t* kd = KL + ((size_t)(b * NH) * LKEY + j) * 192 + 128 + ch * 8;
#pragma unroll
                    for (int h = 0; h < NH; ++h) *(GAS u32x4*)(kd + (size_t)h * LKEY * 192) = w;
                }
            }
            if (sub == 2) { mix_lat_attn(F); if (PROBE_PHASE == 21) for (int r2 = 0; r2 < PROBE_REP; ++r2) mix_lat_attn(F); }
            { SchedSlot S; S.ws = F.ws; S.c = F.vcu; S.G = F.G; S.sub = sub; S.l = l; GEMM_CALL(F.lds, S, E); }
            if (DEFER_FF && sub == 5 && F.G == 256 && l + 1 < DEPTH && !dry) ff_convert(F, l + 1);
            if (FUSE_FINAL && F.G == 256 && l == DEPTH - 1 && sub >= 4 && !dry) {
                SchedSlot S; S.ws = F.ws; S.c = F.vcu; S.G = F.G; S.sub = sub; S.l = l; GUnit u0;
                if (S.next(0, u0) && u0.kind == K_FF2) final_tile(F, u0.pm, u0.pn);
            }
            if (sub == -1 && F.G == 256 && !dry && (F.vcu & 31) >= 12) { asm volatile("s_waitcnt vmcnt(0)" ::: "memory"); __syncthreads(); phase_p0a(F, 1, (F.vcu >> 5) * 20 + (F.vcu & 31) - 12); }
            if (sub == 1) mix_ctx(F, l, dry);
            if (sub == 1 && F.G == 256 && !dry) shw2_deferred(F, l);
            if (sub == 2) mix_lat_small(F, l);
        }
#if !MK_PER_PHASE
        if (threadIdx.x == 0) MISC[10] = (MISC[20] != 0u && ph >= SL_L0 && ph + 1 < SL_FINAL) ? 1u : 0u;
        if (ph + 1 < hi || rep + 1 < reps) xcd_barrier(bar);
        if (ph == SL_P0A && rep == 0) {
            int bad = 0; int tq_ = threadIdx.x; asm volatile("" : "+v"(tq_));
            if (F.G != 256) bad = 1;
            else if (tq_ < 256) { gu32* cc = (gu32*)(F.ws + WS_CTL); const unsigned v = __hip_atomic_load(cc + CW_XCC + tq_, RLX_AGENT), h = __hip_atomic_load(cc + CW_XCC + (tq_ & ~31), RLX_AGENT); bad = (v == 0u || v != h); }
            const bool wbad = __ballot(bad) != 0ull;
            if ((tq_ & 63) == 0) MISC[24 + (tq_ >> 6)] = wbad ? 1u : 0u;
            __syncthreads();
            if (tq_ == 0) { unsigned a = 0u;
#pragma unroll
                for (int w8 = 0; w8 < 8; ++w8) a |= MISC[24 + w8];
                MISC[20] = a ? 0u : 1u; }
            __syncthreads();
        }
        if (PROBE_PHASE == 20 && ph >= SL_L0 && ph < SL_FINAL) { for (int r2 = 0; r2 < PROBE_REP; ++r2) xcd_barrier(bar); }
#endif
      }
    }
}

extern "C" void kernel_launch(void* const* d_in, const int* in_sizes, int n_in, void* d_out, int out_size, void* d_ws, size_t ws_size, hipStream_t stream) {
    static int grid = 0;
    if (grid == 0) {
        if (n_in != 24 || out_size != (int)OUT_END || ws_size < WS_END) { fprintf(stderr, "kernel_launch: unexpected shapes: n_in %d out %d ws %zu (need %zu)\n", n_in, out_size, ws_size, (size_t)WS_END); grid = -1; return; }
        int dev = 0, cus = 0, per_cu = 0;
        if (hipGetDevice(&dev) != hipSuccess || hipDeviceGetAttribute(&cus, hipDeviceAttributeMultiprocessorCount, dev) != hipSuccess) { grid = -1; return; }
        if (hipFuncSetAttribute((const void*)mega_fwd, hipFuncAttributeMaxDynamicSharedMemorySize, LDS_BYTES) != hipSuccess) { fprintf(stderr, "kernel_launch: hipFuncSetAttribute failed\n"); grid = -1; return; }
        if (hipOccupancyMaxActiveBlocksPerMultiprocessor(&per_cu, (const void*)mega_fwd, 512, LDS_BYTES) != hipSuccess || per_cu < 1) { fprintf(stderr, "kernel_launch: occupancy query says %d\n", per_cu); per_cu = 1; }
        (void)hipGetLastError();
        grid = cus;
    }
    if (grid < 0) return;
    (void)hipMemsetAsync((char*)d_ws + WS_CTL, 0, CTL_ZERO_BYTES, stream);
    Args a{};
    for (int i = 0; i < 24; ++i) a.in[i] = (const float*)d_in[i];
    a.out = (float*)d_out; a.ws = (unsigned char*)d_ws;
#if MK_PER_PHASE
    for (int ph = 0; ph < N_PHASES; ++ph) { a.ph_lo = ph; a.ph_hi = ph + 1; hipLaunchKernelGGL(mega_fwd, dim3(grid), dim3(512), LDS_BYTES, stream, a); }
#else
    a.ph_lo = 0; a.ph_hi = N_PHASES; hipLaunchKernelGGL(mega_fwd, dim3(grid), dim3(512), LDS_BYTES, stream, a);
#endif
    const hipError_t le = hipPeekAtLastError();
    if (le != hipSuccess) fprintf(stderr, "kernel_launch: launch failed: %s\n", hipGetErrorName(le));
}
```

```cpp
#include <hip/hip_runtime.h>
#include <cstdio>
#include <cstdint>

#define LAS __attribute__((address_space(3)))
#if defined(__HIP_DEVICE_COMPILE__)
#define GAS __attribute__((address_space(1)))
#else
#define GAS
#endif
typedef unsigned short bf16_t;
typedef short bf16x8 __attribute__((ext_vector_type(8)));
typedef short s16x4 __attribute__((ext_vector_type(4)));
typedef float f32x2 __attribute__((ext_vector_type(2)));
typedef float f32x4 __attribute__((ext_vector_type(4)));
typedef float f32x16 __attribute__((ext_vector_type(16)));
typedef unsigned u32x4 __attribute__((ext_vector_type(4)));
typedef unsigned u32x2 __attribute__((ext_vector_type(2)));
typedef GAS unsigned gu32;

#ifndef PROBE_PHASE
#define PROBE_PHASE -1
#endif
#ifndef PROBE_REP
#define PROBE_REP 0
#endif
#ifndef PROBE_FLUSH
#define PROBE_FLUSH 0
#endif
#ifndef MK_PER_PHASE
#define MK_PER_PHASE 0
#endif
#define FUSE_FINAL (!MK_PER_PHASE)
#ifndef DEFER_FF
#define DEFER_FF 1
#endif

constexpr int DM = 1024, DEPTH = 4, NCTXB = 16, LCTX = 256, NLATB = 8, LLAT = 2048, PAST = 256;
constexpr int NCTX = NCTXB * LCTX  , NLAT = NLATB * LLAT  , MROWS = NCTX + NLAT  ;
constexpr int NSLOT = 9, MODW = 6 * DM;
constexpr int INW = 1472, INP = 1536, QRANK = 384, KVRANK = 256, QW = 768, KVW = 1024, DFF = 4096, NH = 4;
constexpr int LKEY = PAST + LLAT  ;
constexpr float EPS = 1e-6f;
constexpr float C2 = 0.07216878364870322f * 1.4426950408889634f;
constexpr int NTM = MROWS / 256;

constexpr size_t OUT_X = 0, OUT_CKV = (size_t)MROWS * DM, OUT_KR = OUT_CKV + (size_t)NCTXB * DEPTH * LCTX * KVRANK, OUT_END = OUT_KR + (size_t)NCTXB * DEPTH * LCTX * 64;

constexpr size_t al256(size_t x) { return (x + 255) / 256 * 256; }
constexpr size_t WS_CTL = 0, CTL_ZERO_BYTES = 1u << 20;
constexpr size_t WS_MODP = CTL_ZERO_BYTES;
constexpr size_t WS_SH1 = WS_MODP + al256((size_t)16 * NSLOT * DEPTH * MODW * 4);
constexpr size_t MODV = al256((size_t)DEPTH * NSLOT * DM * 4);
constexpr size_t WS_GM1 = WS_SH1 + MODV, WS_G1 = WS_GM1 + MODV, WS_SH2 = WS_G1 + MODV, WS_GM2 = WS_SH2 + MODV, WS_G2 = WS_GM2 + MODV;
constexpr size_t WS_SHW1 = WS_G2 + MODV;
constexpr size_t WS_SHW2 = WS_SHW1 + al256((size_t)DEPTH * NSLOT * INP * 4);
constexpr size_t WS_ROPE = WS_SHW2 + al256((size_t)DEPTH * NSLOT * DFF * 4);
constexpr size_t WS_ST1 = WS_ROPE + al256(64 * 16 * 8);
constexpr size_t WS_ST2 = WS_ST1 + al256((size_t)MROWS * 16 * 4);
constexpr size_t WS_STQ = WS_ST2 + al256((size_t)MROWS * 16 * 4);
constexpr size_t WS_STKV = WS_STQ + al256((size_t)MROWS * 8 * 4);
constexpr size_t WS_STG = WS_STKV + al256((size_t)MROWS * 4 * 4);
constexpr size_t WS_WIN = WS_STG + al256((size_t)MROWS * 4 * 4);
constexpr size_t WS_WUQ = WS_WIN + al256((size_t)DEPTH * INP * DM * 2);
constexpr size_t WS_WKVF = WS_WUQ + al256((size_t)DEPTH * QW * QRANK * 2);
constexpr size_t WS_WKVC = WS_WKVF + al256((size_t)DEPTH * KVW * KVRANK * 2);
constexpr size_t WS_WOUT = WS_WKVC + al256((size_t)DEPTH * KVW * KVRANK * 2);
constexpr size_t WS_WF1 = WS_WOUT + al256((size_t)DEPTH * DM * DM * 2);
constexpr size_t WS_WF2 = WS_WF1 + al256((size_t)DEPTH * DFF * DM * 2);
constexpr size_t WS_WPT = WS_WF2 + al256((size_t)DEPTH * DM * DFF * 2);
constexpr size_t WS_WSB = WS_WPT + al256((size_t)DEPTH * 4 * 64 * 64 * 2);
constexpr size_t WS_CCKV = WS_WSB + al256((size_t)DEPTH * 4 * 128 * 128 * 2);
constexpr size_t WS_XG = WS_CCKV + al256((size_t)DEPTH * NLATB * PAST * KVRANK * 2);
constexpr size_t cmax(size_t a, size_t b) { return a > b ? a : b; }
constexpr size_t LB(size_t base, size_t w) { return base - (size_t)NCTX * w * 2; }
constexpr size_t WS_XB = WS_XG + al256((size_t)MROWS * DM * 2);
constexpr size_t WS_RC = WS_XB + al256((size_t)MROWS * DM * 2);
constexpr size_t HP_C = WS_RC, CKVR_C = HP_C + (size_t)NCTX * 256 * 2, U_C = CKVR_C + (size_t)NCTX * 256 * 2, GL_C = U_C + (size_t)NCTX * 256 * 2;
constexpr size_t CQ_C = GL_C + (size_t)NCTX * 256 * 2, Q_C = CQ_C + (size_t)NCTX * QRANK * 2, WS_KC = Q_C + (size_t)NCTX * QW * 2;
constexpr size_t WS_VC = WS_KC + (size_t)NCTXB * NH * LCTX * 192 * 2, YCAT_C = WS_VC + (size_t)NCTXB * NH * LCTX * 128 * 2;
constexpr size_t HID_C = WS_RC;
constexpr size_t WS_RL = al256(cmax(YCAT_C + (size_t)NCTX * DM * 2, HID_C + (size_t)NCTX * DFF * 2));
constexpr size_t HP_L0 = WS_RL, CKVR_L0 = HP_L0 + (size_t)NLAT * 256 * 2, U_L0 = CKVR_L0 + (size_t)NLAT * 256 * 2, GL_L0 = U_L0 + (size_t)NLAT * 256 * 2;
constexpr size_t CQ_L0 = GL_L0 + (size_t)NLAT * 256 * 2, Q_L0 = CQ_L0 + (size_t)NLAT * QRANK * 2, WS_KL = Q_L0 + (size_t)NLAT * QW * 2;
constexpr size_t WS_VL = WS_KL + (size_t)NLATB * NH * LKEY * 192 * 2, YCAT_L0 = WS_VL + (size_t)NLATB * NH * LKEY * 128 * 2;
constexpr size_t HID_L0 = WS_RL;
constexpr size_t HP_L = LB(HP_L0, 256), CKVR_L = LB(CKVR_L0, 256), U_L = LB(U_L0, 256), GL_L = LB(GL_L0, 256), CQ_L = LB(CQ_L0, QRANK), Q_L = LB(Q_L0, QW), YCAT_L = LB(YCAT_L0, DM), HID_L = LB(HID_L0, DFF);
constexpr size_t WS_OVL = WS_RC;
constexpr size_t WS_END = al256(cmax(YCAT_L0 + (size_t)NLAT * DM * 2, HID_L0 + (size_t)NLAT * DFF * 2));
#define SPLIT(isctx, NAME) ((isctx) ? NAME##_C : NAME##_L)

constexpr int CW_BAR = 4096;
constexpr int CW_FIN = 16384;
constexpr int CW_XCC = 8192;

constexpr int RING_BYTES = 131072, MISC_OFF = RING_BYTES + 320, LDS_BYTES = 147456;

#define RLX_AGENT __ATOMIC_RELAXED, __HIP_MEMORY_SCOPE_AGENT
#define LDS_WAIT() asm volatile("s_waitcnt lgkmcnt(0)" ::: "memory")
#define VM_WAIT() asm volatile("s_waitcnt vmcnt(0)" ::: "memory")
#define SBAR() __builtin_amdgcn_sched_barrier(0)
__device__ __forceinline__ unsigned cvt_pk_bf16(float lo, float hi) { unsigned r; asm volatile("v_cvt_pk_bf16_f32 %0, %1, %2" : "=v"(r) : "v"(lo), "v"(hi)); return r; }
__device__ __forceinline__ float bf_lo(unsigned w) { return __uint_as_float(w << 16); }
__device__ __forceinline__ float bf_hi(unsigned w) { return __uint_as_float(w & 0xffff0000u); }
__device__ __forceinline__ float bf1(bf16_t h) { return __uint_as_float(((unsigned)h) << 16); }
__device__ __forceinline__ bf16_t f2bf(float f) { return (bf16_t)(cvt_pk_bf16(f, 0.f) & 0xffffu); }
__device__ __forceinline__ float fast_rsqrt(float x) { return __builtin_amdgcn_rsqf(x); }
__device__ __forceinline__ float gelu_tanh(float x) {
    const float z = x * (1.0f + 0.044715f * x * x);
    const float e = __builtin_amdgcn_exp2f(z * (-2.0f * 0.7978845608028654f * 1.4426950408889634f));
    return x * __builtin_amdgcn_rcpf(1.0f + e);
}
__device__ __forceinline__ float wave_sum(float v) {
#pragma unroll
    for (int o = 1; o < 64; o <<= 1) v += __shfl_xor(v, o);
    return v;
}
__device__ __forceinline__ float fq_sum(float q) {
    { auto r = __builtin_amdgcn_permlane16_swap(__float_as_uint(q), __float_as_uint(q), false, false); q = __uint_as_float(r[0]) + __uint_as_float(r[1]); }
    { auto r = __builtin_amdgcn_permlane32_swap(__float_as_uint(q), __float_as_uint(q), false, false); q = __uint_as_float(r[0]) + __uint_as_float(r[1]); }
    return q;
}
__device__ __forceinline__ int slot_of_tile(int pm) { return pm < 16 ? 0 : 1 + ((pm - 16) >> 3); }

#define XB_TMO      128
#define XB_XCNT(j)  (256  + 64 * (j))
#define XB_XSUB(j)  (1280 + 64 * (j))
#define XB_XGEN(j)  (2304 + 64 * (j))
#define XB_TOP      3328
#define XB_TOPGEN   3392
#define XCD_BAR_WORDS 3456
#define XB_SPIN_CAP (1u << 18)
__device__ __forceinline__ unsigned xb_ld(unsigned* p)              { return __hip_atomic_load(p, __ATOMIC_RELAXED, __HIP_MEMORY_SCOPE_AGENT); }
__device__ __forceinline__ unsigned xb_add(unsigned* p, unsigned v) { return __hip_atomic_fetch_add(p, v, __ATOMIC_RELAXED, __HIP_MEMORY_SCOPE_AGENT); }
__device__ __forceinline__ unsigned xb_xcc_id() { return (unsigned)__builtin_amdgcn_s_getreg((3 << 11) | 20) & 0xFu; }
#define XB_SPIN(cond, bar) do { unsigned _sp = 0; while (cond) { __builtin_amdgcn_s_sleep(1); \
    if ((++_sp & 255u) == 0u) { if (xb_ld(&(bar)[XB_TMO])) break; if (_sp > XB_SPIN_CAP) { atomicAdd(&(bar)[XB_TMO], 1u); break; } } } } while (0)
struct XcdBarrier { unsigned* bar; unsigned x; volatile LAS unsigned* st; };
__device__ __forceinline__ XcdBarrier xcd_barrier_post(unsigned* bar, volatile LAS unsigned* st) {
    XcdBarrier b; b.bar = bar; b.x = xb_xcc_id(); b.st = st;
    if (threadIdx.x == 0) (void)xb_add(&bar[XB_XCNT(b.x)], 1u);
    return b;
}
__device__ __forceinline__ void xcd_barrier_complete(unsigned* bar, unsigned x, unsigned& nloc, unsigned& nx) {
    const unsigned G = gridDim.x * gridDim.y * gridDim.z;
    unsigned sum, cnt, mine, sp = 0u;
    for (;;) {
        sum = 0u; cnt = 0u; mine = 0u;
#pragma unroll
        for (unsigned j = 0; j < 16; ++j) { const unsigned c = xb_ld(&bar[XB_XCNT(j)]); sum += c; cnt += (c > 0u) ? 1u : 0u; mine = (j == x) ? c : mine; }
        if (sum == G) break;
        __builtin_amdgcn_s_sleep(1);
        if ((++sp & 255u) == 0u) { if (xb_ld(&bar[XB_TMO])) break; if (sp > XB_SPIN_CAP) { atomicAdd(&bar[XB_TMO], 1u); break; } }
    }
    nloc = mine > 0u ? mine : 1u; nx = cnt > 0u ? cnt : 1u;
}
__device__ __forceinline__ void xcd_barrier(const XcdBarrier& b) {
    asm volatile("s_waitcnt vmcnt(0)" ::: "memory");
    __syncthreads();
    if (threadIdx.x == 0) {
        unsigned* bar = b.bar;
        __builtin_amdgcn_s_waitcnt(0);
        unsigned nloc = b.st[0], nx = b.st[1];
        if (nloc == 0u) { xcd_barrier_complete(bar, b.x, nloc, nx); b.st[0] = nloc; b.st[1] = nx; }
        const unsigned old = xb_add(&bar[XB_XSUB(b.x)], 1u);
        const unsigned gen = old / nloc;
        if (old + 1u == (gen + 1u) * nloc) {
            if (b.st[2] == 0u) __builtin_amdgcn_fence(__ATOMIC_RELEASE, "agent");
            asm volatile("s_waitcnt vmcnt(0)" ::: "memory");
            const unsigned og = xb_add(&bar[XB_TOP], 1u);
            const unsigned tg = og / nx;
            if (og + 1u == (tg + 1u) * nx) xb_add(&bar[XB_TOPGEN], 1u);
            else XB_SPIN(xb_ld(&bar[XB_TOPGEN]) == tg, bar);
            __builtin_amdgcn_fence(__ATOMIC_ACQUIRE, "agent");
            xb_add(&bar[XB_XGEN(b.x)], 1u);
            asm volatile("s_waitcnt vmcnt(0)" ::: "memory");
        } else {
            XB_SPIN(xb_ld(&bar[XB_XGEN(b.x)]) == gen, bar);
            __builtin_amdgcn_fence(__ATOMIC_ACQUIRE, "agent");
            asm volatile("s_waitcnt vmcnt(0)" ::: "memory");
        }
    }
    __syncthreads();
}

struct Args { const float* in[24]; float* out; unsigned char* ws; int ph_lo, ph_hi; };

struct Ctx {
    const Args* a; GAS float* out; GAS unsigned char* ws;
    LAS unsigned char* lds;
    int tid, lane, wave, G, vcu;
};
template <class T> __device__ __forceinline__ GAS T* wsp(const Ctx& F, size_t off) { return (GAS T*)(F.ws + off); }
#define GIN(k) ((const GAS float*)F.a->in[k])

constexpr int BK = 64, HALF = 128, HTB = HALF * BK * 2;
__host__ __device__ __forceinline__ int lds_byte(int r, int c) { const int st = (r >> 4) * 2 + (c >> 5), rr = r & 15, cc = c & 31, ob = rr * 64 + cc * 2; return st * 1024 + (ob ^ (((ob >> 9) & 1) << 5)); }
__host__ __device__ __forceinline__ void stage_rc(int b, int& R, int& C) { const int st = b / 1024, sb = b % 1024, swz = sb ^ (((sb >> 9) & 1) << 5); R = (st >> 1) * 16 + swz / 64; C = (st & 1) * 32 + (swz % 64) / 2; }
__host__ __device__ __forceinline__ int perm32(int rho) { const int n = rho >> 4, i = rho & 15; return 8 * (i >> 2) + 4 * n + (i & 3); }

struct GUnit { unsigned A, B; int K, pm, pn, kind, l; };
__device__ __forceinline__ void map_unit(int L, int nM, int nN, int& pm, int& pn) {
    const int nwg = nM * nN; int wgid = L;
    { const int q = nwg / 8, r = nwg % 8, xcd = wgid % 8, off = wgid / 8; wgid = (xcd < r ? xcd * (q + 1) : r * (q + 1) + (xcd - r) * q) + off; }
    const int nig = 8 * nN, gid = wgid / nig, fm = gid * 8, gsz = (nM - fm) < 8 ? (nM - fm) : 8;
    pm = fm + ((wgid % nig) % gsz); pn = (wgid % nig) / gsz;
}

typedef f32x4 Acc[2][2][4][2];

template <class Sched, class Epi>
__device__ __forceinline__ void gemm_phase(LAS unsigned char* lds, const Sched& S, const Epi& E) {
    int tid_ = threadIdx.x; asm volatile("" : "+v"(tid_));
    const int tid = tid_, wid = __builtin_amdgcn_readfirstlane(tid >> 6), lane = tid & 63, wr = wid >> 2, wc = wid & 3, fr = lane & 15, fq = lane >> 4;
    int sR[2], sRb[2], sC[2];
#define PG8_LANECONST(t_) do { _Pragma("unroll") for (int i = 0; i < 2; ++i) { int R, C; stage_rc((t_) * 16 + i * 8192, R, C); sR[i] = R; sRb[i] = (R & ~31) + perm32(R & 31); sC[i] = C; } } while (0)
    PG8_LANECONST(tid);
    const unsigned kstep = (unsigned)(BK * 2);
    const GAS unsigned char* gws = S.ws;
    const unsigned ldsw = (unsigned)wid * 1024u;
    int aoff = lds_byte(wr * 64 + fr, fq * 8), boff = lds_byte(wc * 32 + fr, fq * 8);
#define PG8_SA(b, h) (((b) * 2 + (h)) * HTB)
#define PG8_SB(b, h) ((4 + (b) * 2 + (h)) * HTB)
#define PG8_STAGE(bufoff, goff, v0, v1) do { \
        __builtin_amdgcn_global_load_lds((const GAS unsigned*)(gws + (size_t)((goff) + (v0))), (LAS unsigned*)(lds + (bufoff) + ldsw), 16, 0, 0); \
        __builtin_amdgcn_global_load_lds((const GAS unsigned*)(gws + (size_t)((goff) + (v1))), (LAS unsigned*)(lds + (bufoff) + ldsw + 8192), 16, 0, 0); } while (0)
#define PG8_LDA(dst, b, h) do { _Pragma("unroll") for (int m = 0; m < 4; ++m) _Pragma("unroll") for (int k = 0; k < 2; ++k) dst[m][k] = *(const LAS bf16x8*)(lds + PG8_SA(b, h) + aoff + m * 2048 + k * 1024); } while (0)
#define PG8_LDB(dst, b, h) do { _Pragma("unroll") for (int n = 0; n < 2; ++n) _Pragma("unroll") for (int k = 0; k < 2; ++k) dst[n][k] = *(const LAS bf16x8*)(lds + PG8_SB(b, h) + boff + n * 2048 + k * 1024); } while (0)
#define PG8_MMA(ai, bj, At, Bt) do { __builtin_amdgcn_s_setprio(1); _Pragma("unroll") for (int m = 0; m < 4; ++m) _Pragma("unroll") for (int n = 0; n < 2; ++n) _Pragma("unroll") for (int k = 0; k < 2; ++k) \
        acc[ai][bj][m][n] = __builtin_amdgcn_mfma_f32_16x16x32_bf16(Bt[n][k], At[m][k], acc[ai][bj][m][n], 0, 0, 0); __builtin_amdgcn_s_setprio(0); } while (0)
#define PG8_WAIT_V(n) asm volatile("s_waitcnt vmcnt(" #n ")" ::: "memory")
#define PG8_WAIT_L(n) asm volatile("s_waitcnt lgkmcnt(" #n ")" ::: "memory")
#define PG8_BAR __builtin_amdgcn_s_barrier()
#define PG8_SCHED __builtin_amdgcn_sched_barrier(0)
    GUnit cur, nxt; int ui = 0;
    if (!S.next(0, cur)) return;
    Acc acc;
#pragma unroll
    for (int a = 0; a < 2; ++a)
#pragma unroll
        for (int b = 0; b < 2; ++b)
#pragma unroll
            for (int m = 0; m < 4; ++m)
#pragma unroll
                for (int n = 0; n < 2; ++n) acc[a][b][m][n] = (f32x4){0.f, 0.f, 0.f, 0.f};
    bf16x8 At[4][2], B0[2][2], B1[2][2];
    unsigned vA0 = (unsigned)(sR[0] * cur.K + sC[0]) * 2u, vA1 = (unsigned)(sR[1] * cur.K + sC[1]) * 2u;
    unsigned vB0 = (unsigned)(sRb[0] * cur.K + sC[0]) * 2u, vB1 = (unsigned)(sRb[1] * cur.K + sC[1]) * 2u;
    unsigned hs = (unsigned)HALF * cur.K * 2;
    unsigned cA = cur.A, cB = cur.B;
    PG8_STAGE(PG8_SB(0, 0), cB, vB0, vB1); PG8_STAGE(PG8_SB(0, 1), cB + hs, vB0, vB1); PG8_STAGE(PG8_SA(0, 0), cA, vA0, vA1); PG8_STAGE(PG8_SA(0, 1), cA + hs, vA0, vA1);
    if (wr == 1) PG8_BAR;
    PG8_WAIT_V(2); PG8_BAR;
    PG8_STAGE(PG8_SB(1, 0), cB + kstep, vB0, vB1); PG8_STAGE(PG8_SA(1, 0), cA + kstep, vA0, vA1); PG8_STAGE(PG8_SB(1, 1), cB + hs + kstep, vB0, vB1);
    PG8_WAIT_V(6); PG8_BAR;
    for (;;) {
        { int tq = tid; asm volatile("" : "+v"(tq)); PG8_LANECONST(tq); const int fr_ = tq & 15, fq_ = (tq & 63) >> 4; aoff = lds_byte(wr * 64 + fr_, fq_ * 8); boff = lds_byte(wc * 32 + fr_, fq_ * 8);
          vA0 = (unsigned)(sR[0] * cur.K + sC[0]) * 2u; vA1 = (unsigned)(sR[1] * cur.K + sC[1]) * 2u; vB0 = (unsigned)(sRb[0] * cur.K + sC[0]) * 2u; vB1 = (unsigned)(sRb[1] * cur.K + sC[1]) * 2u; }
        const bool has_next = S.next(ui + 1, nxt);
        if (!has_next) nxt = cur;
        const unsigned nvA0 = (unsigned)(sR[0] * nxt.K + sC[0]) * 2u, nvA1 = (unsigned)(sR[1] * nxt.K + sC[1]) * 2u;
        const unsigned nvB0 = (unsigned)(sRb[0] * nxt.K + sC[0]) * 2u, nvB1 = (unsigned)(sRb[1] * nxt.K + sC[1]) * 2u;
        const unsigned nhs = (unsigned)HALF * nxt.K * 2;
        const unsigned nA = nxt.A, nB = nxt.B;
        const int nt = cur.K >> 6;
        for (int t = 0; t < nt; t += 2) {
            const bool last = (t == nt - 2);
            const unsigned a1 = cA + (unsigned)(t + 1) * kstep;
            const unsigned a2 = last ? nA : cA + (unsigned)(t + 2) * kstep, b2 = last ? nB : cB + (unsigned)(t + 2) * kstep;
            const unsigned a3 = a2 + kstep, b3 = b2 + kstep;
            const unsigned wA0 = last ? nvA0 : vA0, wA1 = last ? nvA1 : vA1, wB0 = last ? nvB0 : vB0, wB1 = last ? nvB1 : vB1;
            const unsigned hs2 = last ? nhs : hs;
            PG8_LDB(B0, 0, 0); PG8_LDB(B1, 0, 1); PG8_SCHED; PG8_LDA(At, 0, 0); PG8_STAGE(PG8_SA(1, 1), a1 + hs, vA0, vA1);
            PG8_WAIT_V(8); PG8_WAIT_L(0); PG8_BAR; PG8_MMA(0, 0, At, B0); PG8_MMA(0, 1, At, B1); PG8_BAR; PG8_SCHED;
            PG8_LDA(At, 0, 1); PG8_STAGE(PG8_SB(0, 0), b2, wB0, wB1); PG8_STAGE(PG8_SB(0, 1), b2 + hs2, wB0, wB1); PG8_STAGE(PG8_SA(0, 0), a2, wA0, wA1);
            PG8_WAIT_V(8); PG8_WAIT_L(0); PG8_BAR; PG8_MMA(1, 0, At, B0); PG8_MMA(1, 1, At, B1); PG8_BAR; PG8_SCHED;
            PG8_LDB(B0, 1, 0); PG8_LDB(B1, 1, 1); PG8_SCHED; PG8_LDA(At, 1, 0); PG8_STAGE(PG8_SA(0, 1), a2 + hs2, wA0, wA1);
            PG8_WAIT_V(8); PG8_WAIT_L(0); PG8_BAR; PG8_MMA(0, 0, At, B0); PG8_MMA(0, 1, At, B1); PG8_BAR; PG8_SCHED;
            PG8_LDA(At, 1, 1); PG8_STAGE(PG8_SB(1, 0), b3, wB0, wB1); PG8_STAGE(PG8_SB(1, 1), b3 + hs2, wB0, wB1); PG8_STAGE(PG8_SA(1, 0), a3, wA0, wA1);
            PG8_WAIT_V(8); PG8_WAIT_L(0); PG8_BAR; PG8_MMA(1, 0, At, B0); PG8_MMA(1, 1, At, B1); PG8_BAR; PG8_SCHED;
        }
        if (wr == 0) PG8_BAR;
        E(acc, cur, wr, wc, fr, fq, tid, (LAS float*)(lds + RING_BYTES + 2048));
        if (!has_next) break;
#pragma unroll
        for (int a = 0; a < 2; ++a)
#pragma unroll
            for (int b = 0; b < 2; ++b)
#pragma unroll
                for (int m = 0; m < 4; ++m)
#pragma unroll
                    for (int n = 0; n < 2; ++n) acc[a][b][m][n] = (f32x4){0.f, 0.f, 0.f, 0.f};
        cur = nxt; cA = nA; cB = nB; hs = nhs; ++ui;
        if (wr == 1) PG8_BAR;
    }
    PG8_WAIT_V(0);
    PG8_BAR;
#undef PG8_SA
#undef PG8_LANECONST
#undef PG8_SB
#undef PG8_STAGE
#undef PG8_LDA
#undef PG8_LDB
#undef PG8_MMA
#undef PG8_WAIT_V
#undef PG8_WAIT_L
#undef PG8_BAR
#undef PG8_SCHED
}

enum Kind { K_HP = 0, K_CKV = 1, K_U = 2, K_VG = 3, K_CQ0 = 4, K_CQ1 = 5, K_Q = 6, K_KV = 7, K_KVC = 8, K_OUT = 9, K_FF1 = 10, K_FF2 = 11 };

__device__ __forceinline__ u32x4 pack8(const f32x4 a, const f32x4 b) { u32x4 w; w.x = cvt_pk_bf16(a[0], a[1]); w.y = cvt_pk_bf16(a[2], a[3]); w.z = cvt_pk_bf16(b[0], b[1]); w.w = cvt_pk_bf16(b[2], b[3]); return w; }
__device__ __forceinline__ float sum4(const f32x4 v) { return (v[0] + v[1]) + (v[2] + v[3]); }
__device__ __forceinline__ float sq8(const f32x4 a, const f32x4 b) { return (a[0] * a[0] + a[1] * a[1]) + (a[2] * a[2] + a[3] * a[3]) + (b[0] * b[0] + b[1] * b[1]) + (b[2] * b[2] + b[3] * b[3]); }

struct Epi {
    GAS unsigned char* ws; GAS float* out; const GAS float* xp; const GAS float* xs;
    bool dry;

    __device__ __forceinline__ void operator()(Acc& acc, const GUnit& u, int wr, int wc, int fr, int fq, int tid, LAS float* tab) const {
        int rowb_ = u.pm * 256 + wr * 64 + fr, colw_ = wc * 32 + 8 * fq;
        asm volatile("" : "+v"(rowb_), "+v"(colw_));
        const int rowb = rowb_, colw = colw_, s = slot_of_tile(u.pm), l = u.l;
        const bool isctx = u.pm < 16;
        GAS float* xout = out + OUT_X;
        const GAS float* stin = nullptr;
        if (u.kind <= K_CQ1) stin = (const GAS float*)(ws + WS_ST1);
        else if (u.kind == K_Q) stin = (const GAS float*)(ws + WS_STQ);
        else if (u.kind == K_KV) stin = (const GAS float*)(ws + WS_STKV);
        else if (u.kind == K_FF1) stin = (const GAS float*)(ws + WS_ST2);
        const int tagv = ((u.kind <= K_CQ1 ? 0 : u.kind) << 20) | (l << 12) | (u.pm << 2) | 1;
        const bool fresh = stin && __builtin_amdgcn_readfirstlane(*(volatile LAS int*)(tab + 256)) != tagv;
        if (fresh) {
            if (tid < 256) { const int row = u.pm * 256 + tid; float rs;
                if (u.kind == K_Q) { const GAS f32x4* sp = (const GAS f32x4*)(stin + (size_t)row * 8); rs = fast_rsqrt((sum4(sp[0]) + sum4(sp[1])) * (1.0f / QRANK) + EPS) * C2; }
                else if (u.kind == K_KV) { const f32x4 t0 = *(const GAS f32x4*)(stin + (size_t)row * 4); rs = fast_rsqrt(sum4(t0) * (1.0f / KVRANK) + EPS); }
                else { const GAS f32x4* sp = (const GAS f32x4*)(stin + (size_t)row * 16); rs = fast_rsqrt(((sum4(sp[0]) + sum4(sp[1])) + (sum4(sp[2]) + sum4(sp[3]))) * (1.0f / DM) + EPS); }
                tab[tid] = rs; }
            asm volatile("s_waitcnt lgkmcnt(0)" ::: "memory"); __builtin_amdgcn_s_barrier(); asm volatile("" ::: "memory");
            if (tid == 0) *(volatile LAS int*)(tab + 256) = tagv;
        }
        const int rl0 = wr * 64 + fr;
        switch (u.kind) {
        case K_HP: case K_CKV: case K_U: case K_VG: case K_CQ0: case K_CQ1: {
            const GAS float* shw = (const GAS float*)(ws + WS_SHW1) + (size_t)l * NSLOT * INP; const int ldshw = INP;
            const LAS f32x2* rope = (const LAS f32x2*)(tab + 512);
            f32x4 sw[2][2];
#pragma unroll
            for (int bj = 0; bj < 2; ++bj) { const float* p = shw + (size_t)s * ldshw + u.pn * 256 + bj * 128 + colw; sw[bj][0] = *(const f32x4*)p; sw[bj][1] = *(const f32x4*)(p + 4); }
            bf16_t* dst; int ldd, coff = 0; float* st = nullptr; int sto = 0, stw = 4;
            if (u.kind == K_HP) { dst = (bf16_t*)(ws + SPLIT(isctx, HP)); ldd = 256; }
            else if (u.kind == K_CKV) { dst = (bf16_t*)(ws + SPLIT(isctx, CKVR)); ldd = 256; st = (float*)(ws + WS_STKV); }
            else if (u.kind == K_U) { dst = (bf16_t*)(ws + SPLIT(isctx, U)); ldd = 256; }
            else if (u.kind == K_VG) { dst = (bf16_t*)(ws + SPLIT(isctx, GL)); ldd = 256; st = (float*)(ws + WS_STG); }
            else if (u.kind == K_CQ0) { dst = (bf16_t*)(ws + SPLIT(isctx, CQ)); ldd = QRANK; st = (float*)(ws + WS_STQ); stw = 8; }
            else { dst = (bf16_t*)(ws + SPLIT(isctx, CQ)); ldd = QRANK; coff = 256; st = (float*)(ws + WS_STQ); stw = 8; sto = 4; }
            const bool act = (u.kind == K_U || u.kind == K_VG);
#pragma unroll
            for (int ai = 0; ai < 2; ++ai)
#pragma unroll
                for (int m = 0; m < 4; ++m) {
                    asm volatile("" ::: "memory");
                    const int row = rowb + ai * 128 + m * 16;
                    const float rs = tab[rl0 + ai * 128 + m * 16];
                    f32x4 v[2][2];
#pragma unroll
                    for (int bj = 0; bj < 2; ++bj)
#pragma unroll
                        for (int n = 0; n < 2; ++n) { v[bj][n] = acc[ai][bj][m][n] * rs + sw[bj][n];
                            if (act) {
#pragma unroll
                                for (int j = 0; j < 4; ++j) v[bj][n][j] = gelu_tanh(v[bj][n][j]); } }
                    if (u.kind != K_CQ1) {
                        *(u32x4*)(dst + (size_t)row * ldd + coff + colw) = pack8(v[0][0], v[0][1]);
                        *(u32x4*)(dst + (size_t)row * ldd + coff + 128 + colw) = pack8(v[1][0], v[1][1]);
                        if (st) { float q = sq8(v[0][0], v[0][1]) + sq8(v[1][0], v[1][1]); q = fq_sum(q); if (fq == 0) st[(size_t)row * stw + sto + wc] = q; }
                        if (u.kind == K_CKV && isctx) {
                            float* o = out + OUT_CKV + ((size_t)(u.pm * DEPTH + l) * LCTX + (row & 255)) * KVRANK + colw;
                            *(f32x4*)o = v[0][0]; *(f32x4*)(o + 4) = v[0][1]; *(f32x4*)(o + 128) = v[1][0]; *(f32x4*)(o + 132) = v[1][1];
                        }
                    } else {
                        *(u32x4*)(dst + (size_t)row * ldd + coff + colw) = pack8(v[0][0], v[0][1]);
                        { float q = sq8(v[0][0], v[0][1]); q = fq_sum(q); if (fq == 0) st[(size_t)row * stw + sto + wc] = q; }
                        if (wc < 2) {
                            const int p0 = colw, i0 = p0 >> 1, t = row & 255;
                            float x[8] = {v[1][0][0], v[1][0][1], v[1][0][2], v[1][0][3], v[1][1][0], v[1][1][1], v[1][1][2], v[1][1][3]};
                            if (isctx) {
                                float* o = out + OUT_KR + ((size_t)(u.pm * DEPTH + l) * LCTX + t) * 64;
#pragma unroll
                                for (int j = 0; j < 4; ++j) { o[i0 + j] = x[2 * j]; o[32 + i0 + j] = x[2 * j + 1]; }
                                u32x4 w; w.x = cvt_pk_bf16(x[0], x[1]); w.y = cvt_pk_bf16(x[2], x[3]); w.z = cvt_pk_bf16(x[4], x[5]); w.w = cvt_pk_bf16(x[6], x[7]);
                                bf16_t* kd = (bf16_t*)(ws + WS_KC) + ((size_t)(u.pm * NH) * LCTX + t) * 192 + 128 + p0;
#pragma unroll
                                for (int h = 0; h < NH; ++h) *(u32x4*)(kd + (size_t)h * LCTX * 192) = w;
                            } else {
                                const int b = (u.pm - 16) >> 3, tl = ((u.pm - 16) & 7) * 256 + t;
                                const int pos = (wc == 0) ? (tl >> 6) : (tl & 63);
                                float y[8];
#pragma unroll
                                for (int j = 0; j < 4; ++j) { const f32x2 cs = rope[pos * 16 + ((i0 + j) & 15)]; y[2 * j] = x[2 * j] * cs.x - x[2 * j + 1] * cs.y; y[2 * j + 1] = x[2 * j + 1] * cs.x + x[2 * j] * cs.y; }
                                u32x4 w; w.x = cvt_pk_bf16(y[0], y[1]); w.y = cvt_pk_bf16(y[2], y[3]); w.z = cvt_pk_bf16(y[4], y[5]); w.w = cvt_pk_bf16(y[6], y[7]);
                                bf16_t* kd = (bf16_t*)(ws + WS_KL) + ((size_t)(b * NH) * LKEY + PAST + tl) * 192 + 128 + p0;
#pragma unroll
                                for (int h = 0; h < NH; ++h) *(u32x4*)(kd + (size_t)h * LKEY * 192) = w;
                            }
                        }
                    }
                }
        } break;
        case K_Q: {
            const LAS f32x2* rope = (const LAS f32x2*)(tab + 512);
            bf16_t* dst = (bf16_t*)(ws + SPLIT(isctx, Q));
#pragma unroll
            for (int ai = 0; ai < 2; ++ai)
#pragma unroll
                for (int m = 0; m < 4; ++m) {
                    asm volatile("" ::: "memory");
                    const int row = rowb + ai * 128 + m * 16;
                    const float rs = tab[rl0 + ai * 128 + m * 16];
#pragma unroll
                    for (int bj = 0; bj < 2; ++bj) {
                        const int c = u.pn * 256 + bj * 128 + colw, w192 = c % 192;
                        f32x4 v0 = acc[ai][bj][m][0] * rs, v1 = acc[ai][bj][m][1] * rs;
                        if (!isctx && w192 >= 128) {
                            const int i0 = (w192 - 128) >> 1, tl = ((u.pm - 16) & 7) * 256 + (row & 255);
                            const int pos = (i0 < 16) ? (tl >> 6) : (tl & 63);
                            float x[8] = {v0[0], v0[1], v0[2], v0[3], v1[0], v1[1], v1[2], v1[3]}, y[8];
#pragma unroll
                            for (int j = 0; j < 4; ++j) { const f32x2 cs = rope[pos * 16 + ((i0 + j) & 15)]; y[2 * j] = x[2 * j] * cs.x - x[2 * j + 1] * cs.y; y[2 * j + 1] = x[2 * j + 1] * cs.x + x[2 * j] * cs.y; }
                            v0 = (f32x4){y[0], y[1], y[2], y[3]}; v1 = (f32x4){y[4], y[5], y[6], y[7]};
                        }
                        *(u32x4*)(dst + (size_t)row * QW + c) = pack8(v0, v1);
                    }
                }
        } break;
        case K_KV: case K_KVC: {
            const int h = u.pn;
            bf16_t *kd, *vd; int ldrow;
            if (u.kind == K_KVC) { kd = (bf16_t*)(ws + WS_KL) + ((size_t)(u.pm * NH + h) * LKEY) * 192; vd = (bf16_t*)(ws + WS_VL) + ((size_t)(u.pm * NH + h) * LKEY) * 128; }
            else if (isctx) { kd = (bf16_t*)(ws + WS_KC) + ((size_t)(u.pm * NH + h) * LCTX) * 192; vd = (bf16_t*)(ws + WS_VC) + ((size_t)(u.pm * NH + h) * LCTX) * 128; }
            else { const int b = (u.pm - 16) >> 3, k0 = PAST + ((u.pm - 16) & 7) * 256; kd = (bf16_t*)(ws + WS_KL) + ((size_t)(b * NH + h) * LKEY + k0) * 192; vd = (bf16_t*)(ws + WS_VL) + ((size_t)(b * NH + h) * LKEY + k0) * 128; }
            (void)ldrow;
#pragma unroll
            for (int ai = 0; ai < 2; ++ai)
#pragma unroll
                for (int m = 0; m < 4; ++m) {
                    asm volatile("" ::: "memory");
                    const int row = rowb + ai * 128 + m * 16, rl = row & 255;
                    float rs = 1.0f;
                    if (u.kind == K_KV) rs = tab[rl0 + ai * 128 + m * 16];
                    *(u32x4*)(kd + (size_t)rl * 192 + colw) = pack8(acc[ai][0][m][0] * rs, acc[ai][0][m][1] * rs);
                    *(u32x4*)(vd + (size_t)rl * 128 + colw) = pack8(acc[ai][1][m][0] * rs, acc[ai][1][m][1] * rs);
                }
        } break;
        case K_OUT: case K_FF2: {
            const GAS float *gate, *gmn; GAS float* stout;
            if (u.kind == K_OUT) { gate = (const GAS float*)(ws + WS_G1) + (size_t)l * NSLOT * DM; gmn = (const GAS float*)(ws + WS_GM2) + (size_t)l * NSLOT * DM; stout = (GAS float*)(ws + WS_ST2); }
            else { gate = (const GAS float*)(ws + WS_G2) + (size_t)l * NSLOT * DM; gmn = (l + 1 < DEPTH) ? (const GAS float*)(ws + WS_GM1) + (size_t)(l + 1) * NSLOT * DM : nullptr; stout = (GAS float*)(ws + WS_ST1); }
            const bool in32 = (u.kind == K_OUT && l == 0);
            const GAS float* xin = isctx ? xp : xs - (size_t)NCTX * DM;
            GAS bf16_t* xb = (GAS bf16_t*)(ws + WS_XB);
            bf16_t* xg = (bf16_t*)(ws + WS_XG);
            const unsigned cb = (unsigned)(u.pn * 256 + colw);
            const float* gp = gate + (size_t)s * DM + cb; const float* mp_ = gmn ? gmn + (size_t)s * DM + cb : gp;
            if (!in32) {
                GAS unsigned char* const XBB = (GAS unsigned char*)xb; GAS unsigned char* const XGB = (GAS unsigned char*)xg;
                float qa[8];
#pragma unroll
                for (int bj = 0; bj < 2; ++bj) {
                    asm volatile("" ::: "memory");
                    const f32x4 gtA = *(const f32x4*)(gp + bj * 128), gtB = *(const f32x4*)(gp + bj * 128 + 4), gmA = *(const f32x4*)(mp_ + bj * 128), gmB = *(const f32x4*)(mp_ + bj * 128 + 4);
                    u32x4 rb[8];
#pragma unroll
                    for (int r = 0; r < 8; ++r) { const unsigned eb = ((unsigned)(rowb + (r >> 2) * 128 + (r & 3) * 16) * (unsigned)DM + cb + (unsigned)(bj * 128)) * 2u; rb[r] = *(const GAS u32x4*)(XBB + eb); }
                    asm volatile("" ::: "memory");
#pragma unroll
                    for (int r = 0; r < 8; ++r) { const int ai = r >> 2, m = r & 3; const unsigned eb = ((unsigned)(rowb + ai * 128 + m * 16) * (unsigned)DM + cb + (unsigned)(bj * 128)) * 2u;
                        const u32x4 b = rb[r];
                        const f32x4 x0 = (f32x4){bf_lo(b.x), bf_hi(b.x), bf_lo(b.y), bf_hi(b.y)} + gtA * acc[ai][bj][m][0], x1 = (f32x4){bf_lo(b.z), bf_hi(b.z), bf_lo(b.w), bf_hi(b.w)} + gtB * acc[ai][bj][m][1];
                        if (!dry) *(GAS u32x4*)(XBB + eb) = pack8(x0, x1);
                        if (gmn && !dry) *(GAS u32x4*)(XGB + eb) = pack8(x0 * gmA, x1 * gmB);
                        float q_ = sq8(x0, x1); asm volatile("" : "+v"(q_));
                        if (bj == 0) qa[r] = q_;
                        else { const float q = fq_sum(qa[r] + q_); if (fq == 0 && !dry) stout[(size_t)(rowb + ai * 128 + m * 16) * 16 + u.pn * 4 + wc] = q; }
                        asm volatile("" ::: "memory"); }
                }
            } else {
            const f32x4 gt00 = *(const f32x4*)gp, gt01 = *(const f32x4*)(gp + 4), gt10 = *(const f32x4*)(gp + 128), gt11 = *(const f32x4*)(gp + 132);
#pragma unroll
            for (int ai = 0; ai < 2; ++ai)
#pragma unroll
                for (int mp = 0; mp < 2; ++mp) {
                    asm volatile("" ::: "memory");
                    const unsigned e0 = (unsigned)(rowb + ai * 128 + (2 * mp) * 16) * (unsigned)DM + cb, e1 = e0 + 16u * DM;
                    f32x4 r000, r001, r010, r011, r100, r101, r110, r111;
                    if (in32) {
                        r000 = *(const GAS f32x4*)(xin + e0); r001 = *(const GAS f32x4*)(xin + e0 + 4); r010 = *(const GAS f32x4*)(xin + e0 + 128); r011 = *(const GAS f32x4*)(xin + e0 + 132);
                        r100 = *(const GAS f32x4*)(xin + e1); r101 = *(const GAS f32x4*)(xin + e1 + 4); r110 = *(const GAS f32x4*)(xin + e1 + 128); r111 = *(const GAS f32x4*)(xin + e1 + 132);
                    } else {
                        const u32x4 b00 = *(const GAS u32x4*)(xb + e0), b01 = *(const GAS u32x4*)(xb + e0 + 128), b10 = *(const GAS u32x4*)(xb + e1), b11 = *(const GAS u32x4*)(xb + e1 + 128);
                        r000 = (f32x4){bf_lo(b00.x), bf_hi(b00.x), bf_lo(b00.y), bf_hi(b00.y)}; r001 = (f32x4){bf_lo(b00.z), bf_hi(b00.z), bf_lo(b00.w), bf_hi(b00.w)};
                        r010 = (f32x4){bf_lo(b01.x), bf_hi(b01.x), bf_lo(b01.y), bf_hi(b01.y)}; r011 = (f32x4){bf_lo(b01.z), bf_hi(b01.z), bf_lo(b01.w), bf_hi(b01.w)};
                        r100 = (f32x4){bf_lo(b10.x), bf_hi(b10.x), bf_lo(b10.y), bf_hi(b10.y)}; r101 = (f32x4){bf_lo(b10.z), bf_hi(b10.z), bf_lo(b10.w), bf_hi(b10.w)};
                        r110 = (f32x4){bf_lo(b11.x), bf_hi(b11.x), bf_lo(b11.y), bf_hi(b11.y)}; r111 = (f32x4){bf_lo(b11.z), bf_hi(b11.z), bf_lo(b11.w), bf_hi(b11.w)};
                    }
                    const f32x4 gm00 = *(const f32x4*)mp_, gm01 = *(const f32x4*)(mp_ + 4), gm10 = *(const f32x4*)(mp_ + 128), gm11 = *(const f32x4*)(mp_ + 132);
                    {   const int m = 2 * mp;
                        const f32x4 x00 = r000 + gt00 * acc[ai][0][m][0], x01 = r001 + gt01 * acc[ai][0][m][1], x10 = r010 + gt10 * acc[ai][1][m][0], x11 = r011 + gt11 * acc[ai][1][m][1];
                        if (!dry) { *(GAS u32x4*)(xb + e0) = pack8(x00, x01); *(GAS u32x4*)(xb + e0 + 128) = pack8(x10, x11); }
                        if (gmn && !dry) { *(u32x4*)(xg + e0) = pack8(x00 * gm00, x01 * gm01); *(u32x4*)(xg + e0 + 128) = pack8(x10 * gm10, x11 * gm11); }
                        float q = sq8(x00, x01) + sq8(x10, x11); q = fq_sum(q);
                        if (fq == 0 && !dry) stout[(size_t)(rowb + ai * 128 + m * 16) * 16 + u.pn * 4 + wc] = q; }
                    {   const int m = 2 * mp + 1;
                        const f32x4 x00 = r100 + gt00 * acc[ai][0][m][0], x01 = r101 + gt01 * acc[ai][0][m][1], x10 = r110 + gt10 * acc[ai][1][m][0], x11 = r111 + gt11 * acc[ai][1][m][1];
                        if (!dry) { *(GAS u32x4*)(xb + e1) = pack8(x00, x01); *(GAS u32x4*)(xb + e1 + 128) = pack8(x10, x11); }
                        if (gmn && !dry) { *(u32x4*)(xg + e1) = pack8(x00 * gm00, x01 * gm01); *(u32x4*)(xg + e1 + 128) = pack8(x10 * gm10, x11 * gm11); }
                        float q = sq8(x00, x01) + sq8(x10, x11); q = fq_sum(q);
                        if (fq == 0 && !dry) stout[(size_t)(rowb + ai * 128 + m * 16) * 16 + u.pn * 4 + wc] = q; }
                }
            }
        } break;
        case K_FF1: {
            const GAS float* shw = (const GAS float*)(ws + WS_SHW2) + (size_t)l * NSLOT * DFF; const int ldshw = DFF;
            f32x4 sw[2][2];
#pragma unroll
            for (int bj = 0; bj < 2; ++bj) { const float* p = shw + (size_t)s * ldshw + u.pn * 256 + bj * 128 + colw; sw[bj][0] = *(const f32x4*)p; sw[bj][1] = *(const f32x4*)(p + 4); }
            bf16_t* dst = (bf16_t*)(ws + SPLIT(isctx, HID));
#pragma unroll
            for (int ai = 0; ai < 2; ++ai)
#pragma unroll
                for (int m = 0; m < 4; ++m) {
                    asm volatile("" ::: "memory");
                    const int row = rowb + ai * 128 + m * 16;
                    const float rs = tab[rl0 + ai * 128 + m * 16];
#pragma unroll
                    for (int bj = 0; bj < 2; ++bj) {
                        f32x4 v0 = acc[ai][bj][m][0] * rs + sw[bj][0], v1 = acc[ai][bj][m][1] * rs + sw[bj][1];
#pragma unroll
                        for (int j = 0; j < 4; ++j) { const float a = fmaxf(v0[j], 0.f), b = fmaxf(v1[j], 0.f); v0[j] = a * a; v1[j] = b * b; }
                        *(u32x4*)(dst + (size_t)row * DFF + u.pn * 256 + bj * 128 + colw) = pack8(v0, v1);
                    }
                }
        } break;
        default: break;
        }
    }
};

struct GList { size_t aoff, boff; int K, nM, nN, pm0, kind, l, n0, q0, q1; };
#define GL_(ao, bo, K_, nM_, nN_, pm0_, kind_, l_, n0_, q0_, q1_) do { g.aoff = (ao); g.boff = (bo); g.K = (K_); g.nM = (nM_); g.nN = (nN_); g.pm0 = (pm0_); g.kind = (kind_); g.l = (l_); g.n0 = (n0_); g.q0 = (q0_); g.q1 = (q1_); return true; } while (0)
__device__ __forceinline__ bool slot_list(int sub, int j, int l, GList& g) {
    const size_t oWIN = WS_WIN + (size_t)l * INP * DM * 2, oWUQ = WS_WUQ + (size_t)l * QW * QRANK * 2, oWKVF = WS_WKVF + (size_t)l * KVW * KVRANK * 2, oWKVC = WS_WKVC + (size_t)l * KVW * KVRANK * 2;
    const size_t oWOUT = WS_WOUT + (size_t)l * DM * DM * 2, oWF1 = WS_WF1 + (size_t)l * DFF * DM * 2, oWF2 = WS_WF2 + (size_t)l * DM * DFF * 2;
    switch (sub) {
    case -1: if (j == 0) GL_(WS_XG, oWIN, DM, 16, 6, 0, -1, 0, 12, 1, 0); break;
    case 0:  if (j == 0) GL_(WS_XG, oWIN, DM, 64, 6, 16, -1, l, 16, 2, 1);
             if (j == 1) GL_(CQ_C, oWUQ, QRANK, 16, 3, 0, K_Q, l, 16, 0, 1);
             if (j == 2) GL_(CKVR_C, oWKVF, KVRANK, 16, 4, 0, K_KV, l, 22, 0, 1); break;
    case 1:  if (j == 0) GL_(CQ_L, oWUQ, QRANK, 64, 3, 16, K_Q, l, 24, 1, 0);
             if (j == 1) GL_(CKVR_L, oWKVF, KVRANK, 64, 4, 16, K_KV, l, 32, 1, 0);
             if (j == 2) GL_(WS_CCKV + (size_t)l * NLATB * PAST * KVRANK * 2, oWKVC, KVRANK, 8, 4, 0, K_KVC, l, 4, 1, 0); break;
    case 2:  if (j == 0) GL_(YCAT_C, oWOUT, DM, 16, 4, 0, K_OUT, l, 8, 1, 0); break;
    case 3:  if (j == 0) GL_(YCAT_L, oWOUT, DM, 64, 4, 16, K_OUT, l, 32, 1, 0);
             if (j == 1) GL_(WS_XG, oWF1, DM, 16, 16, 0, K_FF1, l, 32, 1, 0); break;
    case 4:  if (j == 0) GL_(HID_C, oWF2, DFF, 16, 4, 0, K_FF2, l, 8, 1, 0);
             if (j == 1) GL_(WS_XG, oWF1, DM, 64, 16, 16, K_FF1, l, 8, 1, -5); break;
    default: if (j == 0) GL_(HID_L, oWF2, DFF, 64, 4, 16, K_FF2, l, 32, 1, 0);
             if (j == 1 && l + 1 < DEPTH) GL_(WS_XG, oWIN + (size_t)INP * DM * 2, DM, 16, 6, 0, -1, l + 1, 12, 1, 0); break;
    }
    return false;
}
#undef GL_
struct SchedSlot {
    const GAS unsigned char* ws; int c, G, sub, l;
    __device__ __forceinline__ bool next(int i, GUnit& u) const {
        int k = i;
        const int x = c >> 5, li = c & 31;
#pragma unroll
        for (int j = 0; j < 3; ++j) {
            GList g; if (!slot_list(sub, (sub == 3 && (c & 1)) ? (j ^ 1) : j, l, g)) { if (sub == 3 && j < 2) continue; return false; }
            int pm, pn; bool hit = false;
            if (G == 256) {
                const int rM = g.nM >> 3, n = rM * g.nN;
                if (g.q1 < 0) {
                    const int qa = -g.q1, t = li - g.n0, qe = li < g.n0 ? g.q0 : qa;
                    if (k < qe) { pm = g.pm0 + rM * x + (li < g.n0 ? li % rM : t % rM); pn = li < g.n0 ? ((32 - g.n0) / rM) * qa + li / rM : (t / rM) * qa + k; hit = true; } else k -= qe;
                } else {
                const int q = li < g.n0 ? g.q0 : g.q1, start = li < g.n0 ? li * g.q0 : g.n0 * g.q0 + (li - g.n0) * g.q1;
                int qe = n - start; qe = qe < 0 ? 0 : (qe < q ? qe : q);
                if (k < qe) { const int lidx = start + k; pm = g.pm0 + rM * x + (lidx % rM); pn = lidx / rM; hit = true; } else k -= qe;
                }
            } else {
                const int n = g.nM * g.nN, q = (n + G - 1) / G, start = c * q;
                int qe = n - start; qe = qe < 0 ? 0 : (qe < q ? qe : q);
                if (k < qe) { const int idx = start + k; pm = g.pm0 + idx % g.nM; pn = idx / g.nM; hit = true; } else k -= qe;
            }
            if (hit) { u.A = (unsigned)(g.aoff + (size_t)pm * 256 * g.K * 2); u.B = (unsigned)(g.boff + (size_t)pn * 256 * g.K * 2); u.K = g.K; u.pm = pm; u.pn = pn; u.kind = g.kind < 0 ? pn : g.kind; u.l = g.l; return true; }
        }
        return false;
    }
};

#define KSWZ(row, colB) ((row) * 256 + ((colB) ^ (((row) & 15) << 4)))
#define KRSWZ(row, colB) ((row) * 128 + ((colB) ^ ((((row) >> 1) & 7) << 4)))
__device__ __forceinline__ int crow(int r, int hi) { return (r & 3) + 8 * (r >> 2) + 4 * hi; }
__device__ __forceinline__ int v_rd_base(int lane) { return ((lane & 3) << 3) | (((lane >> 2) & 3) << 6) | (((lane >> 4) & 1) << 5) | (((lane >> 5) & 1) << 8); }
constexpr int v_rd_off(int d0, int ks, int half) { return d0 * 512 + ks * 4096 + half * 2048; }
template <int OFF> __device__ __forceinline__ s16x4 tr_read(int vb) { s16x4 r; asm volatile("ds_read_b64_tr_b16 %0, %1 offset:%2" : "=&v"(r) : "v"(vb), "i"(OFF) : "memory"); return r; }
struct VFrag { s16x4 l0, h0, l1, h1, l2, h2, l3, h3; };
template <int D0> __device__ __forceinline__ void pv_read(VFrag& f, int vb) {
    f.l0 = tr_read<v_rd_off(D0, 0, 0)>(vb); f.h0 = tr_read<v_rd_off(D0, 0, 1)>(vb); f.l1 = tr_read<v_rd_off(D0, 1, 0)>(vb); f.h1 = tr_read<v_rd_off(D0, 1, 1)>(vb);
    f.l2 = tr_read<v_rd_off(D0, 2, 0)>(vb); f.h2 = tr_read<v_rd_off(D0, 2, 1)>(vb); f.l3 = tr_read<v_rd_off(D0, 3, 0)>(vb); f.h3 = tr_read<v_rd_off(D0, 3, 1)>(vb);
}
__device__ __forceinline__ void pv_wait(VFrag& f) {
    asm volatile("s_waitcnt lgkmcnt(0)" : "+v"(f.l0), "+v"(f.h0), "+v"(f.l1), "+v"(f.h1), "+v"(f.l2), "+v"(f.h2), "+v"(f.l3), "+v"(f.h3) :: "memory"); SBAR();
}
__device__ __forceinline__ void pv_mma(f32x16& od, const VFrag& f, bf16x8 pa0, bf16x8 pa1, bf16x8 pa2, bf16x8 pa3) {
#define PK(L, H) (bf16x8){L[0], L[1], L[2], L[3], H[0], H[1], H[2], H[3]}
    od = __builtin_amdgcn_mfma_f32_32x32x16_bf16(pa0, PK(f.l0, f.h0), od, 0, 0, 0);
    od = __builtin_amdgcn_mfma_f32_32x32x16_bf16(pa1, PK(f.l1, f.h1), od, 0, 0, 0);
    od = __builtin_amdgcn_mfma_f32_32x32x16_bf16(pa2, PK(f.l2, f.h2), od, 0, 0, 0);
    od = __builtin_amdgcn_mfma_f32_32x32x16_bf16(pa3, PK(f.l3, f.h3), od, 0, 0, 0);
#undef PK
}
constexpr int A_V = 0, A_KN = 32768, A_KR = 65536, A_WS = 81920, A_OST = 0;
constexpr float ATT_THR = 6.0f;
__device__ __forceinline__ void attn_unit(LAS unsigned char* ldsb, const GAS bf16_t* __restrict__ Qb, const GAS bf16_t* __restrict__ Kh, const GAS bf16_t* __restrict__ Vh, GAS bf16_t* __restrict__ Ob, int seq) {
    int tid_ = threadIdx.x; asm volatile("" : "+v"(tid_));
    const int tid = tid_, wid = __builtin_amdgcn_readfirstlane(tid >> 6), lane = tid & 63, r32 = lane & 31, hi = lane >> 5;
    char* lds = (char*)ldsb;
    char* Kn_lds = lds + A_KN; char* Kr_lds = lds + A_KR;
    float* wsf = (float*)(lds + A_WS) + wid * 64; float* li_l = wsf; float* al_l = wsf + 32;
    float m_reg = -1e30f, l_reg = 0.f; f32x16 o[4] = {}; bf16x8 qr[12];
    const GAS bf16_t* Qw = Qb + (size_t)(wid * 32 + r32) * QW + hi * 8;
#pragma unroll
    for (int d0 = 0; d0 < 12; ++d0) qr[d0] = *(const GAS bf16x8*)(Qw + d0 * 16);
#pragma unroll
    for (int d0 = 0; d0 < 12; ++d0) asm volatile("" : "+v"(qr[d0]));
    unsigned gk0, gk1, gkr, gv0, gv1;
    { int r = 4 * wid + (lane >> 4), c = (lane & 15) ^ (r & 15); gk0 = (unsigned)(r * 192 + c * 8);
      r = 4 * (wid + 8) + (lane >> 4); c = (lane & 15) ^ (r & 15); gk1 = (unsigned)(r * 192 + c * 8);
      r = 8 * wid + (lane >> 3); c = (lane & 7) ^ ((r >> 1) & 7); gkr = (unsigned)(r * 192 + 128 + c * 8);
      int p = wid, kk = (p >> 1) * 8 + ((lane & 31) >> 2), k = (kk & ~0xC) | ((kk & 4) << 1) | ((kk & 8) >> 1); gv0 = (unsigned)(k * 128 + (2 * (p & 1) + (lane >> 5)) * 32 + (lane & 3) * 8);
      p = wid + 8; kk = (p >> 1) * 8 + ((lane & 31) >> 2); k = (kk & ~0xC) | ((kk & 4) << 1) | ((kk & 8) >> 1); gv1 = (unsigned)(k * 128 + (2 * (p & 1) + (lane >> 5)) * 32 + (lane & 3) * 8); }
    const int vb0 = (int)(uintptr_t)(lds + A_V) + v_rd_base(lane);
#define ADMA(k0, b) do { const GAS bf16_t* kt = Kh + (size_t)(k0) * 192; const GAS bf16_t* vt = Vh + (size_t)(k0) * 128; \
        __builtin_amdgcn_global_load_lds((const GAS unsigned*)(kt + gk0), (LAS unsigned*)(ldsb + A_KN + (b) * 16384 + wid * 1024), 16, 0, 0); \
        __builtin_amdgcn_global_load_lds((const GAS unsigned*)(kt + gk1), (LAS unsigned*)(ldsb + A_KN + (b) * 16384 + (wid + 8) * 1024), 16, 0, 0); \
        __builtin_amdgcn_global_load_lds((const GAS unsigned*)(kt + gkr), (LAS unsigned*)(ldsb + A_KR + (b) * 8192 + wid * 1024), 16, 0, 0); \
        __builtin_amdgcn_global_load_lds((const GAS unsigned*)(vt + gv0), (LAS unsigned*)(ldsb + A_V + (b) * 16384 + wid * 1024), 16, 0, 0); \
        __builtin_amdgcn_global_load_lds((const GAS unsigned*)(vt + gv1), (LAS unsigned*)(ldsb + A_V + (b) * 16384 + (wid + 8) * 1024), 16, 0, 0); } while (0)
#define AWAITBAR() do { asm volatile("s_waitcnt vmcnt(0) lgkmcnt(0)" ::: "memory"); __builtin_amdgcn_s_barrier(); asm volatile("" ::: "memory"); } while (0)
    const int NT = seq / 64;
    ADMA(0, 0); AWAITBAR();
    for (int j = 0; j < NT; ++j) {
        const int cb = j & 1;
        if (j + 1 < NT) ADMA((j + 1) * 64, cb ^ 1);
        f32x16 p0 = {}, p1 = {};
        { const char* Kn = Kn_lds + cb * 16384; const char* Kr = Kr_lds + cb * 8192;
#define KFRAG(G, I, ROWOFF) ((G) < 4 ? *(const bf16x8*)(Kn + KSWZ((ROWOFF) + r32, ((2 * (G) + (I)) * 16 + hi * 8) * 2)) : *(const bf16x8*)(Kr + KRSWZ((ROWOFF) + r32, ((2 * ((G) - 4) + (I)) * 16 + hi * 8) * 2)))
#define KLOADG(G, X0, X1, Y0, Y1) do { X0 = KFRAG(G, 0, 0); Y0 = KFRAG(G, 0, 32); X1 = KFRAG(G, 1, 0); Y1 = KFRAG(G, 1, 32); } while (0)
#define KPIN(X0, X1, Y0, Y1) asm volatile("" : "+v"(X0), "+v"(Y0), "+v"(X1), "+v"(Y1))
#define KMMAG(G, X0, X1, Y0, Y1) do { \
              p0 = __builtin_amdgcn_mfma_f32_32x32x16_bf16(X0, qr[2 * (G)], p0, 0, 0, 0); p1 = __builtin_amdgcn_mfma_f32_32x32x16_bf16(Y0, qr[2 * (G)], p1, 0, 0, 0); \
              p0 = __builtin_amdgcn_mfma_f32_32x32x16_bf16(X1, qr[2 * (G) + 1], p0, 0, 0, 0); p1 = __builtin_amdgcn_mfma_f32_32x32x16_bf16(Y1, qr[2 * (G) + 1], p1, 0, 0, 0); } while (0)
          bf16x8 fa0, fa1, fb0, fb1, ga0, ga1, gb0, gb1;
          KLOADG(0, fa0, fa1, fb0, fb1); SBAR(); KPIN(fa0, fa1, fb0, fb1); SBAR();
          KLOADG(1, ga0, ga1, gb0, gb1); SBAR(); KMMAG(0, fa0, fa1, fb0, fb1); SBAR(); KPIN(ga0, ga1, gb0, gb1); SBAR();
          KLOADG(2, fa0, fa1, fb0, fb1); SBAR(); KMMAG(1, ga0, ga1, gb0, gb1); SBAR(); KPIN(fa0, fa1, fb0, fb1); SBAR();
          KLOADG(3, ga0, ga1, gb0, gb1); SBAR(); KMMAG(2, fa0, fa1, fb0, fb1); SBAR(); KPIN(ga0, ga1, gb0, gb1); SBAR();
          KLOADG(4, fa0, fa1, fb0, fb1); SBAR(); KMMAG(3, ga0, ga1, gb0, gb1); SBAR(); KPIN(fa0, fa1, fb0, fb1); SBAR();
          KLOADG(5, ga0, ga1, gb0, gb1); SBAR(); KMMAG(4, fa0, fa1, fb0, fb1); SBAR(); KPIN(ga0, ga1, gb0, gb1); SBAR();
          KMMAG(5, ga0, ga1, gb0, gb1); SBAR();
#undef KPIN
#undef KFRAG
#undef KLOADG
#undef KMMAG
        }
        float pmax = p0[0];
#pragma unroll
        for (int r = 1; r < 16; ++r) pmax = fmaxf(pmax, p0[r]);
#pragma unroll
        for (int r = 0; r < 16; ++r) pmax = fmaxf(pmax, p1[r]);
        { auto rr = __builtin_amdgcn_permlane32_swap(__float_as_uint(pmax), __float_as_uint(pmax), false, false); pmax = fmaxf(__uint_as_float(rr[0]), __uint_as_float(rr[1])); }
        float alpha = 1.f;
        if (!__all(pmax - m_reg <= ATT_THR)) { const float mn = fmaxf(m_reg, pmax); alpha = __builtin_amdgcn_exp2f(m_reg - mn); m_reg = mn; }
        float ps = 0.f;
#pragma unroll
        for (int r = 0; r < 16; ++r) { p0[r] = __builtin_amdgcn_exp2f(p0[r] - m_reg); p1[r] = __builtin_amdgcn_exp2f(p1[r] - m_reg); ps += p0[r] + p1[r]; }
        { auto rr = __builtin_amdgcn_permlane32_swap(__float_as_uint(ps), __float_as_uint(ps), false, false); ps = __uint_as_float(rr[0]) + __uint_as_float(rr[1]); }
        l_reg = l_reg * alpha + ps;
        bf16x8 pa0, pa1, pa2, pa3;
#define PK4(P, BASE, OUT) do { unsigned a0 = cvt_pk_bf16(P[BASE + 0], P[BASE + 1]), a1 = cvt_pk_bf16(P[BASE + 2], P[BASE + 3]);   \
        unsigned b0 = cvt_pk_bf16(P[BASE + 4], P[BASE + 5]), b1 = cvt_pk_bf16(P[BASE + 6], P[BASE + 7]);                              \
        auto r0 = __builtin_amdgcn_permlane32_swap(a0, b0, false, false); auto r1 = __builtin_amdgcn_permlane32_swap(a1, b1, false, false); \
        u32x4 w = {r0[0], r1[0], r0[1], r1[1]}; OUT = *reinterpret_cast<bf16x8*>(&w); } while (0)
        PK4(p0, 0, pa0); PK4(p0, 8, pa1); PK4(p1, 0, pa2); PK4(p1, 8, pa3);
#undef PK4
        if (__any(alpha < 1.f)) { if (hi == 0) al_l[r32] = alpha; LDS_WAIT();
#pragma unroll
            for (int d = 0; d < 4; ++d)
#pragma unroll
                for (int r = 0; r < 16; ++r) o[d][r] *= al_l[crow(r, hi)]; }
        { const int vb = vb0 + cb * 16384;
          VFrag va, vc;
          pv_read<0>(va, vb); pv_wait(va);
          pv_read<1>(vc, vb); SBAR(); pv_mma(o[0], va, pa0, pa1, pa2, pa3); SBAR(); pv_wait(vc);
          pv_read<2>(va, vb); SBAR(); pv_mma(o[1], vc, pa0, pa1, pa2, pa3); SBAR(); pv_wait(va);
          pv_read<3>(vc, vb); SBAR(); pv_mma(o[2], va, pa0, pa1, pa2, pa3); SBAR(); pv_wait(vc);
          pv_mma(o[3], vc, pa0, pa1, pa2, pa3); SBAR(); }
        AWAITBAR();
    }
#undef ADMA
#undef AWAITBAR
    if (hi == 0) li_l[r32] = l_reg; LDS_WAIT();
    float rli[16];
#pragma unroll
    for (int r = 0; r < 16; ++r) rli[r] = __builtin_amdgcn_rcpf(li_l[crow(r, hi)]);
    bf16_t* stg = (bf16_t*)(lds + A_OST) + wid * 4096;
#pragma unroll
    for (int r = 0; r < 16; ++r) { const int orow = crow(r, hi);
#pragma unroll
        for (int d0 = 0; d0 < 4; ++d0) stg[orow * 128 + d0 * 32 + r32] = f2bf(o[d0][r] * rli[r]); }
    LDS_WAIT();
#pragma unroll
    for (int i = 0; i < 8; ++i) { const int id = lane + 64 * i, row = id >> 4, ch = id & 15; const u32x4 v = *(const u32x4*)(stg + row * 128 + ch * 8); *(GAS u32x4*)(Ob + (size_t)(wid * 32 + row) * DM + ch * 8) = v; }
    LDS_WAIT();
    __syncthreads();
}

__device__ __forceinline__ void pool_unit(const Ctx& F, int l, int pm, int g0, int g1) {
    char* lds = (char*)F.lds;
    int tid_ = threadIdx.x; asm volatile("" : "+v"(tid_));
    const int tid = tid_, lane = tid & 63, wid = __builtin_amdgcn_readfirstlane(tid >> 6), fr = lane & 15, fq = lane >> 4;
    const bool isctx0 = pm < 16;
    const bf16_t* HP = wsp<const bf16_t>(F, SPLIT(isctx0, HP)); bf16_t* Y = wsp<bf16_t>(F, SPLIT(isctx0, YCAT));
    const bf16_t* WPT = wsp<const bf16_t>(F, WS_WPT) + (size_t)l * 4 * 4096;
    const float* pscale = GIN(11) + (size_t)l * 256;
    const int row0 = pm * 256; const bool isctx = pm < 16;
    const int L = isctx ? LCTX : LLAT, t0 = isctx ? 0 : ((pm - 16) & 7) * 256, seq0 = row0 - t0;
    bf16_t* hbuf = (bf16_t*)lds; bf16_t* abuf = (bf16_t*)(lds + 36864);
    for (int g = g0; g < g1; ++g) {
        const int w = 2 << g, hw = w >> 1;
        u32x4 hv[5];
#pragma unroll
        for (int i = 0; i < 5; ++i) { const int id = tid + 512 * i, rr = id >> 3, ch = id & 7, t = t0 - 8 + rr;
            hv[i] = (u32x4){0u, 0u, 0u, 0u}; if (id < 272 * 8 && t >= 0 && t < L) hv[i] = *(const u32x4*)(HP + (size_t)(seq0 + t) * 256 + g * 64 + ch * 8); }
        bf16x8 xa[2][4]; f32x4 psc[4];
#pragma unroll
        for (int ks = 0; ks < 2; ++ks)
#pragma unroll
            for (int nb = 0; nb < 4; ++nb) xa[ks][nb] = *(const bf16x8*)(WPT + (size_t)g * 4096 + (nb * 16 + fr) * 64 + ks * 32 + fq * 8);
#pragma unroll
        for (int nb = 0; nb < 4; ++nb) psc[nb] = *(const f32x4*)(pscale + g * 64 + nb * 16 + 4 * fq);
#pragma unroll
        for (int i = 0; i < 5; ++i) { const int id = tid + 512 * i, rr = id >> 3, ch = id & 7; if (id < 272 * 8) *(u32x4*)(hbuf + rr * 64 + ch * 8) = hv[i]; }
        __syncthreads();
#pragma unroll
        for (int it = 0; it < 4; ++it) { const int id = tid + 512 * it, tt = id >> 3, ch = id & 7, t = t0 + tt;
            const int lo = max(t - hw, 0), hiw = min(t + hw, L); float s[8] = {0, 0, 0, 0, 0, 0, 0, 0};
            for (int dq = -hw; dq < hw; ++dq) { const int q = t + dq; if (q >= lo && q < hiw) { const u32x4 v = *(const u32x4*)(hbuf + (tt + dq + 8) * 64 + ch * 8);
                s[0] += bf_lo(v.x); s[1] += bf_hi(v.x); s[2] += bf_lo(v.y); s[3] += bf_hi(v.y); s[4] += bf_lo(v.z); s[5] += bf_hi(v.z); s[6] += bf_lo(v.w); s[7] += bf_hi(v.w); } }
            const float ic = __builtin_amdgcn_rcpf((float)(hiw - lo)); const u32x4 c = *(const u32x4*)(hbuf + (tt + 8) * 64 + ch * 8);
            u32x4 o; o.x = cvt_pk_bf16(s[0] * ic - bf_lo(c.x), s[1] * ic - bf_hi(c.x)); o.y = cvt_pk_bf16(s[2] * ic - bf_lo(c.y), s[3] * ic - bf_hi(c.y));
            o.z = cvt_pk_bf16(s[4] * ic - bf_lo(c.z), s[5] * ic - bf_hi(c.z)); o.w = cvt_pk_bf16(s[6] * ic - bf_lo(c.w), s[7] * ic - bf_hi(c.w));
            *(u32x4*)(abuf + tt * 64 + ch * 8) = o; }
        __syncthreads();
        f32x4 acc[2][4];
#pragma unroll
        for (int mb = 0; mb < 2; ++mb)
#pragma unroll
            for (int nb = 0; nb < 4; ++nb) acc[mb][nb] = (f32x4){0.f, 0.f, 0.f, 0.f};
#pragma unroll
        for (int ks = 0; ks < 2; ++ks) {
            bf16x8 ya[2];
#pragma unroll
            for (int mb = 0; mb < 2; ++mb) ya[mb] = *(const bf16x8*)(abuf + (wid * 32 + mb * 16 + fr) * 64 + ks * 32 + fq * 8);
#pragma unroll
            for (int mb = 0; mb < 2; ++mb)
#pragma unroll
                for (int nb = 0; nb < 4; ++nb) acc[mb][nb] = __builtin_amdgcn_mfma_f32_16x16x32_bf16(xa[ks][nb], ya[mb], acc[mb][nb], 0, 0, 0);
        }
#pragma unroll
        for (int mb = 0; mb < 2; ++mb)
#pragma unroll
            for (int nb = 0; nb < 4; ++nb) { const int d = nb * 16 + 4 * fq; const f32x4 v = acc[mb][nb] * psc[nb];
                u32x2 o; o.x = cvt_pk_bf16(v[0], v[1]); o.y = cvt_pk_bf16(v[2], v[3]);
                *(u32x2*)(Y + (size_t)(row0 + wid * 32 + mb * 16 + fr) * DM + g * 64 + d) = o; }
        __syncthreads();
    }
}

__device__ __forceinline__ void gmlp_unit(const Ctx& F, int l, int chunk) {
    char* lds = (char*)F.lds;
    int tid_ = threadIdx.x; asm volatile("" : "+v"(tid_));
    const int tid = tid_, lane = tid & 63, wid = __builtin_amdgcn_readfirstlane(tid >> 6), fr = lane & 15, fq = lane >> 4;
    const bool isctx0 = chunk < 32;
    const bf16_t* GL = wsp<const bf16_t>(F, SPLIT(isctx0, GL)); const bf16_t* U = wsp<const bf16_t>(F, SPLIT(isctx0, U)); bf16_t* Y = wsp<bf16_t>(F, SPLIT(isctx0, YCAT));
    const float* STG = wsp<const float>(F, WS_STG);
    const bf16_t* WSB = wsp<const bf16_t>(F, WS_WSB) + (size_t)l * 4 * 16384;
    const float* gsgu = GIN(16) + (size_t)l * 256; const float* bs = GIN(18) + (size_t)l * 4 * 128;
    const int r0 = chunk * 128;
    float* rsg = (float*)lds; bf16_t* vT = (bf16_t*)(lds + 1024); constexpr int LDT = 136, VTG = 64 * LDT;
    u32x4 gv[4][2]; f32x4 g0v[4][2], g1v[4][2]; u32x2 uu[4][4]; float bp[4];
#pragma unroll
    for (int g = 0; g < 4; ++g)
#pragma unroll
        for (int i = 0; i < 2; ++i) { const int id = tid + 512 * i, q = id >> 3, cc = (id & 7) * 8;
            gv[g][i] = *(const u32x4*)(GL + (size_t)(r0 + q) * 256 + g * 64 + cc); g0v[g][i] = *(const f32x4*)(gsgu + g * 64 + cc); g1v[g][i] = *(const f32x4*)(gsgu + g * 64 + cc + 4); }
    const int p = wid * 16 + fr;
#pragma unroll
    for (int g = 0; g < 4; ++g) { bp[g] = bs[g * 128 + p];
#pragma unroll
        for (int nb = 0; nb < 4; ++nb) uu[g][nb] = *(const u32x2*)(U + (size_t)(r0 + p) * 256 + g * 64 + nb * 16 + 4 * fq); }
    if (tid < 128) { const f32x4 t = *(const f32x4*)(STG + (size_t)(r0 + tid) * 4); rsg[tid] = fast_rsqrt(sum4(t) * (1.0f / 256.0f) + EPS); }
    __syncthreads();
#pragma unroll
    for (int g = 0; g < 4; ++g)
#pragma unroll
        for (int i = 0; i < 2; ++i) { const int id = tid + 512 * i, q = id >> 3, cc = (id & 7) * 8; const float rs = rsg[q]; bf16_t* vt = vT + g * VTG; const u32x4 v = gv[g][i]; const f32x4 g0 = g0v[g][i], g1 = g1v[g][i];
            vt[(cc + 0) * LDT + q] = f2bf(bf_lo(v.x) * rs * g0[0]); vt[(cc + 1) * LDT + q] = f2bf(bf_hi(v.x) * rs * g0[1]);
            vt[(cc + 2) * LDT + q] = f2bf(bf_lo(v.y) * rs * g0[2]); vt[(cc + 3) * LDT + q] = f2bf(bf_hi(v.y) * rs * g0[3]);
            vt[(cc + 4) * LDT + q] = f2bf(bf_lo(v.z) * rs * g1[0]); vt[(cc + 5) * LDT + q] = f2bf(bf_hi(v.z) * rs * g1[1]);
            vt[(cc + 6) * LDT + q] = f2bf(bf_lo(v.w) * rs * g1[2]); vt[(cc + 7) * LDT + q] = f2bf(bf_hi(v.w) * rs * g1[3]); }
    __syncthreads();
#pragma unroll
    for (int g = 0; g < 4; ++g) {
        bf16x8 ya[4];
#pragma unroll
        for (int ks = 0; ks < 4; ++ks) ya[ks] = *(const bf16x8*)(WSB + (size_t)g * 16384 + (wid * 16 + fr) * 128 + ks * 32 + fq * 8);
        f32x4 acc[4];
#pragma unroll
        for (int nb = 0; nb < 4; ++nb) acc[nb] = (f32x4){0.f, 0.f, 0.f, 0.f};
#pragma unroll
        for (int ks = 0; ks < 4; ++ks)
#pragma unroll
            for (int nb = 0; nb < 4; ++nb) { const bf16x8 xa = *(const bf16x8*)(vT + g * VTG + (nb * 16 + fr) * LDT + ks * 32 + fq * 8);
                acc[nb] = __builtin_amdgcn_mfma_f32_16x16x32_bf16(xa, ya[ks], acc[nb], 0, 0, 0); }
#pragma unroll
        for (int nb = 0; nb < 4; ++nb) { const int c = nb * 16 + 4 * fq; const u32x2 u2 = uu[g][nb];
            u32x2 o; o.x = cvt_pk_bf16(bf_lo(u2.x) * (acc[nb][0] + bp[g]), bf_hi(u2.x) * (acc[nb][1] + bp[g])); o.y = cvt_pk_bf16(bf_lo(u2.y) * (acc[nb][2] + bp[g]), bf_hi(u2.y) * (acc[nb][3] + bp[g]));
            *(u32x2*)(Y + (size_t)(r0 + p) * DM + 768 + g * 64 + c) = o; }
    }
    __syncthreads();
}

enum MapKind { MAP_ID = 0, MAP_WIN = 1, MAP_WUQ = 2 };
__device__ __forceinline__ int colmap(int kind, int n) {
    if (kind == MAP_ID) return n;
    if (kind == MAP_WIN) {
        if (n < 256) return n;
        if (n < 512) return 640 + (n - 256);
        if (n < 768) return 960 + (n - 512);
        if (n < 1024) return 1216 + (n - 768);
        if (n < 1280) return 256 + (n - 1024);
        if (n < 1408) return 512 + (n - 1280);
        if (n < 1472) { const int p = n - 1408, i = p >> 1; return (p & 1) ? 896 + 32 + i : 896 + i; }
        return -1;
    }
    { const int hh = n / 192, w = n % 192; if (w < 128) return hh * 192 + w; const int p = w - 128, i = p >> 1; return hh * 192 + 128 + ((p & 1) ? 32 + i : i); }
}
template <bool WTHRU = false>
__device__ __forceinline__ void transpose_item(const float* W, int K, int Nsrc, int Ndst, bf16_t* WT, int mapk, const float* kscale, LAS float* scr, int item, int lane) {
    const int nblk = Ndst / 64, kb = item / nblk, nb = item % nblk, k0 = 64 * kb, n0 = 64 * nb;
    const int srcA = colmap(mapk, n0 + (lane & 31)), srcB = colmap(mapk, n0 + 32 + (lane & 31));
    float tvA[32], tvB[32];
    const int sa = srcA >= 0 ? srcA : 0, sb = srcB >= 0 ? srcB : 0;
#pragma unroll
    for (int i = 0; i < 32; ++i) { const int kk = 2 * i + (lane >> 5); tvA[i] = W[(size_t)(k0 + kk) * Nsrc + sa]; }
#pragma unroll
    for (int i = 0; i < 32; ++i) { const int kk = 2 * i + (lane >> 5); tvB[i] = W[(size_t)(k0 + kk) * Nsrc + sb]; }
    if (kscale) {
#pragma unroll
        for (int i = 0; i < 32; ++i) { const float ks = kscale[k0 + 2 * i + (lane >> 5)]; tvA[i] *= ks; tvB[i] *= ks; } }
    const int c = lane & 7;
#pragma unroll
    for (int h = 0; h < 2; ++h) {
#pragma unroll
        for (int i = 0; i < 32; ++i) { const int kk = 2 * i + (lane >> 5); scr[kk * 33 + (lane & 31)] = h == 0 ? (srcA >= 0 ? tvA[i] : 0.f) : (srcB >= 0 ? tvB[i] : 0.f); }
        LDS_WAIT(); asm volatile("" ::: "memory");
#pragma unroll
        for (int j = 0; j < 4; ++j) { const int n = (lane >> 3) + 8 * j; const LAS float* sp = scr + (8 * c) * 33 + n;
            u32x4 o; o.x = cvt_pk_bf16(sp[0 * 33], sp[1 * 33]); o.y = cvt_pk_bf16(sp[2 * 33], sp[3 * 33]); o.z = cvt_pk_bf16(sp[4 * 33], sp[5 * 33]); o.w = cvt_pk_bf16(sp[6 * 33], sp[7 * 33]);
            bf16_t* dp = WT + (size_t)(n0 + 32 * h + n) * K + k0 + 8 * c;
            if (WTHRU) asm volatile("global_store_dwordx4 %0, %1, off sc0 sc1" :: "v"((GAS u32x4*)dp), "v"(o) : "memory");
            else *(u32x4*)dp = o; }
        LDS_WAIT(); asm volatile("" ::: "memory");
    }
}
__device__ __forceinline__ float silu(float x) { return x / (1.0f + __expf(-x)); }

__device__ __forceinline__ void phase_p0a(const Ctx& F, int part = 0, int widx = 0) {
    LAS float* scr = (LAS float*)(F.lds + F.wave * 16384);
    const int gw = F.vcu * 8 + F.wave, NGW = F.G * 8, lane = F.lane;
    constexpr int I_WIN = (DM / 64) * (INP / 64), I_WUQ = (QRANK / 64) * (QW / 64), I_WKV = (KVRANK / 64) * (KVW / 64), I_WOUT = (DM / 64) * (DM / 64), I_WF1 = (DM / 64) * (DFF / 64), I_WF2 = (DFF / 64) * (DM / 64), I_WP = 1;
    constexpr int PER_L = I_WIN + I_WUQ + 2 * I_WKV + I_WOUT + I_WF1 + I_WF2 + 4 * I_WP;
    constexpr int N_T = DEPTH * PER_L, N_MOD = 96 * 16, N_WS = (DEPTH * 4 * 128 * 128) / 512, N_CK = (DEPTH * NLATB * PAST * KVRANK) / 512, N_ROPE = 16;
    constexpr int NITEMS = N_MOD + N_T + N_WS + N_CK + N_ROPE;
    const bool spread = (F.G == 256);
    volatile LAS unsigned* MISCq = (volatile LAS unsigned*)(F.lds + MISC_OFF);
    if (F.tid == 0) MISCq[40] = 0u;
    __syncthreads();
    constexpr int NB_L = I_WUQ + 2 * I_WKV + I_WOUT + 4 * I_WP, NB_G = I_WUQ + 2 * I_WKV + I_WOUT, NFF = I_WF1 + I_WF2, NFFL = DEFER_FF ? 1 : DEPTH;
    bool first = true;
    for (int it = gw; ; it += NGW) {
        int r;
        if (spread) {
            if (part == 0 && first && F.wave < 6) r = F.vcu * 6 + F.wave;
            else { unsigned j = 0u; if (lane == 0) j = __hip_atomic_fetch_add((LAS unsigned*)(F.lds + MISC_OFF) + 40, 1u, __ATOMIC_RELAXED, __HIP_MEMORY_SCOPE_WORKGROUP);
                   j = (unsigned)__builtin_amdgcn_readfirstlane((int)j);
                   int d = part == 0 ? F.vcu + (int)j * F.G : widx + (int)j * 160; r = -1;
                   if (part == 0) { if (d < DEPTH * I_WIN) r = N_MOD + (d / I_WIN) * PER_L + d % I_WIN; else if (d < DEPTH * I_WIN + N_ROPE) r = NITEMS - N_ROPE + (d - DEPTH * I_WIN); }
                   else { if (d < DEPTH * NB_L) { const int q = d % NB_L; r = N_MOD + (d / NB_L) * PER_L + I_WIN + (q < NB_G ? q : q + NFF); }
                          else if ((d -= DEPTH * NB_L) < NFFL * NFF) r = N_MOD + (d / NFF) * PER_L + I_WIN + NB_G + d % NFF;
                          else if ((d -= NFFL * NFF) < N_WS + N_CK) r = N_MOD + N_T + d; }
                   if (r < 0) break; }
            first = false;
        } else { if (part != 0) break; r = it; if (r >= NITEMS) break; }
        if (r < N_MOD) {
            const int cg = r >> 4, kc = r & 15, n = cg * 256 + lane * 4, l = n / MODW, nn = n % MODW;
            { float cv[NSLOT]; const int k = kc * 64 + lane;
#pragma unroll
              for (int s = 0; s < NSLOT; ++s) cv[s] = (s == 0) ? GIN(5)[k] : GIN(4)[(size_t)(s - 1) * DM + k];
#pragma unroll
              for (int s = 0; s < NSLOT; ++s) scr[s * 64 + lane] = silu(cv[s]); }
            LDS_WAIT(); asm volatile("" ::: "memory");
            f32x4 a[NSLOT];
#pragma unroll
            for (int s = 0; s < NSLOT; ++s) a[s] = (f32x4){0.f, 0.f, 0.f, 0.f};
            const float* wp = GIN(6) + ((size_t)l * DM + kc * 64) * MODW + nn;
#pragma unroll 32
            for (int kk = 0; kk < 64; ++kk) { const f32x4 w = *(const f32x4*)(wp + (size_t)kk * MODW);
#pragma unroll
                for (int s = 0; s < NSLOT; ++s) a[s] += w * scr[s * 64 + kk]; }
            float* mp = wsp<float>(F, WS_MODP);
#pragma unroll
            for (int s = 0; s < NSLOT; ++s) *(f32x4*)(mp + ((size_t)(kc * NSLOT + s)) * (DEPTH * MODW) + n) = a[s];
            LDS_WAIT(); asm volatile("" ::: "memory");
            continue;
        }
        r -= N_MOD;
        if (r < N_T) {
            const int l = r / PER_L; int q = r % PER_L;
            if (q < I_WIN) { transpose_item(GIN(9) + (size_t)l * DM * INW, DM, INW, INP, wsp<bf16_t>(F, WS_WIN) + (size_t)l * INP * DM, MAP_WIN, nullptr, scr, q, lane); continue; } q -= I_WIN;
            if (q < I_WUQ) { transpose_item(GIN(13) + (size_t)l * QRANK * QW, QRANK, QW, QW, wsp<bf16_t>(F, WS_WUQ) + (size_t)l * QW * QRANK, MAP_WUQ, GIN(12) + (size_t)l * QRANK, scr, q, lane); continue; } q -= I_WUQ;
            if (q < I_WKV) { transpose_item(GIN(15) + (size_t)l * KVRANK * KVW, KVRANK, KVW, KVW, wsp<bf16_t>(F, WS_WKVF) + (size_t)l * KVW * KVRANK, MAP_ID, GIN(14) + (size_t)l * KVRANK, scr, q, lane); continue; } q -= I_WKV;
            if (q < I_WKV) { transpose_item(GIN(15) + (size_t)l * KVRANK * KVW, KVRANK, KVW, KVW, wsp<bf16_t>(F, WS_WKVC) + (size_t)l * KVW * KVRANK, MAP_ID, nullptr, scr, q, lane); continue; } q -= I_WKV;
            if (q < I_WOUT) { transpose_item(GIN(19) + (size_t)l * DM * DM, DM, DM, DM, wsp<bf16_t>(F, WS_WOUT) + (size_t)l * DM * DM, MAP_ID, nullptr, scr, q, lane); continue; } q -= I_WOUT;
            if (DEFER_FF && spread && l >= 1 && q < I_WF1 + I_WF2) continue;
            if (q < I_WF1) { transpose_item(GIN(21) + (size_t)l * DM * DFF, DM, DFF, DFF, wsp<bf16_t>(F, WS_WF1) + (size_t)l * DFF * DM, MAP_ID, nullptr, scr, q, lane); continue; } q -= I_WF1;
            if (q < I_WF2) { transpose_item(GIN(22) + (size_t)l * DFF * DM, DFF, DM, DM, wsp<bf16_t>(F, WS_WF2) + (size_t)l * DM * DFF, MAP_ID, nullptr, scr, q, lane); continue; } q -= I_WF2;
            { const int g = q / I_WP, it2 = q % I_WP; transpose_item(GIN(10) + ((size_t)l * 4 + g) * 4096, 64, 64, 64, wsp<bf16_t>(F, WS_WPT) + ((size_t)l * 4 + g) * 4096, MAP_ID, nullptr, scr, it2, lane); continue; }
        }
        r -= N_T;
        if (r < N_WS) {
            const float* src = GIN(17) + (size_t)r * 512 + lane * 8; const f32x4 a = *(const f32x4*)src, b = *(const f32x4*)(src + 4);
            *(u32x4*)(wsp<bf16_t>(F, WS_WSB) + (size_t)r * 512 + lane * 8) = pack8(a, b); continue;
        }
        r -= N_WS;
        if (r < N_CK) {
            const size_t e = (size_t)r * 512 + lane * 8; const int c = (int)(e % 256), j = (int)((e / 256) % 256), l = (int)((e / 65536) % 4), b = (int)(e / 262144);
            const float* src = GIN(2) + e; const f32x4 a = *(const f32x4*)src, bb = *(const f32x4*)(src + 4);
            *(u32x4*)(wsp<bf16_t>(F, WS_CCKV) + ((size_t)(l * NLATB + b) * PAST + j) * KVRANK + c) = pack8(a, bb); continue;
        }
        r -= N_CK;
        { const int id = r * 64 + lane, pos = id >> 4, j = id & 15;
          const double inv = (double)__builtin_amdgcn_exp2f(-(float)j * (13.287712379549449f / 16.0f));
          const double ang = (double)pos * inv, rev = ang * 0.15915494309189535;
          const float fr_ = (float)(rev - (double)(long long)rev);
          wsp<f32x2>(F, WS_ROPE)[id] = (f32x2){__builtin_amdgcn_cosf(fr_), __builtin_amdgcn_sinf(fr_)}; }
    }
}
__device__ __forceinline__ void ff_convert(const Ctx& F, int l) {
    constexpr int I_WF1 = (DM / 64) * (DFF / 64), I_WF2 = (DFF / 64) * (DM / 64);
    const int li = F.vcu & 31, x = F.vcu >> 5; if (li < 12) return;
    asm volatile("s_waitcnt vmcnt(0)" ::: "memory"); __syncthreads();
    LAS float* scr = (LAS float*)(F.lds + F.wave * 16384);
    const int gw = (x * 20 + (li - 12)) * 8 + F.wave, NGW = 160 * 8, lane = F.lane;
    for (int it = gw; it < I_WF1 + I_WF2; it += NGW) {
        if (it < I_WF1) transpose_item<true>(GIN(21) + (size_t)l * DM * DFF, DM, DFF, DFF, wsp<bf16_t>(F, WS_WF1) + (size_t)l * DFF * DM, MAP_ID, nullptr, scr, it, lane);
        else transpose_item<true>(GIN(22) + (size_t)l * DFF * DM, DFF, DM, DM, wsp<bf16_t>(F, WS_WF2) + (size_t)l * DM * DFF, MAP_ID, nullptr, scr, it - I_WF1, lane);
    }
}
__device__ __forceinline__ void phase_p0b(const Ctx& F) {
    const int gt = F.vcu * 512 + F.tid, NT = F.G * 512;
    const float* mp = wsp<const float>(F, WS_MODP);
    for (int id = gt; id < DEPTH * NSLOT * MODW; id += NT) {
        const int nn = id % MODW, s = (id / MODW) % NSLOT, l = id / (MODW * NSLOT);
        float v = GIN(7)[(size_t)l * MODW + nn];
#pragma unroll
        for (int kc = 0; kc < 16; ++kc) v += mp[((size_t)(kc * NSLOT + s)) * (DEPTH * MODW) + (size_t)l * MODW + nn];
        const int part = nn >> 10, k = nn & 1023; const size_t o = ((size_t)l * NSLOT + s) * DM + k;
        if (part == 0) wsp<float>(F, WS_SH1)[o] = v;
        else if (part == 1) wsp<float>(F, WS_GM1)[o] = GIN(8)[(size_t)l * DM + k] * (1.0f + v);
        else if (part == 2) wsp<float>(F, WS_G1)[o] = v;
        else if (part == 3) wsp<float>(F, WS_SH2)[o] = v;
        else if (part == 4) wsp<float>(F, WS_GM2)[o] = GIN(20)[(size_t)l * DM + k] * (1.0f + v);
        else wsp<float>(F, WS_G2)[o] = v;
    }
}
template <bool WTHRU>
__device__ __forceinline__ void shw_item(const float* SH, const GAS bf16_t* WT, float* out, int ldo, int n0, int lane) {
    const int r16 = lane & 15, kg = lane >> 4; const bool live = r16 < NSLOT;
    f32x4 acc = (f32x4){0.f, 0.f, 0.f, 0.f};
    const GAS bf16_t* bp = WT + (size_t)(n0 + r16) * DM + kg * 8;
    const float* ap = SH + (size_t)(live ? r16 : 0) * DM + kg * 8;
    for (int k0 = 0; k0 < DM; k0 += 256) {
        u32x4 b[8]; f32x4 a0[8], a1[8];
#pragma unroll
        for (int j = 0; j < 8; ++j) { b[j] = *(const GAS u32x4*)(bp + k0 + 32 * j); a0[j] = *(const f32x4*)(ap + k0 + 32 * j); a1[j] = *(const f32x4*)(ap + k0 + 32 * j + 4); }
#pragma unroll
        for (int j = 0; j < 8; ++j) {
            u32x4 hi, lo;
            hi.x = cvt_pk_bf16(a0[j][0], a0[j][1]); hi.y = cvt_pk_bf16(a0[j][2], a0[j][3]); hi.z = cvt_pk_bf16(a1[j][0], a1[j][1]); hi.w = cvt_pk_bf16(a1[j][2], a1[j][3]);
            lo.x = cvt_pk_bf16(a0[j][0] - bf_lo(hi.x), a0[j][1] - bf_hi(hi.x)); lo.y = cvt_pk_bf16(a0[j][2] - bf_lo(hi.y), a0[j][3] - bf_hi(hi.y));
            lo.z = cvt_pk_bf16(a1[j][0] - bf_lo(hi.z), a1[j][1] - bf_hi(hi.z)); lo.w = cvt_pk_bf16(a1[j][2] - bf_lo(hi.w), a1[j][3] - bf_hi(hi.w));
            if (!live) { hi = (u32x4){0u, 0u, 0u, 0u}; lo = hi; }
            const bf16x8 bv = __builtin_bit_cast(bf16x8, b[j]);
            acc = __builtin_amdgcn_mfma_f32_16x16x32_bf16(__builtin_bit_cast(bf16x8, hi), bv, acc, 0, 0, 0);
            acc = __builtin_amdgcn_mfma_f32_16x16x32_bf16(__builtin_bit_cast(bf16x8, lo), bv, acc, 0, 0, 0);
        }
    }
#pragma unroll
    for (int r = 0; r < 4; ++r) { const int sr = 4 * kg + r;
        if (sr < NSLOT) { float* o = out + (size_t)sr * ldo + n0 + r16;
            if (WTHRU) __hip_atomic_store(o, acc[r], __ATOMIC_RELAXED, __HIP_MEMORY_SCOPE_AGENT); else *o = acc[r]; } }
}
__device__ __forceinline__ void shw2_deferred(const Ctx& F, int l) {
    const int li = F.vcu & 31, x = F.vcu >> 5; if (li < 4 || li >= 16) return;
    const int item = (x * 12 + (li - 4)) * 8 + F.wave;
    if (item < DFF / 16) shw_item<true>(wsp<const float>(F, WS_SH2) + (size_t)l * NSLOT * DM, wsp<const bf16_t>(F, WS_WF1) + (size_t)l * DFF * DM, wsp<float>(F, WS_SHW2) + (size_t)l * NSLOT * DFF, DFF, item * 16, F.lane);
}
__device__ __forceinline__ const float* xrow_in(const Ctx& F, int row) { return row < NCTX ? GIN(0) + (size_t)row * DM : GIN(1) + (size_t)(row - NCTX) * DM; }
__device__ __forceinline__ void phase_p0c(const Ctx& F) {
    const int lane = F.lane, wid = F.wave, tid = F.tid;
    {
        constexpr int I1 = INP / 16, I2 = DFF / 16;
        const bool defer = F.G == 256;
        const int n2 = defer ? 0 : DEPTH, total = DEPTH * I1 + n2 * I2;
        for (int it = F.vcu * 8 + wid; it < total; it += F.G * 8) {
            if (it < DEPTH * I1) { const int l = it / I1, c = it % I1;
                shw_item<false>(wsp<const float>(F, WS_SH1) + (size_t)l * NSLOT * DM, wsp<const bf16_t>(F, WS_WIN) + (size_t)l * INP * DM, wsp<float>(F, WS_SHW1) + (size_t)l * NSLOT * INP, INP, c * 16, lane); }
            else { const int q = it - DEPTH * I1, l = q / I2, c = q % I2;
                shw_item<false>(wsp<const float>(F, WS_SH2) + (size_t)l * NSLOT * DM, wsp<const bf16_t>(F, WS_WF1) + (size_t)l * DFF * DM, wsp<float>(F, WS_SHW2) + (size_t)l * NSLOT * DFF, DFF, c * 16, lane); }
        }
    }
    {
        const int gw = F.vcu * 8 + wid, NGW = F.G * 8;
        const float* GM = wsp<const float>(F, WS_GM1);
        bf16_t* XG = wsp<bf16_t>(F, WS_XG); float* ST1 = wsp<float>(F, WS_ST1);
        constexpr int RB = 5;
        for (int row0 = gw; row0 < MROWS; row0 += NGW * RB) {
            f32x4 v[RB][4];
#pragma unroll
            for (int i = 0; i < RB; ++i) { const int row = row0 + i * NGW; const f32x4* xr = (const f32x4*)xrow_in(F, row < MROWS ? row : row0) + lane;
#pragma unroll
                for (int j = 0; j < 4; ++j) v[i][j] = xr[64 * j]; }
#pragma unroll
            for (int i = 0; i < RB; ++i) { const int row = row0 + i * NGW;
                if (row < MROWS) {
                    const int s = slot_of_tile(row >> 8); const f32x4* gr = (const f32x4*)(GM + (size_t)s * DM) + lane;
                    float q = 0.f;
#pragma unroll
                    for (int j = 0; j < 4; ++j) { const f32x4 vv = v[i][j], g = gr[64 * j]; q += (vv[0] * vv[0] + vv[1] * vv[1]) + (vv[2] * vv[2] + vv[3] * vv[3]); const f32x4 y = vv * g;
                        u32x2 o; o.x = cvt_pk_bf16(y[0], y[1]); o.y = cvt_pk_bf16(y[2], y[3]); *(u32x2*)(XG + (size_t)row * DM + (64 * j + lane) * 4) = o; }
                    q = wave_sum(q);
                    if (lane < 16) ST1[(size_t)row * 16 + lane] = (lane == 0) ? q : 0.f;
                } }
        }
    }
}
__device__ __forceinline__ void final_tile(const Ctx& F, int pm, int pn) {
    asm volatile("s_waitcnt vmcnt(0)" ::: "memory");
    __syncthreads();
    if (F.tid == 0) {
        unsigned* bar = (unsigned*)((gu32*)(F.ws + WS_CTL) + CW_BAR); unsigned* cw = (unsigned*)((gu32*)(F.ws + WS_CTL) + CW_FIN + 32 * pm);
        __builtin_amdgcn_fence(__ATOMIC_RELEASE, "agent");
        asm volatile("s_waitcnt vmcnt(0)" ::: "memory");
        xb_add(cw, 1u);
        XB_SPIN(xb_ld(cw) < 4u, bar);
        __builtin_amdgcn_fence(__ATOMIC_ACQUIRE, "agent");
        asm volatile("s_waitcnt vmcnt(0)" ::: "memory");
    }
    __syncthreads();
    __builtin_amdgcn_fence(__ATOMIC_ACQUIRE, "workgroup");
    LAS float* S = (LAS float*)(F.lds + RING_BYTES + 2048);
    int t_ = F.tid; asm volatile("" : "+v"(t_));
    if (t_ == 0) *(volatile LAS int*)(S + 256) = 0;
    if (t_ < 256) { const GAS f32x4* sp = (const GAS f32x4*)(wsp<const float>(F, WS_ST1) + (size_t)(pm * 256 + t_) * 16);
        S[t_] = fast_rsqrt(((sum4(sp[0]) + sum4(sp[1])) + (sum4(sp[2]) + sum4(sp[3]))) * (1.0f / DM) + EPS); }
    __syncthreads();
    const int c16 = t_ & 31, r0 = t_ >> 5;
    const GAS float* gf = GIN(23) + pn * 256 + c16 * 8; const f32x4 g0 = *(const GAS f32x4*)gf, g1 = *(const GAS f32x4*)(gf + 4);
    const GAS bf16_t* xb = wsp<const bf16_t>(F, WS_XB) + (size_t)(pm * 256 + r0) * DM + pn * 256 + c16 * 8;
    GAS float* y = F.out + OUT_X + (size_t)(pm * 256 + r0) * DM + pn * 256 + c16 * 8;
    u32x4 b[16];
#pragma unroll
    for (int p = 0; p < 16; ++p) b[p] = *(const GAS u32x4*)(xb + (size_t)p * 16 * DM);
#pragma unroll
    for (int p = 0; p < 16; ++p) { const float rs = S[p * 16 + r0]; GAS float* yr = y + (size_t)p * 16 * DM; const u32x4 v = b[p];
        *(GAS f32x4*)yr = (f32x4){bf_lo(v.x), bf_hi(v.x), bf_lo(v.y), bf_hi(v.y)} * rs * g0; *(GAS f32x4*)(yr + 4) = (f32x4){bf_lo(v.z), bf_hi(v.z), bf_lo(v.w), bf_hi(v.w)} * rs * g1; }
}
__device__ __forceinline__ void phase_final(const Ctx& F) {
    const int gw = F.vcu * 8 + F.wave, NGW = F.G * 8, lane = F.lane;
    const float* ST1 = wsp<const float>(F, WS_ST1); const f32x4* gf = (const f32x4*)GIN(23) + lane;
    const GAS bf16_t* XB = wsp<const bf16_t>(F, WS_XB);
    for (int row = gw; row < MROWS; row += NGW) {
        const f32x4* sp = (const f32x4*)(ST1 + (size_t)row * 16);
        const float rs = fast_rsqrt(((sum4(sp[0]) + sum4(sp[1])) + (sum4(sp[2]) + sum4(sp[3]))) * (1.0f / DM) + EPS);
        const GAS u32x2* xr = (const GAS u32x2*)(XB + (size_t)row * DM) + lane;
        f32x4* yr = (f32x4*)(F.out + OUT_X + (size_t)row * DM) + lane;
#pragma unroll
        for (int j = 0; j < 4; ++j) { const u32x2 b = xr[64 * j]; const f32x4 v = (f32x4){bf_lo(b.x), bf_hi(b.x), bf_lo(b.y), bf_hi(b.y)}; yr[64 * j] = v * rs * gf[64 * j]; }
    }
}

#ifdef DIS_ATTN
#define ATTN_CALL(...) do {} while (0)
#else
#define ATTN_CALL(...) attn_unit(__VA_ARGS__)
#endif
#ifdef DIS_POOL
#define POOL_CALL(...) do {} while (0)
#else
#define POOL_CALL(...) pool_unit(__VA_ARGS__)
#endif
#ifdef DIS_GMLP
#define GMLP_CALL(...) do {} while (0)
#else
#define GMLP_CALL(...) gmlp_unit(__VA_ARGS__)
#endif
__device__ __forceinline__ void mix_fix(const Ctx& F, int l, int L, bool dry) {
    if (dry) return;
    const float* STKV = wsp<const float>(F, WS_STKV); const float* gkv = GIN(14) + (size_t)l * KVRANK;
    float* o = F.out + OUT_CKV + ((size_t)(L * DEPTH + l) * LCTX) * KVRANK;
    int tid0_ = threadIdx.x; asm volatile("" : "+v"(tid0_));
    const int c4 = (tid0_ & 63) * 4; const f32x4 g = *(const f32x4*)(gkv + c4);
    for (int t0 = tid0_ >> 6; t0 < LCTX; t0 += 64) {
        f32x4 st[8], v[8];
#pragma unroll
        for (int k = 0; k < 8; ++k) { const int t = t0 + 8 * k; st[k] = *(const f32x4*)(STKV + (size_t)(L * LCTX + t) * 4); v[k] = *(const f32x4*)(o + (size_t)t * KVRANK + c4); }
#pragma unroll
        for (int k = 0; k < 8; ++k) { const int t = t0 + 8 * k; const float rs = fast_rsqrt(sum4(st[k]) * (1.0f / KVRANK) + EPS); *(f32x4*)(o + (size_t)t * KVRANK + c4) = v[k] * rs * g; }
    }
}
__device__ __forceinline__ void mix_attn_ctx(const Ctx& F, int b, int h) {
    const GAS bf16_t* Q = wsp<const bf16_t>(F, Q_C); GAS bf16_t* Y = wsp<bf16_t>(F, YCAT_C);
    const int L = b * 4 + h; const size_t row0 = (size_t)b * LCTX;
    ATTN_CALL(F.lds, Q + row0 * QW + h * 192, wsp<const bf16_t>(F, WS_KC) + (size_t)L * LCTX * 192, wsp<const bf16_t>(F, WS_VC) + (size_t)L * LCTX * 128, Y + row0 * DM + 256 + h * 128, LCTX);
}
__device__ __forceinline__ void mix_ctx(const Ctx& F, int l, bool dry) {
    if (F.G == 256) { const int x = F.vcu >> 5, li = F.vcu & 31;
        if (li >= 16 && li < 24) { const int m = li - 16; mix_attn_ctx(F, 2 * x + (m >> 2), m & 3); }
        else if (li >= 24 && li < 28) { const int m = li - 24; POOL_CALL(F, l, 2 * x, m, m + 1); GMLP_CALL(F, l, 4 * x + m); }
        else if (li >= 28) { const int m = li - 28; POOL_CALL(F, l, 2 * x + 1, m, m + 1); if (m < 2) mix_fix(F, l, 2 * x + m, dry); }
    } else for (int j = F.vcu; j < 128; j += F.G) { const int x = j >> 4, m = j & 15;
        if (m < 2) POOL_CALL(F, l, 2 * x + m, 0, 4); else if (m < 10) mix_attn_ctx(F, 2 * x + ((m - 2) >> 2), (m - 2) & 3); else if (m < 14) GMLP_CALL(F, l, 4 * x + (m - 10)); else mix_fix(F, l, 2 * x + (m - 14), dry); }
}
__device__ __forceinline__ void mix_lat_attn(const Ctx& F) {
    const GAS bf16_t* Q = wsp<const bf16_t>(F, Q_L); GAS bf16_t* Y = wsp<bf16_t>(F, YCAT_L);
    for (int L = F.vcu; L < 256; L += F.G) {
        const int bh = L >> 3, qb = L & 7, b = bh >> 2, h = bh & 3; const size_t row0 = (size_t)NCTX + (size_t)b * LLAT + qb * 256;
        ATTN_CALL(F.lds, Q + row0 * QW + h * 192, wsp<const bf16_t>(F, WS_KL) + (size_t)bh * LKEY * 192, wsp<const bf16_t>(F, WS_VL) + (size_t)bh * LKEY * 128, Y + row0 * DM + 256 + h * 128, LKEY);
    }
}
__device__ __forceinline__ void mix_lat_small(const Ctx& F, int l) {
    if (F.G == 256) { const int x = F.vcu >> 5, li = F.vcu & 31;
        if (li >= 8 && li < 24) { const int m = li - 8; POOL_CALL(F, l, 16 + 8 * x + (m >> 1), 2 * (m & 1), 2 * (m & 1) + 2); }
        else if (li >= 24) { const int m = li - 24; GMLP_CALL(F, l, 32 + 16 * x + 2 * m); GMLP_CALL(F, l, 32 + 16 * x + 2 * m + 1); } }
    else for (int j = F.vcu; j < 192; j += F.G) { if (j < 64) POOL_CALL(F, l, 16 + j, 0, 4); else GMLP_CALL(F, l, 32 + (j - 64)); }
}

#ifdef DIS_GEMM
#define GEMM_CALL(a, b, c) do { (void)(b); (void)(c); } while (0)
#else
#define GEMM_CALL(a, b, c) gemm_phase(a, b, c)
#endif
constexpr int SL_P0A = 0, SL_P0B = 1, SL_P0C = 2, SL_PRE = 3, SL_L0 = 4, SL_PER_L = 6, SL_FINAL = SL_L0 + DEPTH * SL_PER_L, N_PHASES = SL_FINAL + 1;

__global__ void __launch_bounds__(512, 2) mega_fwd(const Args args) {
    extern __shared__ __attribute__((aligned(16))) unsigned char lds_raw[];
    Ctx F;
    F.a = &args; F.out = (GAS float*)args.out; F.ws = (GAS unsigned char*)args.ws; F.lds = (LAS unsigned char*)lds_raw;
    F.tid = threadIdx.x; F.lane = F.tid & 63; F.wave = __builtin_amdgcn_readfirstlane(F.tid >> 6);
    F.G = gridDim.x; { const int bx = blockIdx.x; F.vcu = (F.G % 8 == 0) ? (bx % 8) * (F.G / 8) + bx / 8 : bx; }
    volatile LAS unsigned* MISC = (volatile LAS unsigned*)(F.lds + MISC_OFF);
    for (int u = F.tid; u < (LDS_BYTES - RING_BYTES) / 4; u += 512) ((LAS unsigned*)(F.lds + RING_BYTES))[u] = 0u;
    __syncthreads();
    gu32* ctl = (gu32*)(F.ws + WS_CTL);
    XcdBarrier bar; bar.bar = (unsigned*)(ctl + CW_BAR); bar.x = 0; bar.st = nullptr;
#if !MK_PER_PHASE
    bar = xcd_barrier_post((unsigned*)(ctl + CW_BAR), MISC + 8);
    if (threadIdx.x == 0) __hip_atomic_store(ctl + CW_XCC + F.vcu, xb_xcc_id() + 1u, RLX_AGENT);
#endif
    const int lo = args.ph_lo, hi = (FUSE_FINAL && F.G == 256 && args.ph_hi == N_PHASES) ? (int)SL_FINAL : args.ph_hi;
    for (int ph = lo; ph < hi; ++ph) {
      int reps = 1;
      if (PROBE_PHASE >= 0) { const int key = ph == SL_P0A ? 10 : ph == SL_P0B ? 11 : ph == SL_P0C ? 12 : ph == SL_FINAL ? 13 : ph == SL_PRE ? 9 : (ph - SL_L0) % SL_PER_L; if (key == PROBE_PHASE) reps += PROBE_REP; }
      for (int rep = 0; rep < reps; ++rep) {
        const bool dry = rep > 0;
        if (PROBE_PHASE == 13 && dry) break;
#if PROBE_FLUSH && !MK_PER_PHASE
        if (dry) {
            GAS u32x4* z = (GAS u32x4*)(F.ws + WS_OVL); const size_t n16 = (size_t)180 * 1024 * 1024 / 16;
            for (size_t i = (size_t)F.vcu * 512 + threadIdx.x; i < n16; i += (size_t)F.G * 512) z[i] = (u32x4){0u, 0u, 0u, 0u};
            GAS u32x4* z2 = (GAS u32x4*)(F.out); const size_t m16 = (size_t)100 * 1024 * 1024 / 16;
            for (size_t i = (size_t)F.vcu * 512 + threadIdx.x; i < m16; i += (size_t)F.G * 512) z2[i] = (u32x4){0u, 0u, 0u, 0u};
            xcd_barrier(bar);
        }
#endif
        { int t_ = threadIdx.x; asm volatile("" : "+v"(t_)); F.tid = t_; F.lane = t_ & 63; F.wave = __builtin_amdgcn_readfirstlane(t_ >> 6);
          unsigned char* w_ = args.ws; asm volatile("" : "+s"(w_)); F.ws = (GAS unsigned char*)w_; float* o_ = args.out; asm volatile("" : "+s"(o_)); F.out = (GAS float*)o_; }
#ifndef DIS_P0
        if (ph == SL_P0A) phase_p0a(F);
        else if (ph == SL_P0B) { phase_p0b(F);
            { int t_ = threadIdx.x; asm volatile("" : "+v"(t_)); const GAS u32x4* src = (const GAS u32x4*)(F.ws + WS_ROPE); LAS u32x4* dl = (LAS u32x4*)(F.lds + RING_BYTES + 4096); dl[t_] = src[t_]; } }
        else if (ph == SL_P0C) phase_p0c(F);
        else if (ph == SL_FINAL) phase_final(F);
#else
        if (ph < SL_PRE || ph == SL_FINAL) {}
#endif
        else {
            Epi E; E.ws = F.ws; E.out = F.out; E.xp = GIN(0); E.xs = GIN(1); E.dry = dry;
            const int l = ph == SL_PRE ? 0 : (ph - SL_L0) / SL_PER_L, sub = ph == SL_PRE ? -1 : (ph - SL_L0) % SL_PER_L;
            if (sub == 1) {
                const GAS float* ck = GIN(3); GAS bf16_t* KL = wsp<bf16_t>(F, WS_KL);
                const bool loc = (F.G == 256);
                for (int id0 = loc ? (F.vcu & 31) * 512 + F.tid : F.vcu * 512 + F.tid; id0 < (loc ? PAST * 8 : NLATB * PAST * 8); id0 += (loc ? 32 : F.G) * 512) {
                    const int id = loc ? ((F.vcu >> 5) << 11) + id0 : id0;
                    const int ch = id & 7, j = (id >> 3) & 255, b = id >> 11, i0 = ch * 4;
                    const GAS float* src = ck + ((size_t)(b * DEPTH + l) * PAST + j) * 64;
                    const f32x4 a = *(const GAS f32x4*)(src + i0), c = *(const GAS f32x4*)(src + 32 + i0);
                    u32x4 w; w.x = cvt_pk_bf16(a[0], c[0]); w.y = cvt_pk_bf16(a[1], c[1]); w.z = cvt_pk_bf16(a[2], c[2]); w.w = cvt_pk_bf16(a[3], c[3]);
                    GAS bf16_t* kd = KL + ((size_t)(b * NH) * LKEY + j) * 192 + 128 + ch * 8;
#pragma unroll
                    for (int h = 0; h < NH; ++h) *(GAS u32x4*)(kd + (size_t)h * LKEY * 192) = w;
                }
            }
            if (sub == 2) { mix_lat_attn(F); if (PROBE_PHASE == 21) for (int r2 = 0; r2 < PROBE_REP; ++r2) mix_lat_attn(F); }
            { SchedSlot S; S.ws = F.ws; S.c = F.vcu; S.G = F.G; S.sub = sub; S.l = l; GEMM_CALL(F.lds, S, E); }
            if (DEFER_FF && sub == 5 && F.G == 256 && l + 1 < DEPTH && !dry) ff_convert(F, l + 1);
            if (FUSE_FINAL && F.G == 256 && l == DEPTH - 1 && sub >= 4 && !dry) {
                SchedSlot S; S.ws = F.ws; S.c = F.vcu; S.G = F.G; S.sub = sub; S.l = l; GUnit u0;
                if (S.next(0, u0) && u0.kind == K_FF2) final_tile(F, u0.pm, u0.pn);
            }
            if (sub == -1 && F.G == 256 && !dry && (F.vcu & 31) >= 12) { asm volatile("s_waitcnt vmcnt(0)" ::: "memory"); __syncthreads(); phase_p0a(F, 1, (F.vcu >> 5) * 20 + (F.vcu & 31) - 12); }
            if (sub == 1) mix_ctx(F, l, dry);
            if (sub == 1 && F.G == 256 && !dry) shw2_deferred(F, l);
            if (sub == 2) mix_lat_small(F, l);
        }
#if !MK_PER_PHASE
        if (threadIdx.x == 0) MISC[10] = (MISC[20] != 0u && ph >= SL_L0 && ph + 1 < SL_FINAL) ? 1u : 0u;
        if (ph + 1 < hi || rep + 1 < reps) xcd_barrier(bar);
        if (ph == SL_P0A && rep == 0) {
            int bad = 0; int tq_ = threadIdx.x; asm volatile("" : "+v"(tq_));
            if (F.G != 256) bad = 1;
            else if (tq_ < 256) { gu32* cc = (gu32*)(F.ws + WS_CTL); const unsigned v = __hip_atomic_load(cc + CW_XCC + tq_, RLX_AGENT), h = __hip_atomic_load(cc + CW_XCC + (tq_ & ~31), RLX_AGENT); bad = (v == 0u || v != h); }
            const bool wbad = __ballot(bad) != 0ull;
            if ((tq_ & 63) == 0) MISC[24 + (tq_ >> 6)] = wbad ? 1u : 0u;
            __syncthreads();
            if (tq_ == 0) { unsigned a = 0u;
#pragma unroll
                for (int w8 = 0; w8 < 8; ++w8) a |= MISC[24 + w8];
                MISC[20] = a ? 0u : 1u; }
            __syncthreads();
        }
        if (PROBE_PHASE == 20 && ph >= SL_L0 && ph < SL_FINAL) { for (int r2 = 0; r2 < PROBE_REP; ++r2) xcd_barrier(bar); }
#endif
      }
    }
}

extern "C" void kernel_launch(void* const* d_in, const int* in_sizes, int n_in, void* d_out, int out_size, void* d_ws, size_t ws_size, hipStream_t stream) {
    static int grid = 0;
    if (grid == 0) {
        if (n_in != 24 || out_size != (int)OUT_END || ws_size < WS_END) { fprintf(stderr, "kernel_launch: unexpected shapes: n_in %d out %d ws %zu (need %zu)\n", n_in, out_size, ws_size, (size_t)WS_END); grid = -1; return; }
        int dev = 0, cus = 0, per_cu = 0;
        if (hipGetDevice(&dev) != hipSuccess || hipDeviceGetAttribute(&cus, hipDeviceAttributeMultiprocessorCount, dev) != hipSuccess) { grid = -1; return; }
        if (hipFuncSetAttribute((const void*)mega_fwd, hipFuncAttributeMaxDynamicSharedMemorySize, LDS_BYTES) != hipSuccess) { fprintf(stderr, "kernel_launch: hipFuncSetAttribute failed\n"); grid = -1; return; }
        if (hipOccupancyMaxActiveBlocksPerMultiprocessor(&per_cu, (const void*)mega_fwd, 512, LDS_BYTES) != hipSuccess || per_cu < 1) { fprintf(stderr, "kernel_launch: occupancy query says %d\n", per_cu); per_cu = 1; }
        (void)hipGetLastError();
        grid = cus;
    }
    if (grid < 0) return;
    (void)hipMemsetAsync((char*)d_ws + WS_CTL, 0, CTL_ZERO_BYTES, stream);
    Args a{};
    for (int i = 0; i < 24; ++i) a.in[i] = (const float*)d_in[i];
    a.out = (float*)d_out; a.ws = (unsigned char*)d_ws;
#if MK_PER_PHASE
    for (int ph = 0; ph < N_PHASES; ++ph) { a.ph_lo = ph; a.ph_hi = ph + 1; hipLaunchKernelGGL(mega_fwd, dim3(grid), dim3(512), LDS_BYTES, stream, a); }
#else
    a.ph_lo = 0; a.ph_hi = N_PHASES; hipLaunchKernelGGL(mega_fwd, dim3(grid), dim3(512), LDS_BYTES, stream, a);
#endif
    const hipError_t le = hipPeekAtLastError();
    if (le != hipSuccess) fprintf(stderr, "kernel_launch: launch failed: %s\n", hipGetErrorName(le));
}
```

```cpp
#include <hip/hip_runtime.h>
#include <cstdio>
#include <cstdint>

#define LAS __attribute__((address_space(3)))
#if defined(__HIP_DEVICE_COMPILE__)
#define GAS __attribute__((address_space(1)))
#else
#define GAS
#endif
typedef unsigned short bf16_t;
typedef short bf16x8 __attribute__((ext_vector_type(8)));
typedef short s16x4 __attribute__((ext_vector_type(4)));
typedef float f32x2 __attribute__((ext_vector_type(2)));
typedef float f32x4 __attribute__((ext_vector_type(4)));
typedef float f32x16 __attribute__((ext_vector_type(16)));
typedef unsigned u32x4 __attribute__((ext_vector_type(4)));
typedef unsigned u32x2 __attribute__((ext_vector_type(2)));
typedef GAS unsigned gu32;

#ifndef PROBE_PHASE
#define PROBE_PHASE -1
#endif
#ifndef PROBE_REP
#define PROBE_REP 0
#endif
#ifndef PROBE_FLUSH
#define PROBE_FLUSH 0
#endif
#ifndef MK_PER_PHASE
#define MK_PER_PHASE 0
#endif
#define FUSE_FINAL (!MK_PER_PHASE)
#ifndef LOCAL_BAR
#define LOCAL_BAR 1
#endif
#ifndef DEFER_FF
#define DEFER_FF 1
#endif

constexpr int DM = 1024, DEPTH = 4, NCTXB = 16, LCTX = 256, NLATB = 8, LLAT = 2048, PAST = 256;
constexpr int NCTX = NCTXB * LCTX  , NLAT = NLATB * LLAT  , MROWS = NCTX + NLAT  ;
constexpr int NSLOT = 9, MODW = 6 * DM;
constexpr int INW = 1472, INP = 1536, QRANK = 384, KVRANK = 256, QW = 768, KVW = 1024, DFF = 4096, NH = 4;
constexpr int LKEY = PAST + LLAT  ;
constexpr float EPS = 1e-6f;
constexpr float C2 = 0.07216878364870322f * 1.4426950408889634f;
constexpr int NTM = MROWS / 256;

constexpr size_t OUT_X = 0, OUT_CKV = (size_t)MROWS * DM, OUT_KR = OUT_CKV + (size_t)NCTXB * DEPTH * LCTX * KVRANK, OUT_END = OUT_KR + (size_t)NCTXB * DEPTH * LCTX * 64;

constexpr size_t al256(size_t x) { return (x + 255) / 256 * 256; }
constexpr size_t WS_CTL = 0, CTL_ZERO_BYTES = 1u << 20;
constexpr size_t WS_MODP = CTL_ZERO_BYTES;
constexpr size_t WS_SH1 = WS_MODP + al256((size_t)16 * NSLOT * DEPTH * MODW * 4);
constexpr size_t MODV = al256((size_t)DEPTH * NSLOT * DM * 4);
constexpr size_t WS_GM1 = WS_SH1 + MODV, WS_G1 = WS_GM1 + MODV, WS_SH2 = WS_G1 + MODV, WS_GM2 = WS_SH2 + MODV, WS_G2 = WS_GM2 + MODV;
constexpr size_t WS_SHW1 = WS_G2 + MODV;
constexpr size_t WS_SHW2 = WS_SHW1 + al256((size_t)DEPTH * NSLOT * INP * 4);
constexpr size_t WS_ROPE = WS_SHW2 + al256((size_t)DEPTH * NSLOT * DFF * 4);
constexpr size_t WS_ST1 = WS_ROPE + al256(64 * 16 * 8);
constexpr size_t WS_ST2 = WS_ST1 + al256((size_t)MROWS * 16 * 4);
constexpr size_t WS_STQ = WS_ST2 + al256((size_t)MROWS * 16 * 4);
constexpr size_t WS_STKV = WS_STQ + al256((size_t)MROWS * 8 * 4);
constexpr size_t WS_STG = WS_STKV + al256((size_t)MROWS * 4 * 4);
constexpr size_t WS_WIN = WS_STG + al256((size_t)MROWS * 4 * 4);
constexpr size_t WS_WUQ = WS_WIN + al256((size_t)DEPTH * INP * DM * 2);
constexpr size_t WS_WKVF = WS_WUQ + al256((size_t)DEPTH * QW * QRANK * 2);
constexpr size_t WS_WKVC = WS_WKVF + al256((size_t)DEPTH * KVW * KVRANK * 2);
constexpr size_t WS_WOUT = WS_WKVC + al256((size_t)DEPTH * KVW * KVRANK * 2);
constexpr size_t WS_WF1 = WS_WOUT + al256((size_t)DEPTH * DM * DM * 2);
constexpr size_t WS_WF2 = WS_WF1 + al256((size_t)DEPTH * DFF * DM * 2);
constexpr size_t WS_WPT = WS_WF2 + al256((size_t)DEPTH * DM * DFF * 2);
constexpr size_t WS_WSB = WS_WPT + al256((size_t)DEPTH * 4 * 64 * 64 * 2);
constexpr size_t WS_CCKV = WS_WSB + al256((size_t)DEPTH * 4 * 128 * 128 * 2);
constexpr size_t WS_XG = WS_CCKV + al256((size_t)DEPTH * NLATB * PAST * KVRANK * 2);
constexpr size_t cmax(size_t a, size_t b) { return a > b ? a : b; }
constexpr size_t LB(size_t base, size_t w) { return base - (size_t)NCTX * w * 2; }
constexpr size_t WS_XB = WS_XG + al256((size_t)MROWS * DM * 2);
constexpr size_t WS_RC = WS_XB + al256((size_t)MROWS * DM * 2);
constexpr size_t HP_C = WS_RC, CKVR_C = HP_C + (size_t)NCTX * 256 * 2, U_C = CKVR_C + (size_t)NCTX * 256 * 2, GL_C = U_C + (size_t)NCTX * 256 * 2;
constexpr size_t CQ_C = GL_C + (size_t)NCTX * 256 * 2, Q_C = CQ_C + (size_t)NCTX * QRANK * 2, WS_KC = Q_C + (size_t)NCTX * QW * 2;
constexpr size_t WS_VC = WS_KC + (size_t)NCTXB * NH * LCTX * 192 * 2, YCAT_C = WS_VC + (size_t)NCTXB * NH * LCTX * 128 * 2;
constexpr size_t HID_C = WS_RC;
constexpr size_t WS_RL = al256(cmax(YCAT_C + (size_t)NCTX * DM * 2, HID_C + (size_t)NCTX * DFF * 2));
constexpr size_t HP_L0 = WS_RL, CKVR_L0 = HP_L0 + (size_t)NLAT * 256 * 2, U_L0 = CKVR_L0 + (size_t)NLAT * 256 * 2, GL_L0 = U_L0 + (size_t)NLAT * 256 * 2;
constexpr size_t CQ_L0 = GL_L0 + (size_t)NLAT * 256 * 2, Q_L0 = CQ_L0 + (size_t)NLAT * QRANK * 2, WS_KL = Q_L0 + (size_t)NLAT * QW * 2;
constexpr size_t WS_VL = WS_KL + (size_t)NLATB * NH * LKEY * 192 * 2, YCAT_L0 = WS_VL + (size_t)NLATB * NH * LKEY * 128 * 2;
constexpr size_t HID_L0 = WS_RL;
constexpr size_t HP_L = LB(HP_L0, 256), CKVR_L = LB(CKVR_L0, 256), U_L = LB(U_L0, 256), GL_L = LB(GL_L0, 256), CQ_L = LB(CQ_L0, QRANK), Q_L = LB(Q_L0, QW), YCAT_L = LB(YCAT_L0, DM), HID_L = LB(HID_L0, DFF);
constexpr size_t WS_OVL = WS_RC;
constexpr size_t WS_END = al256(cmax(YCAT_L0 + (size_t)NLAT * DM * 2, HID_L0 + (size_t)NLAT * DFF * 2));
#define SPLIT(isctx, NAME) ((isctx) ? NAME##_C : NAME##_L)

constexpr int CW_BAR = 4096;
constexpr int CW_FIN = 16384;
constexpr int CW_XCC = 8192;

constexpr int RING_BYTES = 131072, MISC_OFF = RING_BYTES + 320, LDS_BYTES = 147456;

#define RLX_AGENT __ATOMIC_RELAXED, __HIP_MEMORY_SCOPE_AGENT
#define LDS_WAIT() asm volatile("s_waitcnt lgkmcnt(0)" ::: "memory")
#define VM_WAIT() asm volatile("s_waitcnt vmcnt(0)" ::: "memory")
#define SBAR() __builtin_amdgcn_sched_barrier(0)
__device__ __forceinline__ unsigned cvt_pk_bf16(float lo, float hi) { unsigned r; asm volatile("v_cvt_pk_bf16_f32 %0, %1, %2" : "=v"(r) : "v"(lo), "v"(hi)); return r; }
__device__ __forceinline__ float bf_lo(unsigned w) { return __uint_as_float(w << 16); }
__device__ __forceinline__ float bf_hi(unsigned w) { return __uint_as_float(w & 0xffff0000u); }
__device__ __forceinline__ float bf1(bf16_t h) { return __uint_as_float(((unsigned)h) << 16); }
__device__ __forceinline__ bf16_t f2bf(float f) { return (bf16_t)(cvt_pk_bf16(f, 0.f) & 0xffffu); }
__device__ __forceinline__ float fast_rsqrt(float x) { return __builtin_amdgcn_rsqf(x); }
__device__ __forceinline__ float gelu_tanh(float x) {
    const float z = x * (1.0f + 0.044715f * x * x);
    const float e = __builtin_amdgcn_exp2f(z * (-2.0f * 0.7978845608028654f * 1.4426950408889634f));
    return x * __builtin_amdgcn_rcpf(1.0f + e);
}
__device__ __forceinline__ float wave_sum(float v) {
#pragma unroll
    for (int o = 1; o < 64; o <<= 1) v += __shfl_xor(v, o);
    return v;
}
__device__ __forceinline__ float fq_sum(float q) {
    { auto r = __builtin_amdgcn_permlane16_swap(__float_as_uint(q), __float_as_uint(q), false, false); q = __uint_as_float(r[0]) + __uint_as_float(r[1]); }
    { auto r = __builtin_amdgcn_permlane32_swap(__float_as_uint(q), __float_as_uint(q), false, false); q = __uint_as_float(r[0]) + __uint_as_float(r[1]); }
    return q;
}
__device__ __forceinline__ int slot_of_tile(int pm) { return pm < 16 ? 0 : 1 + ((pm - 16) >> 3); }

#define XB_TMO      128
#define XB_XCNT(j)  (256  + 64 * (j))
#define XB_XSUB(j)  (1280 + 64 * (j))
#define XB_XGEN(j)  (2304 + 64 * (j))
#define XB_TOP      3328
#define XB_TOPGEN   3392
#define XCD_BAR_WORDS 3456
#define XB_SPIN_CAP (1u << 18)
__device__ __forceinline__ unsigned xb_ld(unsigned* p)              { return __hip_atomic_load(p, __ATOMIC_RELAXED, __HIP_MEMORY_SCOPE_AGENT); }
__device__ __forceinline__ unsigned xb_add(unsigned* p, unsigned v) { return __hip_atomic_fetch_add(p, v, __ATOMIC_RELAXED, __HIP_MEMORY_SCOPE_AGENT); }
__device__ __forceinline__ unsigned xb_xcc_id() { return (unsigned)__builtin_amdgcn_s_getreg((3 << 11) | 20) & 0xFu; }
#define XB_SPIN(cond, bar) do { unsigned _sp = 0; while (cond) { __builtin_amdgcn_s_sleep(1); \
    if ((++_sp & 255u) == 0u) { if (xb_ld(&(bar)[XB_TMO])) break; if (_sp > XB_SPIN_CAP) { atomicAdd(&(bar)[XB_TMO], 1u); break; } } } } while (0)
struct XcdBarrier { unsigned* bar; unsigned x; volatile LAS unsigned* st; };
__device__ __forceinline__ XcdBarrier xcd_barrier_post(unsigned* bar, volatile LAS unsigned* st) {
    XcdBarrier b; b.bar = bar; b.x = xb_xcc_id(); b.st = st;
    if (threadIdx.x == 0) (void)xb_add(&bar[XB_XCNT(b.x)], 1u);
    return b;
}
__device__ __forceinline__ void xcd_barrier_complete(unsigned* bar, unsigned x, unsigned& nloc, unsigned& nx) {
    const unsigned G = gridDim.x * gridDim.y * gridDim.z;
    unsigned sum, cnt, mine, sp = 0u;
    for (;;) {
        sum = 0u; cnt = 0u; mine = 0u;
#pragma unroll
        for (unsigned j = 0; j < 16; ++j) { const unsigned c = xb_ld(&bar[XB_XCNT(j)]); sum += c; cnt += (c > 0u) ? 1u : 0u; mine = (j == x) ? c : mine; }
        if (sum == G) break;
        __builtin_amdgcn_s_sleep(1);
        if ((++sp & 255u) == 0u) { if (xb_ld(&bar[XB_TMO])) break; if (sp > XB_SPIN_CAP) { atomicAdd(&bar[XB_TMO], 1u); break; } }
    }
    nloc = mine > 0u ? mine : 1u; nx = cnt > 0u ? cnt : 1u;
}
__device__ __forceinline__ void xcd_barrier(const XcdBarrier& b) {
    asm volatile("s_waitcnt vmcnt(0)" ::: "memory");
    __syncthreads();
    if (threadIdx.x == 0) {
        unsigned* bar = b.bar;
        __builtin_amdgcn_s_waitcnt(0);
        unsigned nloc = b.st[0], nx = b.st[1];
        if (nloc == 0u) { xcd_barrier_complete(bar, b.x, nloc, nx); b.st[0] = nloc; b.st[1] = nx; }
        const unsigned old = xb_add(&bar[XB_XSUB(b.x)], 1u);
        const unsigned gen = old / nloc;
        if (old + 1u == (gen + 1u) * nloc && b.st[3] != 0u) {
            asm volatile("s_waitcnt vmcnt(0)" ::: "memory");
            __builtin_amdgcn_fence(__ATOMIC_ACQUIRE, "agent");
            xb_add(&bar[XB_XGEN(b.x)], 1u);
            asm volatile("s_waitcnt vmcnt(0)" ::: "memory");
        } else if (old + 1u == (gen + 1u) * nloc) {
            if (b.st[2] == 0u) __builtin_amdgcn_fence(__ATOMIC_RELEASE, "agent");
            asm volatile("s_waitcnt vmcnt(0)" ::: "memory");
            const unsigned og = xb_add(&bar[XB_TOP], 1u);
            const unsigned tg = og / nx;
            if (og + 1u == (tg + 1u) * nx) xb_add(&bar[XB_TOPGEN], 1u);
            else XB_SPIN(xb_ld(&bar[XB_TOPGEN]) == tg, bar);
            __builtin_amdgcn_fence(__ATOMIC_ACQUIRE, "agent");
            xb_add(&bar[XB_XGEN(b.x)], 1u);
            asm volatile("s_waitcnt vmcnt(0)" ::: "memory");
        } else {
            XB_SPIN(xb_ld(&bar[XB_XGEN(b.x)]) == gen, bar);
            __builtin_amdgcn_fence(__ATOMIC_ACQUIRE, "agent");
            asm volatile("s_waitcnt vmcnt(0)" ::: "memory");
        }
    }
    __syncthreads();
}

struct Args { const float* in[24]; float* out; unsigned char* ws; int ph_lo, ph_hi; };

struct Ctx {
    const Args* a; GAS float* out; GAS unsigned char* ws;
    LAS unsigned char* lds;
    int tid, lane, wave, G, vcu;
};
template <class T> __device__ __forceinline__ GAS T* wsp(const Ctx& F, size_t off) { return (GAS T*)(F.ws + off); }
#define GIN(k) ((const GAS float*)F.a->in[k])

constexpr int BK = 64, HALF = 128, HTB = HALF * BK * 2;
__host__ __device__ __forceinline__ int lds_byte(int r, int c) { const int st = (r >> 4) * 2 + (c >> 5), rr = r & 15, cc = c & 31, ob = rr * 64 + cc * 2; return st * 1024 + (ob ^ (((ob >> 9) & 1) << 5)); }
__host__ __device__ __forceinline__ void stage_rc(int b, int& R, int& C) { const int st = b / 1024, sb = b % 1024, swz = sb ^ (((sb >> 9) & 1) << 5); R = (st >> 1) * 16 + swz / 64; C = (st & 1) * 32 + (swz % 64) / 2; }
__host__ __device__ __forceinline__ int perm32(int rho) { const int n = rho >> 4, i = rho & 15; return 8 * (i >> 2) + 4 * n + (i & 3); }

struct GUnit { unsigned A, B; int K, pm, pn, kind, l; };
__device__ __forceinline__ void map_unit(int L, int nM, int nN, int& pm, int& pn) {
    const int nwg = nM * nN; int wgid = L;
    { const int q = nwg / 8, r = nwg % 8, xcd = wgid % 8, off = wgid / 8; wgid = (xcd < r ? xcd * (q + 1) : r * (q + 1) + (xcd - r) * q) + off; }
    const int nig = 8 * nN, gid = wgid / nig, fm = gid * 8, gsz = (nM - fm) < 8 ? (nM - fm) : 8;
    pm = fm + ((wgid % nig) % gsz); pn = (wgid % nig) / gsz;
}

typedef f32x4 Acc[2][2][4][2];

template <class Sched, class Epi>
__device__ __forceinline__ void gemm_phase(LAS unsigned char* lds, const Sched& S, const Epi& E) {
    int tid_ = threadIdx.x; asm volatile("" : "+v"(tid_));
    const int tid = tid_, wid = __builtin_amdgcn_readfirstlane(tid >> 6), lane = tid & 63, wr = wid >> 2, wc = wid & 3, fr = lane & 15, fq = lane >> 4;
    int sR[2], sRb[2], sC[2];
#define PG8_LANECONST(t_) do { _Pragma("unroll") for (int i = 0; i < 2; ++i) { int R, C; stage_rc((t_) * 16 + i * 8192, R, C); sR[i] = R; sRb[i] = (R & ~31) + perm32(R & 31); sC[i] = C; } } while (0)
    PG8_LANECONST(tid);
    const unsigned kstep = (unsigned)(BK * 2);
    const GAS unsigned char* gws = S.ws;
    const unsigned ldsw = (unsigned)wid * 1024u;
    int aoff = lds_byte(wr * 64 + fr, fq * 8), boff = lds_byte(wc * 32 + fr, fq * 8);
#define PG8_SA(b, h) (((b) * 2 + (h)) * HTB)
#define PG8_SB(b, h) ((4 + (b) * 2 + (h)) * HTB)
#define PG8_STAGE(bufoff, goff, v0, v1) do { \
        __builtin_amdgcn_global_load_lds((const GAS unsigned*)(gws + (size_t)((goff) + (v0))), (LAS unsigned*)(lds + (bufoff) + ldsw), 16, 0, 0); \
        __builtin_amdgcn_global_load_lds((const GAS unsigned*)(gws + (size_t)((goff) + (v1))), (LAS unsigned*)(lds + (bufoff) + ldsw + 8192), 16, 0, 0); } while (0)
#define PG8_LDA(dst, b, h) do { _Pragma("unroll") for (int m = 0; m < 4; ++m) _Pragma("unroll") for (int k = 0; k < 2; ++k) dst[m][k] = *(const LAS bf16x8*)(lds + PG8_SA(b, h) + aoff + m * 2048 + k * 1024); } while (0)
#define PG8_LDB(dst, b, h) do { _Pragma("unroll") for (int n = 0; n < 2; ++n) _Pragma("unroll") for (int k = 0; k < 2; ++k) dst[n][k] = *(const LAS bf16x8*)(lds + PG8_SB(b, h) + boff + n * 2048 + k * 1024); } while (0)
#define PG8_MMA(ai, bj, At, Bt) do { __builtin_amdgcn_s_setprio(1); _Pragma("unroll") for (int m = 0; m < 4; ++m) _Pragma("unroll") for (int n = 0; n < 2; ++n) _Pragma("unroll") for (int k = 0; k < 2; ++k) \
        acc[ai][bj][m][n] = __builtin_amdgcn_mfma_f32_16x16x32_bf16(Bt[n][k], At[m][k], acc[ai][bj][m][n], 0, 0, 0); __builtin_amdgcn_s_setprio(0); } while (0)
#define PG8_WAIT_V(n) asm volatile("s_waitcnt vmcnt(" #n ")" ::: "memory")
#define PG8_WAIT_L(n) asm volatile("s_waitcnt lgkmcnt(" #n ")" ::: "memory")
#define PG8_BAR __builtin_amdgcn_s_barrier()
#define PG8_SCHED __builtin_amdgcn_sched_barrier(0)
    GUnit cur, nxt; int ui = 0;
    if (!S.next(0, cur)) return;
    Acc acc;
#pragma unroll
    for (int a = 0; a < 2; ++a)
#pragma unroll
        for (int b = 0; b < 2; ++b)
#pragma unroll
            for (int m = 0; m < 4; ++m)
#pragma unroll
                for (int n = 0; n < 2; ++n) acc[a][b][m][n] = (f32x4){0.f, 0.f, 0.f, 0.f};
    bf16x8 At[4][2], B0[2][2], B1[2][2];
    unsigned vA0 = (unsigned)(sR[0] * cur.K + sC[0]) * 2u, vA1 = (unsigned)(sR[1] * cur.K + sC[1]) * 2u;
    unsigned vB0 = (unsigned)(sRb[0] * cur.K + sC[0]) * 2u, vB1 = (unsigned)(sRb[1] * cur.K + sC[1]) * 2u;
    unsigned hs = (unsigned)HALF * cur.K * 2;
    unsigned cA = cur.A, cB = cur.B;
    PG8_STAGE(PG8_SB(0, 0), cB, vB0, vB1); PG8_STAGE(PG8_SB(0, 1), cB + hs, vB0, vB1); PG8_STAGE(PG8_SA(0, 0), cA, vA0, vA1); PG8_STAGE(PG8_SA(0, 1), cA + hs, vA0, vA1);
    if (wr == 1) PG8_BAR;
    PG8_WAIT_V(2); PG8_BAR;
    PG8_STAGE(PG8_SB(1, 0), cB + kstep, vB0, vB1); PG8_STAGE(PG8_SA(1, 0), cA + kstep, vA0, vA1); PG8_STAGE(PG8_SB(1, 1), cB + hs + kstep, vB0, vB1);
    PG8_WAIT_V(6); PG8_BAR;
    for (;;) {
        { int tq = tid; asm volatile("" : "+v"(tq)); PG8_LANECONST(tq); const int fr_ = tq & 15, fq_ = (tq & 63) >> 4; aoff = lds_byte(wr * 64 + fr_, fq_ * 8); boff = lds_byte(wc * 32 + fr_, fq_ * 8);
          vA0 = (unsigned)(sR[0] * cur.K + sC[0]) * 2u; vA1 = (unsigned)(sR[1] * cur.K + sC[1]) * 2u; vB0 = (unsigned)(sRb[0] * cur.K + sC[0]) * 2u; vB1 = (unsigned)(sRb[1] * cur.K + sC[1]) * 2u; }
        const bool has_next = S.next(ui + 1, nxt);
        if (!has_next) nxt = cur;
        const unsigned nvA0 = (unsigned)(sR[0] * nxt.K + sC[0]) * 2u, nvA1 = (unsigned)(sR[1] * nxt.K + sC[1]) * 2u;
        const unsigned nvB0 = (unsigned)(sRb[0] * nxt.K + sC[0]) * 2u, nvB1 = (unsigned)(sRb[1] * nxt.K + sC[1]) * 2u;
        const unsigned nhs = (unsigned)HALF * nxt.K * 2;
        const unsigned nA = nxt.A, nB = nxt.B;
        const int nt = cur.K >> 6;
        for (int t = 0; t < nt; t += 2) {
            const bool last = (t == nt - 2);
            const unsigned a1 = cA + (unsigned)(t + 1) * kstep;
            const unsigned a2 = last ? nA : cA + (unsigned)(t + 2) * kstep, b2 = last ? nB : cB + (unsigned)(t + 2) * kstep;
            const unsigned a3 = a2 + kstep, b3 = b2 + kstep;
            const unsigned wA0 = last ? nvA0 : vA0, wA1 = last ? nvA1 : vA1, wB0 = last ? nvB0 : vB0, wB1 = last ? nvB1 : vB1;
            const unsigned hs2 = last ? nhs : hs;
            PG8_LDB(B0, 0, 0); PG8_LDB(B1, 0, 1); PG8_SCHED; PG8_LDA(At, 0, 0); PG8_STAGE(PG8_SA(1, 1), a1 + hs, vA0, vA1);
            PG8_WAIT_V(8); PG8_WAIT_L(0); PG8_BAR; PG8_MMA(0, 0, At, B0); PG8_MMA(0, 1, At, B1); PG8_BAR; PG8_SCHED;
            PG8_LDA(At, 0, 1); PG8_STAGE(PG8_SB(0, 0), b2, wB0, wB1); PG8_STAGE(PG8_SB(0, 1), b2 + hs2, wB0, wB1); PG8_STAGE(PG8_SA(0, 0), a2, wA0, wA1);
            PG8_WAIT_V(8); PG8_WAIT_L(0); PG8_BAR; PG8_MMA(1, 0, At, B0); PG8_MMA(1, 1, At, B1); PG8_BAR; PG8_SCHED;
            PG8_LDB(B0, 1, 0); PG8_LDB(B1, 1, 1); PG8_SCHED; PG8_LDA(At, 1, 0); PG8_STAGE(PG8_SA(0, 1), a2 + hs2, wA0, wA1);
            PG8_WAIT_V(8); PG8_WAIT_L(0); PG8_BAR; PG8_MMA(0, 0, At, B0); PG8_MMA(0, 1, At, B1); PG8_BAR; PG8_SCHED;
            PG8_LDA(At, 1, 1); PG8_STAGE(PG8_SB(1, 0), b3, wB0, wB1); PG8_STAGE(PG8_SB(1, 1), b3 + hs2, wB0, wB1); PG8_STAGE(PG8_SA(1, 0), a3, wA0, wA1);
            PG8_WAIT_V(8); PG8_WAIT_L(0); PG8_BAR; PG8_MMA(1, 0, At, B0); PG8_MMA(1, 1, At, B1); PG8_BAR; PG8_SCHED;
        }
        if (wr == 0) PG8_BAR;
        E(acc, cur, wr, wc, fr, fq, tid, (LAS float*)(lds + RING_BYTES + 2048));
        if (!has_next) break;
#pragma unroll
        for (int a = 0; a < 2; ++a)
#pragma unroll
            for (int b = 0; b < 2; ++b)
#pragma unroll
                for (int m = 0; m < 4; ++m)
#pragma unroll
                    for (int n = 0; n < 2; ++n) acc[a][b][m][n] = (f32x4){0.f, 0.f, 0.f, 0.f};
        cur = nxt; cA = nA; cB = nB; hs = nhs; ++ui;
        if (wr == 1) PG8_BAR;
    }
    PG8_WAIT_V(0);
    PG8_BAR;
#undef PG8_SA
#undef PG8_LANECONST
#undef PG8_SB
#undef PG8_STAGE
#undef PG8_LDA
#undef PG8_LDB
#undef PG8_MMA
#undef PG8_WAIT_V
#undef PG8_WAIT_L
#undef PG8_BAR
#undef PG8_SCHED
}

enum Kind { K_HP = 0, K_CKV = 1, K_U = 2, K_VG = 3, K_CQ0 = 4, K_CQ1 = 5, K_Q = 6, K_KV = 7, K_KVC = 8, K_OUT = 9, K_FF1 = 10, K_FF2 = 11 };

__device__ __forceinline__ u32x4 pack8(const f32x4 a, const f32x4 b) { u32x4 w; w.x = cvt_pk_bf16(a[0], a[1]); w.y = cvt_pk_bf16(a[2], a[3]); w.z = cvt_pk_bf16(b[0], b[1]); w.w = cvt_pk_bf16(b[2], b[3]); return w; }
__device__ __forceinline__ float sum4(const f32x4 v) { return (v[0] + v[1]) + (v[2] + v[3]); }
__device__ __forceinline__ float sq8(const f32x4 a, const f32x4 b) { return (a[0] * a[0] + a[1] * a[1]) + (a[2] * a[2] + a[3] * a[3]) + (b[0] * b[0] + b[1] * b[1]) + (b[2] * b[2] + b[3] * b[3]); }

struct Epi {
    GAS unsigned char* ws; GAS float* out; const GAS float* xp; const GAS float* xs;
    bool dry;

    __device__ __forceinline__ void operator()(Acc& acc, const GUnit& u, int wr, int wc, int fr, int fq, int tid, LAS float* tab) const {
        int rowb_ = u.pm * 256 + wr * 64 + fr, colw_ = wc * 32 + 8 * fq;
        asm volatile("" : "+v"(rowb_), "+v"(colw_));
        const int rowb = rowb_, colw = colw_, s = slot_of_tile(u.pm), l = u.l;
        const bool isctx = u.pm < 16;
        GAS float* xout = out + OUT_X;
        const GAS float* stin = nullptr;
        if (u.kind <= K_CQ1) stin = (const GAS float*)(ws + WS_ST1);
        else if (u.kind == K_Q) stin = (const GAS float*)(ws + WS_STQ);
        else if (u.kind == K_KV) stin = (const GAS float*)(ws + WS_STKV);
        else if (u.kind == K_FF1) stin = (const GAS float*)(ws + WS_ST2);
        const int tagv = ((u.kind <= K_CQ1 ? 0 : u.kind) << 20) | (l << 12) | (u.pm << 2) | 1;
        const bool fresh = stin && __builtin_amdgcn_readfirstlane(*(volatile LAS int*)(tab + 256)) != tagv;
        if (fresh) {
            if (tid < 256) { const int row = u.pm * 256 + tid; float rs;
                if (u.kind == K_Q) { const GAS f32x4* sp = (const GAS f32x4*)(stin + (size_t)row * 8); rs = fast_rsqrt((sum4(sp[0]) + sum4(sp[1])) * (1.0f / QRANK) + EPS) * C2; }
                else if (u.kind == K_KV) { const f32x4 t0 = *(const GAS f32x4*)(stin + (size_t)row * 4); rs = fast_rsqrt(sum4(t0) * (1.0f / KVRANK) + EPS); }
                else { const GAS f32x4* sp = (const GAS f32x4*)(stin + (size_t)row * 16); rs = fast_rsqrt(((sum4(sp[0]) + sum4(sp[1])) + (sum4(sp[2]) + sum4(sp[3]))) * (1.0f / DM) + EPS); }
                tab[tid] = rs; }
            asm volatile("s_waitcnt lgkmcnt(0)" ::: "memory"); __builtin_amdgcn_s_barrier(); asm volatile("" ::: "memory");
            if (tid == 0) *(volatile LAS int*)(tab + 256) = tagv;
        }
        const int rl0 = wr * 64 + fr;
        switch (u.kind) {
        case K_HP: case K_CKV: case K_U: case K_VG: case K_CQ0: case K_CQ1: {
            const GAS float* shw = (const GAS float*)(ws + WS_SHW1) + (size_t)l * NSLOT * INP; const int ldshw = INP;
            const LAS f32x2* rope = (const LAS f32x2*)(tab + 512);
            f32x4 sw[2][2];
#pragma unroll
            for (int bj = 0; bj < 2; ++bj) { const float* p = shw + (size_t)s * ldshw + u.pn * 256 + bj * 128 + colw; sw[bj][0] = *(const f32x4*)p; sw[bj][1] = *(const f32x4*)(p + 4); }
            bf16_t* dst; int ldd, coff = 0; float* st = nullptr; int sto = 0, stw = 4;
            if (u.kind == K_HP) { dst = (bf16_t*)(ws + SPLIT(isctx, HP)); ldd = 256; }
            else if (u.kind == K_CKV) { dst = (bf16_t*)(ws + SPLIT(isctx, CKVR)); ldd = 256; st = (float*)(ws + WS_STKV); }
            else if (u.kind == K_U) { dst = (bf16_t*)(ws + SPLIT(isctx, U)); ldd = 256; }
            else if (u.kind == K_VG) { dst = (bf16_t*)(ws + SPLIT(isctx, GL)); ldd = 256; st = (float*)(ws + WS_STG); }
            else if (u.kind == K_CQ0) { dst = (bf16_t*)(ws + SPLIT(isctx, CQ)); ldd = QRANK; st = (float*)(ws + WS_STQ); stw = 8; }
            else { dst = (bf16_t*)(ws + SPLIT(isctx, CQ)); ldd = QRANK; coff = 256; st = (float*)(ws + WS_STQ); stw = 8; sto = 4; }
            const bool act = (u.kind == K_U || u.kind == K_VG);
#pragma unroll
            for (int ai = 0; ai < 2; ++ai)
#pragma unroll
                for (int m = 0; m < 4; ++m) {
                    asm volatile("" ::: "memory");
                    const int row = rowb + ai * 128 + m * 16;
                    const float rs = tab[rl0 + ai * 128 + m * 16];
                    f32x4 v[2][2];
#pragma unroll
                    for (int bj = 0; bj < 2; ++bj)
#pragma unroll
                        for (int n = 0; n < 2; ++n) { v[bj][n] = acc[ai][bj][m][n] * rs + sw[bj][n];
                            if (act) {
#pragma unroll
                                for (int j = 0; j < 4; ++j) v[bj][n][j] = gelu_tanh(v[bj][n][j]); } }
                    if (u.kind != K_CQ1) {
                        *(u32x4*)(dst + (size_t)row * ldd + coff + colw) = pack8(v[0][0], v[0][1]);
                        *(u32x4*)(dst + (size_t)row * ldd + coff + 128 + colw) = pack8(v[1][0], v[1][1]);
                        if (st) { float q = sq8(v[0][0], v[0][1]) + sq8(v[1][0], v[1][1]); q = fq_sum(q); if (fq == 0) st[(size_t)row * stw + sto + wc] = q; }
                        if (u.kind == K_CKV && isctx) {
                            float* o = out + OUT_CKV + ((size_t)(u.pm * DEPTH + l) * LCTX + (row & 255)) * KVRANK + colw;
                            *(f32x4*)o = v[0][0]; *(f32x4*)(o + 4) = v[0][1]; *(f32x4*)(o + 128) = v[1][0]; *(f32x4*)(o + 132) = v[1][1];
                        }
                    } else {
                        *(u32x4*)(dst + (size_t)row * ldd + coff + colw) = pack8(v[0][0], v[0][1]);
                        { float q = sq8(v[0][0], v[0][1]); q = fq_sum(q); if (fq == 0) st[(size_t)row * stw + sto + wc] = q; }
                        if (wc < 2) {
                            const int p0 = colw, i0 = p0 >> 1, t = row & 255;
                            float x[8] = {v[1][0][0], v[1][0][1], v[1][0][2], v[1][0][3], v[1][1][0], v[1][1][1], v[1][1][2], v[1][1][3]};
                            if (isctx) {
                                float* o = out + OUT_KR + ((size_t)(u.pm * DEPTH + l) * LCTX + t) * 64;
#pragma unroll
                                for (int j = 0; j < 4; ++j) { o[i0 + j] = x[2 * j]; o[32 + i0 + j] = x[2 * j + 1]; }
                                u32x4 w; w.x = cvt_pk_bf16(x[0], x[1]); w.y = cvt_pk_bf16(x[2], x[3]); w.z = cvt_pk_bf16(x[4], x[5]); w.w = cvt_pk_bf16(x[6], x[7]);
                                bf16_t* kd = (bf16_t*)(ws + WS_KC) + ((size_t)(u.pm * NH) * LCTX + t) * 192 + 128 + p0;
#pragma unroll
                                for (int h = 0; h < NH; ++h) *(u32x4*)(kd + (size_t)h * LCTX * 192) = w;
                            } else {
                                const int b = (u.pm - 16) >> 3, tl = ((u.pm - 16) & 7) * 256 + t;
                                const int pos = (wc == 0) ? (tl >> 6) : (tl & 63);
                                float y[8];
#pragma unroll
                                for (int j = 0; j < 4; ++j) { const f32x2 cs = rope[pos * 16 + ((i0 + j) & 15)]; y[2 * j] = x[2 * j] * cs.x - x[2 * j + 1] * cs.y; y[2 * j + 1] = x[2 * j + 1] * cs.x + x[2 * j] * cs.y; }
                                u32x4 w; w.x = cvt_pk_bf16(y[0], y[1]); w.y = cvt_pk_bf16(y[2], y[3]); w.z = cvt_pk_bf16(y[4], y[5]); w.w = cvt_pk_bf16(y[6], y[7]);
                                bf16_t* kd = (bf16_t*)(ws + WS_KL) + ((size_t)(b * NH) * LKEY + PAST + tl) * 192 + 128 + p0;
#pragma unroll
                                for (int h = 0; h < NH; ++h) *(u32x4*)(kd + (size_t)h * LKEY * 192) = w;
                            }
                        }
                    }
                }
        } break;
        case K_Q: {
            const LAS f32x2* rope = (const LAS f32x2*)(tab + 512);
            bf16_t* dst = (bf16_t*)(ws + SPLIT(isctx, Q));
#pragma unroll
            for (int ai = 0; ai < 2; ++ai)
#pragma unroll
                for (int m = 0; m < 4; ++m) {
                    asm volatile("" ::: "memory");
                    const int row = rowb + ai * 128 + m * 16;
                    const float rs = tab[rl0 + ai * 128 + m * 16];
#pragma unroll
                    for (int bj = 0; bj < 2; ++bj) {
                        const int c = u.pn * 256 + bj * 128 + colw, w192 = c % 192;
                        f32x4 v0 = acc[ai][bj][m][0] * rs, v1 = acc[ai][bj][m][1] * rs;
                        if (!isctx && w192 >= 128) {
                            const int i0 = (w192 - 128) >> 1, tl = ((u.pm - 16) & 7) * 256 + (row & 255);
                            const int pos = (i0 < 16) ? (tl >> 6) : (tl & 63);
                            float x[8] = {v0[0], v0[1], v0[2], v0[3], v1[0], v1[1], v1[2], v1[3]}, y[8];
#pragma unroll
                            for (int j = 0; j < 4; ++j) { const f32x2 cs = rope[pos * 16 + ((i0 + j) & 15)]; y[2 * j] = x[2 * j] * cs.x - x[2 * j + 1] * cs.y; y[2 * j + 1] = x[2 * j + 1] * cs.x + x[2 * j] * cs.y; }
                            v0 = (f32x4){y[0], y[1], y[2], y[3]}; v1 = (f32x4){y[4], y[5], y[6], y[7]};
                        }
                        *(u32x4*)(dst + (size_t)row * QW + c) = pack8(v0, v1);
                    }
                }
        } break;
        case K_KV: case K_KVC: {
            const int h = u.pn;
            bf16_t *kd, *vd; int ldrow;
            if (u.kind == K_KVC) { kd = (bf16_t*)(ws + WS_KL) + ((size_t)(u.pm * NH + h) * LKEY) * 192; vd = (bf16_t*)(ws + WS_VL) + ((size_t)(u.pm * NH + h) * LKEY) * 128; }
            else if (isctx) { kd = (bf16_t*)(ws + WS_KC) + ((size_t)(u.pm * NH + h) * LCTX) * 192; vd = (bf16_t*)(ws + WS_VC) + ((size_t)(u.pm * NH + h) * LCTX) * 128; }
            else { const int b = (u.pm - 16) >> 3, k0 = PAST + ((u.pm - 16) & 7) * 256; kd = (bf16_t*)(ws + WS_KL) + ((size_t)(b * NH + h) * LKEY + k0) * 192; vd = (bf16_t*)(ws + WS_VL) + ((size_t)(b * NH + h) * LKEY + k0) * 128; }
            (void)ldrow;
#pragma unroll
            for (int ai = 0; ai < 2; ++ai)
#pragma unroll
                for (int m = 0; m < 4; ++m) {
                    asm volatile("" ::: "memory");
                    const int row = rowb + ai * 128 + m * 16, rl = row & 255;
                    float rs = 1.0f;
                    if (u.kind == K_KV) rs = tab[rl0 + ai * 128 + m * 16];
                    *(u32x4*)(kd + (size_t)rl * 192 + colw) = pack8(acc[ai][0][m][0] * rs, acc[ai][0][m][1] * rs);
                    *(u32x4*)(vd + (size_t)rl * 128 + colw) = pack8(acc[ai][1][m][0] * rs, acc[ai][1][m][1] * rs);
                }
        } break;
        case K_OUT: case K_FF2: {
            const GAS float *gate, *gmn; GAS float* stout;
            if (u.kind == K_OUT) { gate = (const GAS float*)(ws + WS_G1) + (size_t)l * NSLOT * DM; gmn = (const GAS float*)(ws + WS_GM2) + (size_t)l * NSLOT * DM; stout = (GAS float*)(ws + WS_ST2); }
            else { gate = (const GAS float*)(ws + WS_G2) + (size_t)l * NSLOT * DM; gmn = (l + 1 < DEPTH) ? (const GAS float*)(ws + WS_GM1) + (size_t)(l + 1) * NSLOT * DM : nullptr; stout = (GAS float*)(ws + WS_ST1); }
            const bool in32 = (u.kind == K_OUT && l == 0);
            const GAS float* xin = isctx ? xp : xs - (size_t)NCTX * DM;
            GAS bf16_t* xb = (GAS bf16_t*)(ws + WS_XB);
            bf16_t* xg = (bf16_t*)(ws + WS_XG);
            const unsigned cb = (unsigned)(u.pn * 256 + colw);
            const float* gp = gate + (size_t)s * DM + cb; const float* mp_ = gmn ? gmn + (size_t)s * DM + cb : gp;
            if (!in32) {
                GAS unsigned char* const XBB = (GAS unsigned char*)xb; GAS unsigned char* const XGB = (GAS unsigned char*)xg;
                float qa[8];
#pragma unroll
                for (int bj = 0; bj < 2; ++bj) {
                    asm volatile("" ::: "memory");
                    const f32x4 gtA = *(const f32x4*)(gp + bj * 128), gtB = *(const f32x4*)(gp + bj * 128 + 4), gmA = *(const f32x4*)(mp_ + bj * 128), gmB = *(const f32x4*)(mp_ + bj * 128 + 4);
                    u32x4 rb[8];
#pragma unroll
                    for (int r = 0; r < 8; ++r) { const unsigned eb = ((unsigned)(rowb + (r >> 2) * 128 + (r & 3) * 16) * (unsigned)DM + cb + (unsigned)(bj * 128)) * 2u; rb[r] = *(const GAS u32x4*)(XBB + eb); }
                    asm volatile("" ::: "memory");
#pragma unroll
                    for (int r = 0; r < 8; ++r) { const int ai = r >> 2, m = r & 3; const unsigned eb = ((unsigned)(rowb + ai * 128 + m * 16) * (unsigned)DM + cb + (unsigned)(bj * 128)) * 2u;
                        const u32x4 b = rb[r];
                        const f32x4 x0 = (f32x4){bf_lo(b.x), bf_hi(b.x), bf_lo(b.y), bf_hi(b.y)} + gtA * acc[ai][bj][m][0], x1 = (f32x4){bf_lo(b.z), bf_hi(b.z), bf_lo(b.w), bf_hi(b.w)} + gtB * acc[ai][bj][m][1];
                        if (!dry) *(GAS u32x4*)(XBB + eb) = pack8(x0, x1);
                        if (gmn && !dry) *(GAS u32x4*)(XGB + eb) = pack8(x0 * gmA, x1 * gmB);
                        float q_ = sq8(x0, x1); asm volatile("" : "+v"(q_));
                        if (bj == 0) qa[r] = q_;
                        else { const float q = fq_sum(qa[r] + q_); if (fq == 0 && !dry) stout[(size_t)(rowb + ai * 128 + m * 16) * 16 + u.pn * 4 + wc] = q; }
                        asm volatile("" ::: "memory"); }
                }
            } else {
            const f32x4 gt00 = *(const f32x4*)gp, gt01 = *(const f32x4*)(gp + 4), gt10 = *(const f32x4*)(gp + 128), gt11 = *(const f32x4*)(gp + 132);
#pragma unroll
            for (int ai = 0; ai < 2; ++ai)
#pragma unroll
                for (int mp = 0; mp < 2; ++mp) {
                    asm volatile("" ::: "memory");
                    const unsigned e0 = (unsigned)(rowb + ai * 128 + (2 * mp) * 16) * (unsigned)DM + cb, e1 = e0 + 16u * DM;
                    f32x4 r000, r001, r010, r011, r100, r101, r110, r111;
                    if (in32) {
                        r000 = *(const GAS f32x4*)(xin + e0); r001 = *(const GAS f32x4*)(xin + e0 + 4); r010 = *(const GAS f32x4*)(xin + e0 + 128); r011 = *(const GAS f32x4*)(xin + e0 + 132);
                        r100 = *(const GAS f32x4*)(xin + e1); r101 = *(const GAS f32x4*)(xin + e1 + 4); r110 = *(const GAS f32x4*)(xin + e1 + 128); r111 = *(const GAS f32x4*)(xin + e1 + 132);
                    } else {
                        const u32x4 b00 = *(const GAS u32x4*)(xb + e0), b01 = *(const GAS u32x4*)(xb + e0 + 128), b10 = *(const GAS u32x4*)(xb + e1), b11 = *(const GAS u32x4*)(xb + e1 + 128);
                        r000 = (f32x4){bf_lo(b00.x), bf_hi(b00.x), bf_lo(b00.y), bf_hi(b00.y)}; r001 = (f32x4){bf_lo(b00.z), bf_hi(b00.z), bf_lo(b00.w), bf_hi(b00.w)};
                        r010 = (f32x4){bf_lo(b01.x), bf_hi(b01.x), bf_lo(b01.y), bf_hi(b01.y)}; r011 = (f32x4){bf_lo(b01.z), bf_hi(b01.z), bf_lo(b01.w), bf_hi(b01.w)};
                        r100 = (f32x4){bf_lo(b10.x), bf_hi(b10.x), bf_lo(b10.y), bf_hi(b10.y)}; r101 = (f32x4){bf_lo(b10.z), bf_hi(b10.z), bf_lo(b10.w), bf_hi(b10.w)};
                        r110 = (f32x4){bf_lo(b11.x), bf_hi(b11.x), bf_lo(b11.y), bf_hi(b11.y)}; r111 = (f32x4){bf_lo(b11.z), bf_hi(b11.z), bf_lo(b11.w), bf_hi(b11.w)};
                    }
                    const f32x4 gm00 = *(const f32x4*)mp_, gm01 = *(const f32x4*)(mp_ + 4), gm10 = *(const f32x4*)(mp_ + 128), gm11 = *(const f32x4*)(mp_ + 132);
                    {   const int m = 2 * mp;
                        const f32x4 x00 = r000 + gt00 * acc[ai][0][m][0], x01 = r001 + gt01 * acc[ai][0][m][1], x10 = r010 + gt10 * acc[ai][1][m][0], x11 = r011 + gt11 * acc[ai][1][m][1];
                        if (!dry) { *(GAS u32x4*)(xb + e0) = pack8(x00, x01); *(GAS u32x4*)(xb + e0 + 128) = pack8(x10, x11); }
                        if (gmn && !dry) { *(u32x4*)(xg + e0) = pack8(x00 * gm00, x01 * gm01); *(u32x4*)(xg + e0 + 128) = pack8(x10 * gm10, x11 * gm11); }
                        float q = sq8(x00, x01) + sq8(x10, x11); q = fq_sum(q);
                        if (fq == 0 && !dry) stout[(size_t)(rowb + ai * 128 + m * 16) * 16 + u.pn * 4 + wc] = q; }
                    {   const int m = 2 * mp + 1;
                        const f32x4 x00 = r100 + gt00 * acc[ai][0][m][0], x01 = r101 + gt01 * acc[ai][0][m][1], x10 = r110 + gt10 * acc[ai][1][m][0], x11 = r111 + gt11 * acc[ai][1][m][1];
                        if (!dry) { *(GAS u32x4*)(xb + e1) = pack8(x00, x01); *(GAS u32x4*)(xb + e1 + 128) = pack8(x10, x11); }
                        if (gmn && !dry) { *(u32x4*)(xg + e1) = pack8(x00 * gm00, x01 * gm01); *(u32x4*)(xg + e1 + 128) = pack8(x10 * gm10, x11 * gm11); }
                        float q = sq8(x00, x01) + sq8(x10, x11); q = fq_sum(q);
                        if (fq == 0 && !dry) stout[(size_t)(rowb + ai * 128 + m * 16) * 16 + u.pn * 4 + wc] = q; }
                }
            }
        } break;
        case K_FF1: {
            const GAS float* shw = (const GAS float*)(ws + WS_SHW2) + (size_t)l * NSLOT * DFF; const int ldshw = DFF;
            f32x4 sw[2][2];
#pragma unroll
            for (int bj = 0; bj < 2; ++bj) { const float* p = shw + (size_t)s * ldshw + u.pn * 256 + bj * 128 + colw; sw[bj][0] = *(const f32x4*)p; sw[bj][1] = *(const f32x4*)(p + 4); }
            bf16_t* dst = (bf16_t*)(ws + SPLIT(isctx, HID));
#pragma unroll
            for (int ai = 0; ai < 2; ++ai)
#pragma unroll
                for (int m = 0; m < 4; ++m) {
                    asm volatile("" ::: "memory");
                    const int row = rowb + ai * 128 + m * 16;
                    const float rs = tab[rl0 + ai * 128 + m * 16];
#pragma unroll
                    for (int bj = 0; bj < 2; ++bj) {
                        f32x4 v0 = acc[ai][bj][m][0] * rs + sw[bj][0], v1 = acc[ai][bj][m][1] * rs + sw[bj][1];
#pragma unroll
                        for (int j = 0; j < 4; ++j) { const float a = fmaxf(v0[j], 0.f), b = fmaxf(v1[j], 0.f); v0[j] = a * a; v1[j] = b * b; }
                        *(u32x4*)(dst + (size_t)row * DFF + u.pn * 256 + bj * 128 + colw) = pack8(v0, v1);
                    }
                }
        } break;
        default: break;
        }
    }
};

struct GList { size_t aoff, boff; int K, nM, nN, pm0, kind, l, n0, q0, q1; };
#define GL_(ao, bo, K_, nM_, nN_, pm0_, kind_, l_, n0_, q0_, q1_) do { g.aoff = (ao); g.boff = (bo); g.K = (K_); g.nM = (nM_); g.nN = (nN_); g.pm0 = (pm0_); g.kind = (kind_); g.l = (l_); g.n0 = (n0_); g.q0 = (q0_); g.q1 = (q1_); return true; } while (0)
__device__ __forceinline__ bool slot_list(int sub, int j, int l, GList& g) {
    const size_t oWIN = WS_WIN + (size_t)l * INP * DM * 2, oWUQ = WS_WUQ + (size_t)l * QW * QRANK * 2, oWKVF = WS_WKVF + (size_t)l * KVW * KVRANK * 2, oWKVC = WS_WKVC + (size_t)l * KVW * KVRANK * 2;
    const size_t oWOUT = WS_WOUT + (size_t)l * DM * DM * 2, oWF1 = WS_WF1 + (size_t)l * DFF * DM * 2, oWF2 = WS_WF2 + (size_t)l * DM * DFF * 2;
    switch (sub) {
    case -1: if (j == 0) GL_(WS_XG, oWIN, DM, 16, 6, 0, -1, 0, 12, 1, 0); break;
    case 0:  if (j == 0) GL_(WS_XG, oWIN, DM, 64, 6, 16, -1, l, 16, 2, 1);
             if (j == 1) GL_(CQ_C, oWUQ, QRANK, 16, 3, 0, K_Q, l, 16, 0, 1);
             if (j == 2) GL_(CKVR_C, oWKVF, KVRANK, 16, 4, 0, K_KV, l, 22, 0, 1); break;
    case 1:  if (j == 0) GL_(CQ_L, oWUQ, QRANK, 64, 3, 16, K_Q, l, 24, 1, 0);
             if (j == 1) GL_(CKVR_L, oWKVF, KVRANK, 64, 4, 16, K_KV, l, 32, 1, 0);
             if (j == 2) GL_(WS_CCKV + (size_t)l * NLATB * PAST * KVRANK * 2, oWKVC, KVRANK, 8, 4, 0, K_KVC, l, 4, 1, 0); break;
    case 2:  if (j == 0) GL_(YCAT_C, oWOUT, DM, 16, 4, 0, K_OUT, l, 8, 1, 0); break;
    case 3:  if (j == 0) GL_(YCAT_L, oWOUT, DM, 64, 4, 16, K_OUT, l, 32, 1, 0);
             if (j == 1) GL_(WS_XG, oWF1, DM, 16, 16, 0, K_FF1, l, 32, 1, 0); break;
    case 4:  if (j == 0) GL_(HID_C, oWF2, DFF, 16, 4, 0, K_FF2, l, 8, 1, 0);
             if (j == 1) GL_(WS_XG, oWF1, DM, 64, 16, 16, K_FF1, l, 8, 1, -5); break;
    default: if (j == 0) GL_(HID_L, oWF2, DFF, 64, 4, 16, K_FF2, l, 32, 1, 0);
             if (j == 1 && l + 1 < DEPTH) GL_(WS_XG, oWIN + (size_t)INP * DM * 2, DM, 16, 6, 0, -1, l + 1, 12, 1, 0); break;
    }
    return false;
}
#undef GL_
struct SchedSlot {
    const GAS unsigned char* ws; int c, G, sub, l;
    __device__ __forceinline__ bool next(int i, GUnit& u) const {
        int k = i;
        const int x = c >> 5, li = c & 31;
#pragma unroll
        for (int j = 0; j < 3; ++j) {
            GList g; if (!slot_list(sub, (sub == 3 && (c & 1)) ? (j ^ 1) : j, l, g)) { if (sub == 3 && j < 2) continue; return false; }
            int pm, pn; bool hit = false;
            if (G == 256) {
                const int rM = g.nM >> 3, n = rM * g.nN;
                if (g.q1 < 0) {
                    const int qa = -g.q1, t = li - g.n0, qe = li < g.n0 ? g.q0 : qa;
                    if (k < qe) { pm = g.pm0 + rM * x + (li < g.n0 ? li % rM : t % rM); pn = li < g.n0 ? ((32 - g.n0) / rM) * qa + li / rM : (t / rM) * qa + k; hit = true; } else k -= qe;
                } else {
                const int q = li < g.n0 ? g.q0 : g.q1, start = li < g.n0 ? li * g.q0 : g.n0 * g.q0 + (li - g.n0) * g.q1;
                int qe = n - start; qe = qe < 0 ? 0 : (qe < q ? qe : q);
                if (k < qe) { const int lidx = start + k; pm = g.pm0 + rM * x + (lidx % rM); pn = lidx / rM; hit = true; } else k -= qe;
                }
            } else {
                const int n = g.nM * g.nN, q = (n + G - 1) / G, start = c * q;
                int qe = n - start; qe = qe < 0 ? 0 : (qe < q ? qe : q);
                if (k < qe) { const int idx = start + k; pm = g.pm0 + idx % g.nM; pn = idx / g.nM; hit = true; } else k -= qe;
            }
            if (hit) { u.A = (unsigned)(g.aoff + (size_t)pm * 256 * g.K * 2); u.B = (unsigned)(g.boff + (size_t)pn * 256 * g.K * 2); u.K = g.K; u.pm = pm; u.pn = pn; u.kind = g.kind < 0 ? pn : g.kind; u.l = g.l; return true; }
        }
        return false;
    }
};

#define KSWZ(row, colB) ((row) * 256 + ((colB) ^ (((row) & 15) << 4)))
#define KRSWZ(row, colB) ((row) * 128 + ((colB) ^ ((((row) >> 1) & 7) << 4)))
__device__ __forceinline__ int crow(int r, int hi) { return (r & 3) + 8 * (r >> 2) + 4 * hi; }
__device__ __forceinline__ int v_rd_base(int lane) { return ((lane & 3) << 3) | (((lane >> 2) & 3) << 6) | (((lane >> 4) & 1) << 5) | (((lane >> 5) & 1) << 8); }
constexpr int v_rd_off(int d0, int ks, int half) { return d0 * 512 + ks * 4096 + half * 2048; }
template <int OFF> __device__ __forceinline__ s16x4 tr_read(int vb) { s16x4 r; asm volatile("ds_read_b64_tr_b16 %0, %1 offset:%2" : "=&v"(r) : "v"(vb), "i"(OFF) : "memory"); return r; }
struct VFrag { s16x4 l0, h0, l1, h1, l2, h2, l3, h3; };
template <int D0> __device__ __forceinline__ void pv_read(VFrag& f, int vb) {
    f.l0 = tr_read<v_rd_off(D0, 0, 0)>(vb); f.h0 = tr_read<v_rd_off(D0, 0, 1)>(vb); f.l1 = tr_read<v_rd_off(D0, 1, 0)>(vb); f.h1 = tr_read<v_rd_off(D0, 1, 1)>(vb);
    f.l2 = tr_read<v_rd_off(D0, 2, 0)>(vb); f.h2 = tr_read<v_rd_off(D0, 2, 1)>(vb); f.l3 = tr_read<v_rd_off(D0, 3, 0)>(vb); f.h3 = tr_read<v_rd_off(D0, 3, 1)>(vb);
}
__device__ __forceinline__ void pv_wait(VFrag& f) {
    asm volatile("s_waitcnt lgkmcnt(0)" : "+v"(f.l0), "+v"(f.h0), "+v"(f.l1), "+v"(f.h1), "+v"(f.l2), "+v"(f.h2), "+v"(f.l3), "+v"(f.h3) :: "memory"); SBAR();
}
__device__ __forceinline__ void pv_mma(f32x16& od, const VFrag& f, bf16x8 pa0, bf16x8 pa1, bf16x8 pa2, bf16x8 pa3) {
#define PK(L, H) (bf16x8){L[0], L[1], L[2], L[3], H[0], H[1], H[2], H[3]}
    od = __builtin_amdgcn_mfma_f32_32x32x16_bf16(pa0, PK(f.l0, f.h0), od, 0, 0, 0);
    od = __builtin_amdgcn_mfma_f32_32x32x16_bf16(pa1, PK(f.l1, f.h1), od, 0, 0, 0);
    od = __builtin_amdgcn_mfma_f32_32x32x16_bf16(pa2, PK(f.l2, f.h2), od, 0, 0, 0);
    od = __builtin_amdgcn_mfma_f32_32x32x16_bf16(pa3, PK(f.l3, f.h3), od, 0, 0, 0);
#undef PK
}
constexpr int A_V = 0, A_KN = 32768, A_KR = 65536, A_WS = 81920, A_OST = 0;
constexpr float ATT_THR = 6.0f;
__device__ __forceinline__ void attn_unit(LAS unsigned char* ldsb, const GAS bf16_t* __restrict__ Qb, const GAS bf16_t* __restrict__ Kh, const GAS bf16_t* __restrict__ Vh, GAS bf16_t* __restrict__ Ob, int seq) {
    int tid_ = threadIdx.x; asm volatile("" : "+v"(tid_));
    const int tid = tid_, wid = __builtin_amdgcn_readfirstlane(tid >> 6), lane = tid & 63, r32 = lane & 31, hi = lane >> 5;
    char* lds = (char*)ldsb;
    char* Kn_lds = lds + A_KN; char* Kr_lds = lds + A_KR;
    float* wsf = (float*)(lds + A_WS) + wid * 64; float* li_l = wsf; float* al_l = wsf + 32;
    float m_reg = -1e30f, l_reg = 0.f; f32x16 o[4] = {}; bf16x8 qr[12];
    const GAS bf16_t* Qw = Qb + (size_t)(wid * 32 + r32) * QW + hi * 8;
#pragma unroll
    for (int d0 = 0; d0 < 12; ++d0) qr[d0] = *(const GAS bf16x8*)(Qw + d0 * 16);
#pragma unroll
    for (int d0 = 0; d0 < 12; ++d0) asm volatile("" : "+v"(qr[d0]));
    unsigned gk0, gk1, gkr, gv0, gv1;
    { int r = 4 * wid + (lane >> 4), c = (lane & 15) ^ (r & 15); gk0 = (unsigned)(r * 192 + c * 8);
      r = 4 * (wid + 8) + (lane >> 4); c = (lane & 15) ^ (r & 15); gk1 = (unsigned)(r * 192 + c * 8);
      r = 8 * wid + (lane >> 3); c = (lane & 7) ^ ((r >> 1) & 7); gkr = (unsigned)(r * 192 + 128 + c * 8);
      int p = wid, kk = (p >> 1) * 8 + ((lane & 31) >> 2), k = (kk & ~0xC) | ((kk & 4) << 1) | ((kk & 8) >> 1); gv0 = (unsigned)(k * 128 + (2 * (p & 1) + (lane >> 5)) * 32 + (lane & 3) * 8);
      p = wid + 8; kk = (p >> 1) * 8 + ((lane & 31) >> 2); k = (kk & ~0xC) | ((kk & 4) << 1) | ((kk & 8) >> 1); gv1 = (unsigned)(k * 128 + (2 * (p & 1) + (lane >> 5)) * 32 + (lane & 3) * 8); }
    const int vb0 = (int)(uintptr_t)(lds + A_V) + v_rd_base(lane);
#define ADMA(k0, b) do { const GAS bf16_t* kt = Kh + (size_t)(k0) * 192; const GAS bf16_t* vt = Vh + (size_t)(k0) * 128; \
        __builtin_amdgcn_global_load_lds((const GAS unsigned*)(kt + gk0), (LAS unsigned*)(ldsb + A_KN + (b) * 16384 + wid * 1024), 16, 0, 0); \
        __builtin_amdgcn_global_load_lds((const GAS unsigned*)(kt + gk1), (LAS unsigned*)(ldsb + A_KN + (b) * 16384 + (wid + 8) * 1024), 16, 0, 0); \
        __builtin_amdgcn_global_load_lds((const GAS unsigned*)(kt + gkr), (LAS unsigned*)(ldsb + A_KR + (b) * 8192 + wid * 1024), 16, 0, 0); \
        __builtin_amdgcn_global_load_lds((const GAS unsigned*)(vt + gv0), (LAS unsigned*)(ldsb + A_V + (b) * 16384 + wid * 1024), 16, 0, 0); \
        __builtin_amdgcn_global_load_lds((const GAS unsigned*)(vt + gv1), (LAS unsigned*)(ldsb + A_V + (b) * 16384 + (wid + 8) * 1024), 16, 0, 0); } while (0)
#define AWAITBAR() do { asm volatile("s_waitcnt vmcnt(0) lgkmcnt(0)" ::: "memory"); __builtin_amdgcn_s_barrier(); asm volatile("" ::: "memory"); } while (0)
    const int NT = seq / 64;
    ADMA(0, 0); AWAITBAR();
    for (int j = 0; j < NT; ++j) {
        const int cb = j & 1;
        if (j + 1 < NT) ADMA((j + 1) * 64, cb ^ 1);
        f32x16 p0 = {}, p1 = {};
        { const char* Kn = Kn_lds + cb * 16384; const char* Kr = Kr_lds + cb * 8192;
#define KFRAG(G, I, ROWOFF) ((G) < 4 ? *(const bf16x8*)(Kn + KSWZ((ROWOFF) + r32, ((2 * (G) + (I)) * 16 + hi * 8) * 2)) : *(const bf16x8*)(Kr + KRSWZ((ROWOFF) + r32, ((2 * ((G) - 4) + (I)) * 16 + hi * 8) * 2)))
#define KLOADG(G, X0, X1, Y0, Y1) do { X0 = KFRAG(G, 0, 0); Y0 = KFRAG(G, 0, 32); X1 = KFRAG(G, 1, 0); Y1 = KFRAG(G, 1, 32); } while (0)
#define KPIN(X0, X1, Y0, Y1) asm volatile("" : "+v"(X0), "+v"(Y0), "+v"(X1), "+v"(Y1))
#define KMMAG(G, X0, X1, Y0, Y1) do { \
              p0 = __builtin_amdgcn_mfma_f32_32x32x16_bf16(X0, qr[2 * (G)], p0, 0, 0, 0); p1 = __builtin_amdgcn_mfma_f32_32x32x16_bf16(Y0, qr[2 * (G)], p1, 0, 0, 0); \
              p0 = __builtin_amdgcn_mfma_f32_32x32x16_bf16(X1, qr[2 * (G) + 1], p0, 0, 0, 0); p1 = __builtin_amdgcn_mfma_f32_32x32x16_bf16(Y1, qr[2 * (G) + 1], p1, 0, 0, 0); } while (0)
          bf16x8 fa0, fa1, fb0, fb1, ga0, ga1, gb0, gb1;
          KLOADG(0, fa0, fa1, fb0, fb1); SBAR(); KPIN(fa0, fa1, fb0, fb1); SBAR();
          KLOADG(1, ga0, ga1, gb0, gb1); SBAR(); KMMAG(0, fa0, fa1, fb0, fb1); SBAR(); KPIN(ga0, ga1, gb0, gb1); SBAR();
          KLOADG(2, fa0, fa1, fb0, fb1); SBAR(); KMMAG(1, ga0, ga1, gb0, gb1); SBAR(); KPIN(fa0, fa1, fb0, fb1); SBAR();
          KLOADG(3, ga0, ga1, gb0, gb1); SBAR(); KMMAG(2, fa0, fa1, fb0, fb1); SBAR(); KPIN(ga0, ga1, gb0, gb1); SBAR();
          KLOADG(4, fa0, fa1, fb0, fb1); SBAR(); KMMAG(3, ga0, ga1, gb0, gb1); SBAR(); KPIN(fa0, fa1, fb0, fb1); SBAR();
          KLOADG(5, ga0, ga1, gb0, gb1); SBAR(); KMMAG(4, fa0, fa1, fb0, fb1); SBAR(); KPIN(ga0, ga1, gb0, gb1); SBAR();
          KMMAG(5, ga0, ga1, gb0, gb1); SBAR();
#undef KPIN
#undef KFRAG
#undef KLOADG
#undef KMMAG
        }
        float pmax = p0[0];
#pragma unroll
        for (int r = 1; r < 16; ++r) pmax = fmaxf(pmax, p0[r]);
#pragma unroll
        for (int r = 0; r < 16; ++r) pmax = fmaxf(pmax, p1[r]);
        { auto rr = __builtin_amdgcn_permlane32_swap(__float_as_uint(pmax), __float_as_uint(pmax), false, false); pmax = fmaxf(__uint_as_float(rr[0]), __uint_as_float(rr[1])); }
        float alpha = 1.f;
        if (!__all(pmax - m_reg <= ATT_THR)) { const float mn = fmaxf(m_reg, pmax); alpha = __builtin_amdgcn_exp2f(m_reg - mn); m_reg = mn; }
        float ps = 0.f;
#pragma unroll
        for (int r = 0; r < 16; ++r) { p0[r] = __builtin_amdgcn_exp2f(p0[r] - m_reg); p1[r] = __builtin_amdgcn_exp2f(p1[r] - m_reg); ps += p0[r] + p1[r]; }
        { auto rr = __builtin_amdgcn_permlane32_swap(__float_as_uint(ps), __float_as_uint(ps), false, false); ps = __uint_as_float(rr[0]) + __uint_as_float(rr[1]); }
        l_reg = l_reg * alpha + ps;
        bf16x8 pa0, pa1, pa2, pa3;
#define PK4(P, BASE, OUT) do { unsigned a0 = cvt_pk_bf16(P[BASE + 0], P[BASE + 1]), a1 = cvt_pk_bf16(P[BASE + 2], P[BASE + 3]);   \
        unsigned b0 = cvt_pk_bf16(P[BASE + 4], P[BASE + 5]), b1 = cvt_pk_bf16(P[BASE + 6], P[BASE + 7]);                              \
        auto r0 = __builtin_amdgcn_permlane32_swap(a0, b0, false, false); auto r1 = __builtin_amdgcn_permlane32_swap(a1, b1, false, false); \
        u32x4 w = {r0[0], r1[0], r0[1], r1[1]}; OUT = *reinterpret_cast<bf16x8*>(&w); } while (0)
        PK4(p0, 0, pa0); PK4(p0, 8, pa1); PK4(p1, 0, pa2); PK4(p1, 8, pa3);
#undef PK4
        if (__any(alpha < 1.f)) { if (hi == 0) al_l[r32] = alpha; LDS_WAIT();
#pragma unroll
            for (int d = 0; d < 4; ++d)
#pragma unroll
                for (int r = 0; r < 16; ++r) o[d][r] *= al_l[crow(r, hi)]; }
        { const int vb = vb0 + cb * 16384;
          VFrag va, vc;
          pv_read<0>(va, vb); pv_wait(va);
          pv_read<1>(vc, vb); SBAR(); pv_mma(o[0], va, pa0, pa1, pa2, pa3); SBAR(); pv_wait(vc);
          pv_read<2>(va, vb); SBAR(); pv_mma(o[1], vc, pa0, pa1, pa2, pa3); SBAR(); pv_wait(va);
          pv_read<3>(vc, vb); SBAR(); pv_mma(o[2], va, pa0, pa1, pa2, pa3); SBAR(); pv_wait(vc);
          pv_mma(o[3], vc, pa0, pa1, pa2, pa3); SBAR(); }
        AWAITBAR();
    }
#undef ADMA
#undef AWAITBAR
    if (hi == 0) li_l[r32] = l_reg; LDS_WAIT();
    float rli[16];
#pragma unroll
    for (int r = 0; r < 16; ++r) rli[r] = __builtin_amdgcn_rcpf(li_l[crow(r, hi)]);
    bf16_t* stg = (bf16_t*)(lds + A_OST) + wid * 4096;
#pragma unroll
    for (int r = 0; r < 16; ++r) { const int orow = crow(r, hi);
#pragma unroll
        for (int d0 = 0; d0 < 4; ++d0) stg[orow * 128 + d0 * 32 + r32] = f2bf(o[d0][r] * rli[r]); }
    LDS_WAIT();
#pragma unroll
    for (int i = 0; i < 8; ++i) { const int id = lane + 64 * i, row = id >> 4, ch = id & 15; const u32x4 v = *(const u32x4*)(stg + row * 128 + ch * 8); *(GAS u32x4*)(Ob + (size_t)(wid * 32 + row) * DM + ch * 8) = v; }
    LDS_WAIT();
    __syncthreads();
}

__device__ __forceinline__ void pool_unit(const Ctx& F, int l, int pm, int g0, int g1) {
    char* lds = (char*)F.lds;
    int tid_ = threadIdx.x; asm volatile("" : "+v"(tid_));
    const int tid = tid_, lane = tid & 63, wid = __builtin_amdgcn_readfirstlane(tid >> 6), fr = lane & 15, fq = lane >> 4;
    const bool isctx0 = pm < 16;
    const bf16_t* HP = wsp<const bf16_t>(F, SPLIT(isctx0, HP)); bf16_t* Y = wsp<bf16_t>(F, SPLIT(isctx0, YCAT));
    const bf16_t* WPT = wsp<const bf16_t>(F, WS_WPT) + (size_t)l * 4 * 4096;
    const float* pscale = GIN(11) + (size_t)l * 256;
    const int row0 = pm * 256; const bool isctx = pm < 16;
    const int L = isctx ? LCTX : LLAT, t0 = isctx ? 0 : ((pm - 16) & 7) * 256, seq0 = row0 - t0;
    bf16_t* hbuf = (bf16_t*)lds; bf16_t* abuf = (bf16_t*)(lds + 36864);
    for (int g = g0; g < g1; ++g) {
        const int w = 2 << g, hw = w >> 1;
        u32x4 hv[5];
#pragma unroll
        for (int i = 0; i < 5; ++i) { const int id = tid + 512 * i, rr = id >> 3, ch = id & 7, t = t0 - 8 + rr;
            hv[i] = (u32x4){0u, 0u, 0u, 0u}; if (id < 272 * 8 && t >= 0 && t < L) hv[i] = *(const u32x4*)(HP + (size_t)(seq0 + t) * 256 + g * 64 + ch * 8); }
        bf16x8 xa[2][4]; f32x4 psc[4];
#pragma unroll
        for (int ks = 0; ks < 2; ++ks)
#pragma unroll
            for (int nb = 0; nb < 4; ++nb) xa[ks][nb] = *(const bf16x8*)(WPT + (size_t)g * 4096 + (nb * 16 + fr) * 64 + ks * 32 + fq * 8);
#pragma unroll
        for (int nb = 0; nb < 4; ++nb) psc[nb] = *(const f32x4*)(pscale + g * 64 + nb * 16 + 4 * fq);
#pragma unroll
        for (int i = 0; i < 5; ++i) { const int id = tid + 512 * i, rr = id >> 3, ch = id & 7; if (id < 272 * 8) *(u32x4*)(hbuf + rr * 64 + ch * 8) = hv[i]; }
        __syncthreads();
#pragma unroll
        for (int it = 0; it < 4; ++it) { const int id = tid + 512 * it, tt = id >> 3, ch = id & 7, t = t0 + tt;
            const int lo = max(t - hw, 0), hiw = min(t + hw, L); float s[8] = {0, 0, 0, 0, 0, 0, 0, 0};
            for (int dq = -hw; dq < hw; ++dq) { const int q = t + dq; if (q >= lo && q < hiw) { const u32x4 v = *(const u32x4*)(hbuf + (tt + dq + 8) * 64 + ch * 8);
                s[0] += bf_lo(v.x); s[1] += bf_hi(v.x); s[2] += bf_lo(v.y); s[3] += bf_hi(v.y); s[4] += bf_lo(v.z); s[5] += bf_hi(v.z); s[6] += bf_lo(v.w); s[7] += bf_hi(v.w); } }
            const float ic = __builtin_amdgcn_rcpf((float)(hiw - lo)); const u32x4 c = *(const u32x4*)(hbuf + (tt + 8) * 64 + ch * 8);
            u32x4 o; o.x = cvt_pk_bf16(s[0] * ic - bf_lo(c.x), s[1] * ic - bf_hi(c.x)); o.y = cvt_pk_bf16(s[2] * ic - bf_lo(c.y), s[3] * ic - bf_hi(c.y));
            o.z = cvt_pk_bf16(s[4] * ic - bf_lo(c.z), s[5] * ic - bf_hi(c.z)); o.w = cvt_pk_bf16(s[6] * ic - bf_lo(c.w), s[7] * ic - bf_hi(c.w));
            *(u32x4*)(abuf + tt * 64 + ch * 8) = o; }
        __syncthreads();
        f32x4 acc[2][4];
#pragma unroll
        for (int mb = 0; mb < 2; ++mb)
#pragma unroll
            for (int nb = 0; nb < 4; ++nb) acc[mb][nb] = (f32x4){0.f, 0.f, 0.f, 0.f};
#pragma unroll
        for (int ks = 0; ks < 2; ++ks) {
            bf16x8 ya[2];
#pragma unroll
            for (int mb = 0; mb < 2; ++mb) ya[mb] = *(const bf16x8*)(abuf + (wid * 32 + mb * 16 + fr) * 64 + ks * 32 + fq * 8);
#pragma unroll
            for (int mb = 0; mb < 2; ++mb)
#pragma unroll
                for (int nb = 0; nb < 4; ++nb) acc[mb][nb] = __builtin_amdgcn_mfma_f32_16x16x32_bf16(xa[ks][nb], ya[mb], acc[mb][nb], 0, 0, 0);
        }
#pragma unroll
        for (int mb = 0; mb < 2; ++mb)
#pragma unroll
            for (int nb = 0; nb < 4; ++nb) { const int d = nb * 16 + 4 * fq; const f32x4 v = acc[mb][nb] * psc[nb];
                u32x2 o; o.x = cvt_pk_bf16(v[0], v[1]); o.y = cvt_pk_bf16(v[2], v[3]);
                *(u32x2*)(Y + (size_t)(row0 + wid * 32 + mb * 16 + fr) * DM + g * 64 + d) = o; }
        __syncthreads();
    }
}

__device__ __forceinline__ void gmlp_unit(const Ctx& F, int l, int chunk) {
    char* lds = (char*)F.lds;
    int tid_ = threadIdx.x; asm volatile("" : "+v"(tid_));
    const int tid = tid_, lane = tid & 63, wid = __builtin_amdgcn_readfirstlane(tid >> 6), fr = lane & 15, fq = lane >> 4;
    const bool isctx0 = chunk < 32;
    const bf16_t* GL = wsp<const bf16_t>(F, SPLIT(isctx0, GL)); const bf16_t* U = wsp<const bf16_t>(F, SPLIT(isctx0, U)); bf16_t* Y = wsp<bf16_t>(F, SPLIT(isctx0, YCAT));
    const float* STG = wsp<const float>(F, WS_STG);
    const bf16_t* WSB = wsp<const bf16_t>(F, WS_WSB) + (size_t)l * 4 * 16384;
    const float* gsgu = GIN(16) + (size_t)l * 256; const float* bs = GIN(18) + (size_t)l * 4 * 128;
    const int r0 = chunk * 128;
    float* rsg = (float*)lds; bf16_t* vT = (bf16_t*)(lds + 1024); constexpr int LDT = 136, VTG = 64 * LDT;
    u32x4 gv[4][2]; f32x4 g0v[4][2], g1v[4][2]; u32x2 uu[4][4]; float bp[4];
#pragma unroll
    for (int g = 0; g < 4; ++g)
#pragma unroll
        for (int i = 0; i < 2; ++i) { const int id = tid + 512 * i, q = id >> 3, cc = (id & 7) * 8;
            gv[g][i] = *(const u32x4*)(GL + (size_t)(r0 + q) * 256 + g * 64 + cc); g0v[g][i] = *(const f32x4*)(gsgu + g * 64 + cc); g1v[g][i] = *(const f32x4*)(gsgu + g * 64 + cc + 4); }
    const int p = wid * 16 + fr;
#pragma unroll
    for (int g = 0; g < 4; ++g) { bp[g] = bs[g * 128 + p];
#pragma unroll
        for (int nb = 0; nb < 4; ++nb) uu[g][nb] = *(const u32x2*)(U + (size_t)(r0 + p) * 256 + g * 64 + nb * 16 + 4 * fq); }
    if (tid < 128) { const f32x4 t = *(const f32x4*)(STG + (size_t)(r0 + tid) * 4); rsg[tid] = fast_rsqrt(sum4(t) * (1.0f / 256.0f) + EPS); }
    __syncthreads();
#pragma unroll
    for (int g = 0; g < 4; ++g)
#pragma unroll
        for (int i = 0; i < 2; ++i) { const int id = tid + 512 * i, q = id >> 3, cc = (id & 7) * 8; const float rs = rsg[q]; bf16_t* vt = vT + g * VTG; const u32x4 v = gv[g][i]; const f32x4 g0 = g0v[g][i], g1 = g1v[g][i];
            vt[(cc + 0) * LDT + q] = f2bf(bf_lo(v.x) * rs * g0[0]); vt[(cc + 1) * LDT + q] = f2bf(bf_hi(v.x) * rs * g0[1]);
            vt[(cc + 2) * LDT + q] = f2bf(bf_lo(v.y) * rs * g0[2]); vt[(cc + 3) * LDT + q] = f2bf(bf_hi(v.y) * rs * g0[3]);
            vt[(cc + 4) * LDT + q] = f2bf(bf_lo(v.z) * rs * g1[0]); vt[(cc + 5) * LDT + q] = f2bf(bf_hi(v.z) * rs * g1[1]);
            vt[(cc + 6) * LDT + q] = f2bf(bf_lo(v.w) * rs * g1[2]); vt[(cc + 7) * LDT + q] = f2bf(bf_hi(v.w) * rs * g1[3]); }
    __syncthreads();
#pragma unroll
    for (int g = 0; g < 4; ++g) {
        bf16x8 ya[4];
#pragma unroll
        for (int ks = 0; ks < 4; ++ks) ya[ks] = *(const bf16x8*)(WSB + (size_t)g * 16384 + (wid * 16 + fr) * 128 + ks * 32 + fq * 8);
        f32x4 acc[4];
#pragma unroll
        for (int nb = 0; nb < 4; ++nb) acc[nb] = (f32x4){0.f, 0.f, 0.f, 0.f};
#pragma unroll
        for (int ks = 0; ks < 4; ++ks)
#pragma unroll
            for (int nb = 0; nb < 4; ++nb) { const bf16x8 xa = *(const bf16x8*)(vT + g * VTG + (nb * 16 + fr) * LDT + ks * 32 + fq * 8);
                acc[nb] = __builtin_amdgcn_mfma_f32_16x16x32_bf16(xa, ya[ks], acc[nb], 0, 0, 0); }
#pragma unroll
        for (int nb = 0; nb < 4; ++nb) { const int c = nb * 16 + 4 * fq; const u32x2 u2 = uu[g][nb];
            u32x2 o; o.x = cvt_pk_bf16(bf_lo(u2.x) * (acc[nb][0] + bp[g]), bf_hi(u2.x) * (acc[nb][1] + bp[g])); o.y = cvt_pk_bf16(bf_lo(u2.y) * (acc[nb][2] + bp[g]), bf_hi(u2.y) * (acc[nb][3] + bp[g]));
            *(u32x2*)(Y + (size_t)(r0 + p) * DM + 768 + g * 64 + c) = o; }
    }
    __syncthreads();
}

enum MapKind { MAP_ID = 0, MAP_WIN = 1, MAP_WUQ = 2 };
__device__ __forceinline__ int colmap(int kind, int n) {
    if (kind == MAP_ID) return n;
    if (kind == MAP_WIN) {
        if (n < 256) return n;
        if (n < 512) return 640 + (n - 256);
        if (n < 768) return 960 + (n - 512);
        if (n < 1024) return 1216 + (n - 768);
        if (n < 1280) return 256 + (n - 1024);
        if (n < 1408) return 512 + (n - 1280);
        if (n < 1472) { const int p = n - 1408, i = p >> 1; return (p & 1) ? 896 + 32 + i : 896 + i; }
        return -1;
    }
    { const int hh = n / 192, w = n % 192; if (w < 128) return hh * 192 + w; const int p = w - 128, i = p >> 1; return hh * 192 + 128 + ((p & 1) ? 32 + i : i); }
}
template <bool WTHRU = false>
__device__ __forceinline__ void transpose_item(const float* W, int K, int Nsrc, int Ndst, bf16_t* WT, int mapk, const float* kscale, LAS float* scr, int item, int lane) {
    const int nblk = Ndst / 64, kb = item / nblk, nb = item % nblk, k0 = 64 * kb, n0 = 64 * nb;
    const int srcA = colmap(mapk, n0 + (lane & 31)), srcB = colmap(mapk, n0 + 32 + (lane & 31));
    float tvA[32], tvB[32];
    const int sa = srcA >= 0 ? srcA : 0, sb = srcB >= 0 ? srcB : 0;
#pragma unroll
    for (int i = 0; i < 32; ++i) { const int kk = 2 * i + (lane >> 5); tvA[i] = W[(size_t)(k0 + kk) * Nsrc + sa]; }
#pragma unroll
    for (int i = 0; i < 32; ++i) { const int kk = 2 * i + (lane >> 5); tvB[i] = W[(size_t)(k0 + kk) * Nsrc + sb]; }
    if (kscale) {
#pragma unroll
        for (int i = 0; i < 32; ++i) { const float ks = kscale[k0 + 2 * i + (lane >> 5)]; tvA[i] *= ks; tvB[i] *= ks; } }
    const int c = lane & 7;
#pragma unroll
    for (int h = 0; h < 2; ++h) {
#pragma unroll
        for (int i = 0; i < 32; ++i) { const int kk = 2 * i + (lane >> 5); scr[kk * 33 + (lane & 31)] = h == 0 ? (srcA >= 0 ? tvA[i] : 0.f) : (srcB >= 0 ? tvB[i] : 0.f); }
        LDS_WAIT(); asm volatile("" ::: "memory");
#pragma unroll
        for (int j = 0; j < 4; ++j) { const int n = (lane >> 3) + 8 * j; const LAS float* sp = scr + (8 * c) * 33 + n;
            u32x4 o; o.x = cvt_pk_bf16(sp[0 * 33], sp[1 * 33]); o.y = cvt_pk_bf16(sp[2 * 33], sp[3 * 33]); o.z = cvt_pk_bf16(sp[4 * 33], sp[5 * 33]); o.w = cvt_pk_bf16(sp[6 * 33], sp[7 * 33]);
            bf16_t* dp = WT + (size_t)(n0 + 32 * h + n) * K + k0 + 8 * c;
            if (WTHRU) asm volatile("global_store_dwordx4 %0, %1, off sc0 sc1" :: "v"((GAS u32x4*)dp), "v"(o) : "memory");
            else *(u32x4*)dp = o; }
        LDS_WAIT(); asm volatile("" ::: "memory");
    }
}
__device__ __forceinline__ float silu(float x) { return x / (1.0f + __expf(-x)); }

__device__ __forceinline__ void phase_p0a(const Ctx& F, int part = 0, int widx = 0) {
    LAS float* scr = (LAS float*)(F.lds + F.wave * 16384);
    const int gw = F.vcu * 8 + F.wave, NGW = F.G * 8, lane = F.lane;
    constexpr int I_WIN = (DM / 64) * (INP / 64), I_WUQ = (QRANK / 64) * (QW / 64), I_WKV = (KVRANK / 64) * (KVW / 64), I_WOUT = (DM / 64) * (DM / 64), I_WF1 = (DM / 64) * (DFF / 64), I_WF2 = (DFF / 64) * (DM / 64), I_WP = 1;
    constexpr int PER_L = I_WIN + I_WUQ + 2 * I_WKV + I_WOUT + I_WF1 + I_WF2 + 4 * I_WP;
    constexpr int N_T = DEPTH * PER_L, N_MOD = 96 * 16, N_WS = (DEPTH * 4 * 128 * 128) / 512, N_CK = (DEPTH * NLATB * PAST * KVRANK) / 512, N_ROPE = 16;
    constexpr int NITEMS = N_MOD + N_T + N_WS + N_CK + N_ROPE;
    const bool spread = (F.G == 256);
    volatile LAS unsigned* MISCq = (volatile LAS unsigned*)(F.lds + MISC_OFF);
    if (F.tid == 0) MISCq[40] = 0u;
    __syncthreads();
    constexpr int NB_L = I_WUQ + 2 * I_WKV + I_WOUT + 4 * I_WP, NB_G = I_WUQ + 2 * I_WKV + I_WOUT, NFF = I_WF1 + I_WF2, NFFL = DEFER_FF ? 1 : DEPTH;
    bool first = true;
    for (int it = gw; ; it += NGW) {
        int r;
        if (spread) {
            if (part == 0 && first && F.wave < 6) r = F.vcu * 6 + F.wave;
            else { unsigned j = 0u; if (lane == 0) j = __hip_atomic_fetch_add((LAS unsigned*)(F.lds + MISC_OFF) + 40, 1u, __ATOMIC_RELAXED, __HIP_MEMORY_SCOPE_WORKGROUP);
                   j = (unsigned)__builtin_amdgcn_readfirstlane((int)j);
                   int d = part == 0 ? F.vcu + (int)j * F.G : widx + (int)j * 160; r = -1;
                   if (part == 0) { if (d < DEPTH * I_WIN) r = N_MOD + (d / I_WIN) * PER_L + d % I_WIN; else if (d < DEPTH * I_WIN + N_ROPE) r = NITEMS - N_ROPE + (d - DEPTH * I_WIN); }
                   else { if (d < DEPTH * NB_L) { const int q = d % NB_L; r = N_MOD + (d / NB_L) * PER_L + I_WIN + (q < NB_G ? q : q + NFF); }
                          else if ((d -= DEPTH * NB_L) < NFFL * NFF) r = N_MOD + (d / NFF) * PER_L + I_WIN + NB_G + d % NFF;
                          else if ((d -= NFFL * NFF) < N_WS + N_CK) r = N_MOD + N_T + d; }
                   if (r < 0) break; }
            first = false;
        } else { if (part != 0) break; r = it; if (r >= NITEMS) break; }
        if (r < N_MOD) {
            const int cg = r >> 4, kc = r & 15, n = cg * 256 + lane * 4, l = n / MODW, nn = n % MODW;
            { float cv[NSLOT]; const int k = kc * 64 + lane;
#pragma unroll
              for (int s = 0; s < NSLOT; ++s) cv[s] = (s == 0) ? GIN(5)[k] : GIN(4)[(size_t)(s - 1) * DM + k];
#pragma unroll
              for (int s = 0; s < NSLOT; ++s) scr[s * 64 + lane] = silu(cv[s]); }
            LDS_WAIT(); asm volatile("" ::: "memory");
            f32x4 a[NSLOT];
#pragma unroll
            for (int s = 0; s < NSLOT; ++s) a[s] = (f32x4){0.f, 0.f, 0.f, 0.f};
            const float* wp = GIN(6) + ((size_t)l * DM + kc * 64) * MODW + nn;
#pragma unroll 32
            for (int kk = 0; kk < 64; ++kk) { const f32x4 w = *(const f32x4*)(wp + (size_t)kk * MODW);
#pragma unroll
                for (int s = 0; s < NSLOT; ++s) a[s] += w * scr[s * 64 + kk]; }
            float* mp = wsp<float>(F, WS_MODP);
#pragma unroll
            for (int s = 0; s < NSLOT; ++s) *(f32x4*)(mp + ((size_t)(kc * NSLOT + s)) * (DEPTH * MODW) + n) = a[s];
            LDS_WAIT(); asm volatile("" ::: "memory");
            continue;
        }
        r -= N_MOD;
        if (r < N_T) {
            const int l = r / PER_L; int q = r % PER_L;
            if (q < I_WIN) { transpose_item(GIN(9) + (size_t)l * DM * INW, DM, INW, INP, wsp<bf16_t>(F, WS_WIN) + (size_t)l * INP * DM, MAP_WIN, nullptr, scr, q, lane); continue; } q -= I_WIN;
            if (q < I_WUQ) { transpose_item(GIN(13) + (size_t)l * QRANK * QW, QRANK, QW, QW, wsp<bf16_t>(F, WS_WUQ) + (size_t)l * QW * QRANK, MAP_WUQ, GIN(12) + (size_t)l * QRANK, scr, q, lane); continue; } q -= I_WUQ;
            if (q < I_WKV) { transpose_item(GIN(15) + (size_t)l * KVRANK * KVW, KVRANK, KVW, KVW, wsp<bf16_t>(F, WS_WKVF) + (size_t)l * KVW * KVRANK, MAP_ID, GIN(14) + (size_t)l * KVRANK, scr, q, lane); continue; } q -= I_WKV;
            if (q < I_WKV) { transpose_item(GIN(15) + (size_t)l * KVRANK * KVW, KVRANK, KVW, KVW, wsp<bf16_t>(F, WS_WKVC) + (size_t)l * KVW * KVRANK, MAP_ID, nullptr, scr, q, lane); continue; } q -= I_WKV;
            if (q < I_WOUT) { transpose_item(GIN(19) + (size_t)l * DM * DM, DM, DM, DM, wsp<bf16_t>(F, WS_WOUT) + (size_t)l * DM * DM, MAP_ID, nullptr, scr, q, lane); continue; } q -= I_WOUT;
            if (DEFER_FF && spread && l >= 1 && q < I_WF1 + I_WF2) continue;
            if (q < I_WF1) { transpose_item(GIN(21) + (size_t)l * DM * DFF, DM, DFF, DFF, wsp<bf16_t>(F, WS_WF1) + (size_t)l * DFF * DM, MAP_ID, nullptr, scr, q, lane); continue; } q -= I_WF1;
            if (q < I_WF2) { transpose_item(GIN(22) + (size_t)l * DFF * DM, DFF, DM, DM, wsp<bf16_t>(F, WS_WF2) + (size_t)l * DM * DFF, MAP_ID, nullptr, scr, q, lane); continue; } q -= I_WF2;
            { const int g = q / I_WP, it2 = q % I_WP; transpose_item(GIN(10) + ((size_t)l * 4 + g) * 4096, 64, 64, 64, wsp<bf16_t>(F, WS_WPT) + ((size_t)l * 4 + g) * 4096, MAP_ID, nullptr, scr, it2, lane); continue; }
        }
        r -= N_T;
        if (r < N_WS) {
            const float* src = GIN(17) + (size_t)r * 512 + lane * 8; const f32x4 a = *(const f32x4*)src, b = *(const f32x4*)(src + 4);
            *(u32x4*)(wsp<bf16_t>(F, WS_WSB) + (size_t)r * 512 + lane * 8) = pack8(a, b); continue;
        }
        r -= N_WS;
        if (r < N_CK) {
            const size_t e = (size_t)r * 512 + lane * 8; const int c = (int)(e % 256), j = (int)((e / 256) % 256), l = (int)((e / 65536) % 4), b = (int)(e / 262144);
            const float* src = GIN(2) + e; const f32x4 a = *(const f32x4*)src, bb = *(const f32x4*)(src + 4);
            *(u32x4*)(wsp<bf16_t>(F, WS_CCKV) + ((size_t)(l * NLATB + b) * PAST + j) * KVRANK + c) = pack8(a, bb); continue;
        }
        r -= N_CK;
        { const int id = r * 64 + lane, pos = id >> 4, j = id & 15;
          const double inv = (double)__builtin_amdgcn_exp2f(-(float)j * (13.287712379549449f / 16.0f));
          const double ang = (double)pos * inv, rev = ang * 0.15915494309189535;
          const float fr_ = (float)(rev - (double)(long long)rev);
          wsp<f32x2>(F, WS_ROPE)[id] = (f32x2){__builtin_amdgcn_cosf(fr_), __builtin_amdgcn_sinf(fr_)}; }
    }
}
__device__ __forceinline__ void ff_convert(const Ctx& F, int l) {
    constexpr int I_WF1 = (DM / 64) * (DFF / 64), I_WF2 = (DFF / 64) * (DM / 64);
    const int li = F.vcu & 31, x = F.vcu >> 5; if (li < 12) return;
    asm volatile("s_waitcnt vmcnt(0)" ::: "memory"); __syncthreads();
    LAS float* scr = (LAS float*)(F.lds + F.wave * 16384);
    const int gw = (x * 20 + (li - 12)) * 8 + F.wave, NGW = 160 * 8, lane = F.lane;
    for (int it = gw; it < I_WF1 + I_WF2; it += NGW) {
        if (it < I_WF1) transpose_item<true>(GIN(21) + (size_t)l * DM * DFF, DM, DFF, DFF, wsp<bf16_t>(F, WS_WF1) + (size_t)l * DFF * DM, MAP_ID, nullptr, scr, it, lane);
        else transpose_item<true>(GIN(22) + (size_t)l * DFF * DM, DFF, DM, DM, wsp<bf16_t>(F, WS_WF2) + (size_t)l * DM * DFF, MAP_ID, nullptr, scr, it - I_WF1, lane);
    }
}
__device__ __forceinline__ void phase_p0b(const Ctx& F) {
    const int gt = F.vcu * 512 + F.tid, NT = F.G * 512;
    const float* mp = wsp<const float>(F, WS_MODP);
    for (int id = gt; id < DEPTH * NSLOT * MODW; id += NT) {
        const int nn = id % MODW, s = (id / MODW) % NSLOT, l = id / (MODW * NSLOT);
        float v = GIN(7)[(size_t)l * MODW + nn];
#pragma unroll
        for (int kc = 0; kc < 16; ++kc) v += mp[((size_t)(kc * NSLOT + s)) * (DEPTH * MODW) + (size_t)l * MODW + nn];
        const int part = nn >> 10, k = nn & 1023; const size_t o = ((size_t)l * NSLOT + s) * DM + k;
        if (part == 0) wsp<float>(F, WS_SH1)[o] = v;
        else if (part == 1) wsp<float>(F, WS_GM1)[o] = GIN(8)[(size_t)l * DM + k] * (1.0f + v);
        else if (part == 2) wsp<float>(F, WS_G1)[o] = v;
        else if (part == 3) wsp<float>(F, WS_SH2)[o] = v;
        else if (part == 4) wsp<float>(F, WS_GM2)[o] = GIN(20)[(size_t)l * DM + k] * (1.0f + v);
        else wsp<float>(F, WS_G2)[o] = v;
    }
}
template <bool WTHRU>
__device__ __forceinline__ void shw_item(const float* SH, const GAS bf16_t* WT, float* out, int ldo, int n0, int lane) {
    const int r16 = lane & 15, kg = lane >> 4; const bool live = r16 < NSLOT;
    f32x4 acc = (f32x4){0.f, 0.f, 0.f, 0.f};
    const GAS bf16_t* bp = WT + (size_t)(n0 + r16) * DM + kg * 8;
    const float* ap = SH + (size_t)(live ? r16 : 0) * DM + kg * 8;
    for (int k0 = 0; k0 < DM; k0 += 256) {
        u32x4 b[8]; f32x4 a0[8], a1[8];
#pragma unroll
        for (int j = 0; j < 8; ++j) { b[j] = *(const GAS u32x4*)(bp + k0 + 32 * j); a0[j] = *(const f32x4*)(ap + k0 + 32 * j); a1[j] = *(const f32x4*)(ap + k0 + 32 * j + 4); }
#pragma unroll
        for (int j = 0; j < 8; ++j) {
            u32x4 hi, lo;
            hi.x = cvt_pk_bf16(a0[j][0], a0[j][1]); hi.y = cvt_pk_bf16(a0[j][2], a0[j][3]); hi.z = cvt_pk_bf16(a1[j][0], a1[j][1]); hi.w = cvt_pk_bf16(a1[j][2], a1[j][3]);
            lo.x = cvt_pk_bf16(a0[j][0] - bf_lo(hi.x), a0[j][1] - bf_hi(hi.x)); lo.y = cvt_pk_bf16(a0[j][2] - bf_lo(hi.y), a0[j][3] - bf_hi(hi.y));
            lo.z = cvt_pk_bf16(a1[j][0] - bf_lo(hi.z), a1[j][1] - bf_hi(hi.z)); lo.w = cvt_pk_bf16(a1[j][2] - bf_lo(hi.w), a1[j][3] - bf_hi(hi.w));
            if (!live) { hi = (u32x4){0u, 0u, 0u, 0u}; lo = hi; }
            const bf16x8 bv = __builtin_bit_cast(bf16x8, b[j]);
            acc = __builtin_amdgcn_mfma_f32_16x16x32_bf16(__builtin_bit_cast(bf16x8, hi), bv, acc, 0, 0, 0);
            acc = __builtin_amdgcn_mfma_f32_16x16x32_bf16(__builtin_bit_cast(bf16x8, lo), bv, acc, 0, 0, 0);
        }
    }
#pragma unroll
    for (int r = 0; r < 4; ++r) { const int sr = 4 * kg + r;
        if (sr < NSLOT) { float* o = out + (size_t)sr * ldo + n0 + r16;
            if (WTHRU) __hip_atomic_store(o, acc[r], __ATOMIC_RELAXED, __HIP_MEMORY_SCOPE_AGENT); else *o = acc[r]; } }
}
__device__ __forceinline__ void shw2_deferred(const Ctx& F, int l) {
    const int li = F.vcu & 31, x = F.vcu >> 5; if (li < 4 || li >= 16) return;
    const int item = (x * 12 + (li - 4)) * 8 + F.wave;
    if (item < DFF / 16) shw_item<true>(wsp<const float>(F, WS_SH2) + (size_t)l * NSLOT * DM, wsp<const bf16_t>(F, WS_WF1) + (size_t)l * DFF * DM, wsp<float>(F, WS_SHW2) + (size_t)l * NSLOT * DFF, DFF, item * 16, F.lane);
}
__device__ __forceinline__ const float* xrow_in(const Ctx& F, int row) { return row < NCTX ? GIN(0) + (size_t)row * DM : GIN(1) + (size_t)(row - NCTX) * DM; }
__device__ __forceinline__ void phase_p0c(const Ctx& F) {
    const int lane = F.lane, wid = F.wave, tid = F.tid;
    {
        constexpr int I1 = INP / 16, I2 = DFF / 16;
        const bool defer = F.G == 256;
        const int n2 = defer ? 0 : DEPTH, total = DEPTH * I1 + n2 * I2;
        for (int it = F.vcu * 8 + wid; it < total; it += F.G * 8) {
            if (it < DEPTH * I1) { const int l = it / I1, c = it % I1;
                shw_item<false>(wsp<const float>(F, WS_SH1) + (size_t)l * NSLOT * DM, wsp<const bf16_t>(F, WS_WIN) + (size_t)l * INP * DM, wsp<float>(F, WS_SHW1) + (size_t)l * NSLOT * INP, INP, c * 16, lane); }
            else { const int q = it - DEPTH * I1, l = q / I2, c = q % I2;
                shw_item<false>(wsp<const float>(F, WS_SH2) + (size_t)l * NSLOT * DM, wsp<const bf16_t>(F, WS_WF1) + (size_t)l * DFF * DM, wsp<float>(F, WS_SHW2) + (size_t)l * NSLOT * DFF, DFF, c * 16, lane); }
        }
    }
    {
        const int gw = F.vcu * 8 + wid, NGW = F.G * 8;
        const float* GM = wsp<const float>(F, WS_GM1);
        bf16_t* XG = wsp<bf16_t>(F, WS_XG); float* ST1 = wsp<float>(F, WS_ST1);
        constexpr int RB = 5;
        for (int row0 = gw; row0 < MROWS; row0 += NGW * RB) {
            f32x4 v[RB][4];
#pragma unroll
            for (int i = 0; i < RB; ++i) { const int row = row0 + i * NGW; const f32x4* xr = (const f32x4*)xrow_in(F, row < MROWS ? row : row0) + lane;
#pragma unroll
                for (int j = 0; j < 4; ++j) v[i][j] = xr[64 * j]; }
#pragma unroll
            for (int i = 0; i < RB; ++i) { const int row = row0 + i * NGW;
                if (row < MROWS) {
                    const int s = slot_of_tile(row >> 8); const f32x4* gr = (const f32x4*)(GM + (size_t)s * DM) + lane;
                    float q = 0.f;
#pragma unroll
                    for (int j = 0; j < 4; ++j) { const f32x4 vv = v[i][j], g = gr[64 * j]; q += (vv[0] * vv[0] + vv[1] * vv[1]) + (vv[2] * vv[2] + vv[3] * vv[3]); const f32x4 y = vv * g;
                        u32x2 o; o.x = cvt_pk_bf16(y[0], y[1]); o.y = cvt_pk_bf16(y[2], y[3]); *(u32x2*)(XG + (size_t)row * DM + (64 * j + lane) * 4) = o; }
                    q = wave_sum(q);
                    if (lane < 16) ST1[(size_t)row * 16 + lane] = (lane == 0) ? q : 0.f;
                } }
        }
    }
}
__device__ __forceinline__ void final_tile(const Ctx& F, int pm, int pn) {
    asm volatile("s_waitcnt vmcnt(0)" ::: "memory");
    __syncthreads();
    if (F.tid == 0) {
        unsigned* bar = (unsigned*)((gu32*)(F.ws + WS_CTL) + CW_BAR); unsigned* cw = (unsigned*)((gu32*)(F.ws + WS_CTL) + CW_FIN + 32 * pm);
        __builtin_amdgcn_fence(__ATOMIC_RELEASE, "agent");
        asm volatile("s_waitcnt vmcnt(0)" ::: "memory");
        xb_add(cw, 1u);
        XB_SPIN(xb_ld(cw) < 4u, bar);
        __builtin_amdgcn_fence(__ATOMIC_ACQUIRE, "agent");
        asm volatile("s_waitcnt vmcnt(0)" ::: "memory");
    }
    __syncthreads();
    __builtin_amdgcn_fence(__ATOMIC_ACQUIRE, "workgroup");
    LAS float* S = (LAS float*)(F.lds + RING_BYTES + 2048);
    int t_ = F.tid; asm volatile("" : "+v"(t_));
    if (t_ == 0) *(volatile LAS int*)(S + 256) = 0;
    if (t_ < 256) { const GAS f32x4* sp = (const GAS f32x4*)(wsp<const float>(F, WS_ST1) + (size_t)(pm * 256 + t_) * 16);
        S[t_] = fast_rsqrt(((sum4(sp[0]) + sum4(sp[1])) + (sum4(sp[2]) + sum4(sp[3]))) * (1.0f / DM) + EPS); }
    __syncthreads();
    const int c16 = t_ & 31, r0 = t_ >> 5;
    const GAS float* gf = GIN(23) + pn * 256 + c16 * 8; const f32x4 g0 = *(const GAS f32x4*)gf, g1 = *(const GAS f32x4*)(gf + 4);
    const GAS bf16_t* xb = wsp<const bf16_t>(F, WS_XB) + (size_t)(pm * 256 + r0) * DM + pn * 256 + c16 * 8;
    GAS float* y = F.out + OUT_X + (size_t)(pm * 256 + r0) * DM + pn * 256 + c16 * 8;
    u32x4 b[16];
#pragma unroll
    for (int p = 0; p < 16; ++p) b[p] = *(const GAS u32x4*)(xb + (size_t)p * 16 * DM);
#pragma unroll
    for (int p = 0; p < 16; ++p) { const float rs = S[p * 16 + r0]; GAS float* yr = y + (size_t)p * 16 * DM; const u32x4 v = b[p];
        *(GAS f32x4*)yr = (f32x4){bf_lo(v.x), bf_hi(v.x), bf_lo(v.y), bf_hi(v.y)} * rs * g0; *(GAS f32x4*)(yr + 4) = (f32x4){bf_lo(v.z), bf_hi(v.z), bf_lo(v.w), bf_hi(v.w)} * rs * g1; }
}
__device__ __forceinline__ void phase_final(const Ctx& F) {
    const int gw = F.vcu * 8 + F.wave, NGW = F.G * 8, lane = F.lane;
    const float* ST1 = wsp<const float>(F, WS_ST1); const f32x4* gf = (const f32x4*)GIN(23) + lane;
    const GAS bf16_t* XB = wsp<const bf16_t>(F, WS_XB);
    for (int row = gw; row < MROWS; row += NGW) {
        const f32x4* sp = (const f32x4*)(ST1 + (size_t)row * 16);
        const float rs = fast_rsqrt(((sum4(sp[0]) + sum4(sp[1])) + (sum4(sp[2]) + sum4(sp[3]))) * (1.0f / DM) + EPS);
        const GAS u32x2* xr = (const GAS u32x2*)(XB + (size_t)row * DM) + lane;
        f32x4* yr = (f32x4*)(F.out + OUT_X + (size_t)row * DM) + lane;
#pragma unroll
        for (int j = 0; j < 4; ++j) { const u32x2 b = xr[64 * j]; const f32x4 v = (f32x4){bf_lo(b.x), bf_hi(b.x), bf_lo(b.y), bf_hi(b.y)}; yr[64 * j] = v * rs * gf[64 * j]; }
    }
}

#ifdef DIS_ATTN
#define ATTN_CALL(...) do {} while (0)
#else
#define ATTN_CALL(...) attn_unit(__VA_ARGS__)
#endif
#ifdef DIS_POOL
#define POOL_CALL(...) do {} while (0)
#else
#define POOL_CALL(...) pool_unit(__VA_ARGS__)
#endif
#ifdef DIS_GMLP
#define GMLP_CALL(...) do {} while (0)
#else
#define GMLP_CALL(...) gmlp_unit(__VA_ARGS__)
#endif
__device__ __forceinline__ void mix_fix(const Ctx& F, int l, int L, bool dry) {
    if (dry) return;
    const float* STKV = wsp<const float>(F, WS_STKV); const float* gkv = GIN(14) + (size_t)l * KVRANK;
    float* o = F.out + OUT_CKV + ((size_t)(L * DEPTH + l) * LCTX) * KVRANK;
    int tid0_ = threadIdx.x; asm volatile("" : "+v"(tid0_));
    const int c4 = (tid0_ & 63) * 4; const f32x4 g = *(const f32x4*)(gkv + c4);
    for (int t0 = tid0_ >> 6; t0 < LCTX; t0 += 64) {
        f32x4 st[8], v[8];
#pragma unroll
        for (int k = 0; k < 8; ++k) { const int t = t0 + 8 * k; st[k] = *(const f32x4*)(STKV + (size_t)(L * LCTX + t) * 4); v[k] = *(const f32x4*)(o + (size_t)t * KVRANK + c4); }
#pragma unroll
        for (int k = 0; k < 8; ++k) { const int t = t0 + 8 * k; const float rs = fast_rsqrt(sum4(st[k]) * (1.0f / KVRANK) + EPS); *(f32x4*)(o + (size_t)t * KVRANK + c4) = v[k] * rs * g; }
    }
}
__device__ __forceinline__ void mix_attn_ctx(const Ctx& F, int b, int h) {
    const GAS bf16_t* Q = wsp<const bf16_t>(F, Q_C); GAS bf16_t* Y = wsp<bf16_t>(F, YCAT_C);
    const int L = b * 4 + h; const size_t row0 = (size_t)b * LCTX;
    ATTN_CALL(F.lds, Q + row0 * QW + h * 192, wsp<const bf16_t>(F, WS_KC) + (size_t)L * LCTX * 192, wsp<const bf16_t>(F, WS_VC) + (size_t)L * LCTX * 128, Y + row0 * DM + 256 + h * 128, LCTX);
}
__device__ __forceinline__ void mix_ctx(const Ctx& F, int l, bool dry) {
    if (F.G == 256) { const int x = F.vcu >> 5, li = F.vcu & 31;
        if (li >= 16 && li < 24) { const int m = li - 16; mix_attn_ctx(F, 2 * x + (m >> 2), m & 3); }
        else if (li >= 24 && li < 28) { const int m = li - 24; POOL_CALL(F, l, 2 * x, m, m + 1); GMLP_CALL(F, l, 4 * x + m); }
        else if (li >= 28) { const int m = li - 28; POOL_CALL(F, l, 2 * x + 1, m, m + 1); if (m < 2) mix_fix(F, l, 2 * x + m, dry); }
    } else for (int j = F.vcu; j < 128; j += F.G) { const int x = j >> 4, m = j & 15;
        if (m < 2) POOL_CALL(F, l, 2 * x + m, 0, 4); else if (m < 10) mix_attn_ctx(F, 2 * x + ((m - 2) >> 2), (m - 2) & 3); else if (m < 14) GMLP_CALL(F, l, 4 * x + (m - 10)); else mix_fix(F, l, 2 * x + (m - 14), dry); }
}
__device__ __forceinline__ void mix_lat_attn(const Ctx& F) {
    const GAS bf16_t* Q = wsp<const bf16_t>(F, Q_L); GAS bf16_t* Y = wsp<bf16_t>(F, YCAT_L);
    for (int L = F.vcu; L < 256; L += F.G) {
        const int bh = L >> 3, qb = L & 7, b = bh >> 2, h = bh & 3; const size_t row0 = (size_t)NCTX + (size_t)b * LLAT + qb * 256;
        ATTN_CALL(F.lds, Q + row0 * QW + h * 192, wsp<const bf16_t>(F, WS_KL) + (size_t)bh * LKEY * 192, wsp<const bf16_t>(F, WS_VL) + (size_t)bh * LKEY * 128, Y + row0 * DM + 256 + h * 128, LKEY);
    }
}
__device__ __forceinline__ void mix_lat_small(const Ctx& F, int l) {
    if (F.G == 256) { const int x = F.vcu >> 5, li = F.vcu & 31;
        if (li >= 8 && li < 24) { const int m = li - 8; POOL_CALL(F, l, 16 + 8 * x + (m >> 1), 2 * (m & 1), 2 * (m & 1) + 2); }
        else if (li >= 24) { const int m = li - 24; GMLP_CALL(F, l, 32 + 16 * x + 2 * m); GMLP_CALL(F, l, 32 + 16 * x + 2 * m + 1); } }
    else for (int j = F.vcu; j < 192; j += F.G) { if (j < 64) POOL_CALL(F, l, 16 + j, 0, 4); else GMLP_CALL(F, l, 32 + (j - 64)); }
}

#ifdef DIS_GEMM
#define GEMM_CALL(a, b, c) do { (void)(b); (void)(c); } while (0)
#else
#define GEMM_CALL(a, b, c) gemm_phase(a, b, c)
#endif
constexpr int SL_P0A = 0, SL_P0B = 1, SL_P0C = 2, SL_PRE = 3, SL_L0 = 4, SL_PER_L = 6, SL_FINAL = SL_L0 + DEPTH * SL_PER_L, N_PHASES = SL_FINAL + 1;

__global__ void __launch_bounds__(512, 2) mega_fwd(const Args args) {
    extern __shared__ __attribute__((aligned(16))) unsigned char lds_raw[];
    Ctx F;
    F.a = &args; F.out = (GAS float*)args.out; F.ws = (GAS unsigned char*)args.ws; F.lds = (LAS unsigned char*)lds_raw;
    F.tid = threadIdx.x; F.lane = F.tid & 63; F.wave = __builtin_amdgcn_readfirstlane(F.tid >> 6);
    F.G = gridDim.x; { const int bx = blockIdx.x; F.vcu = (F.G % 8 == 0) ? (bx % 8) * (F.G / 8) + bx / 8 : bx; }
    volatile LAS unsigned* MISC = (volatile LAS unsigned*)(F.lds + MISC_OFF);
    for (int u = F.tid; u < (LDS_BYTES - RING_BYTES) / 4; u += 512) ((LAS unsigned*)(F.lds + RING_BYTES))[u] = 0u;
    __syncthreads();
    gu32* ctl = (gu32*)(F.ws + WS_CTL);
    XcdBarrier bar; bar.bar = (unsigned*)(ctl + CW_BAR); bar.x = 0; bar.st = nullptr;
#if !MK_PER_PHASE
    bar = xcd_barrier_post((unsigned*)(ctl + CW_BAR), MISC + 8);
    if (threadIdx.x == 0) __hip_atomic_store(ctl + CW_XCC + F.vcu, xb_xcc_id() + 1u, RLX_AGENT);
#endif
    const int lo = args.ph_lo, hi = (FUSE_FINAL && F.G == 256 && args.ph_hi == N_PHASES) ? (int)SL_FINAL : args.ph_hi;
    for (int ph = lo; ph < hi; ++ph) {
      int reps = 1;
      if (PROBE_PHASE >= 0) { const int key = ph == SL_P0A ? 10 : ph == SL_P0B ? 11 : ph == SL_P0C ? 12 : ph == SL_FINAL ? 13 : ph == SL_PRE ? 9 : (ph - SL_L0) % SL_PER_L; if (key == PROBE_PHASE) reps += PROBE_REP; }
      for (int rep = 0; rep < reps; ++rep) {
        const bool dry = rep > 0;
        if (PROBE_PHASE == 13 && dry) break;
#if PROBE_FLUSH && !MK_PER_PHASE
        if (dry) {
            GAS u32x4* z = (GAS u32x4*)(F.ws + WS_OVL); const size_t n16 = (size_t)180 * 1024 * 1024 / 16;
            for (size_t i = (size_t)F.vcu * 512 + threadIdx.x; i < n16; i += (size_t)F.G * 512) z[i] = (u32x4){0u, 0u, 0u, 0u};
            GAS u32x4* z2 = (GAS u32x4*)(F.out); const size_t m16 = (size_t)100 * 1024 * 1024 / 16;
            for (size_t i = (size_t)F.vcu * 512 + threadIdx.x; i < m16; i += (size_t)F.G * 512) z2[i] = (u32x4){0u, 0u, 0u, 0u};
            xcd_barrier(bar);
        }
#endif
        { int t_ = threadIdx.x; asm volatile("" : "+v"(t_)); F.tid = t_; F.lane = t_ & 63; F.wave = __builtin_amdgcn_readfirstlane(t_ >> 6);
          unsigned char* w_ = args.ws; asm volatile("" : "+s"(w_)); F.ws = (GAS unsigned char*)w_; float* o_ = args.out; asm volatile("" : "+s"(o_)); F.out = (GAS float*)o_; }
#ifndef DIS_P0
        if (ph == SL_P0A) phase_p0a(F);
        else if (ph == SL_P0B) { phase_p0b(F);
            { int t_ = threadIdx.x; asm volatile("" : "+v"(t_)); const GAS u32x4* src = (const GAS u32x4*)(F.ws + WS_ROPE); LAS u32x4* dl = (LAS u32x4*)(F.lds + RING_BYTES + 4096); dl[t_] = src[t_]; } }
        else if (ph == SL_P0C) phase_p0c(F);
        else if (ph == SL_FINAL) phase_final(F);
#else
        if (ph < SL_PRE || ph == SL_FINAL) {}
#endif
        else {
            Epi E; E.ws = F.ws; E.out = F.out; E.xp = GIN(0); E.xs = GIN(1); E.dry = dry;
            const int l = ph == SL_PRE ? 0 : (ph - SL_L0) / SL_PER_L, sub = ph == SL_PRE ? -1 : (ph - SL_L0) % SL_PER_L;
            if (sub == 1) {
                const GAS float* ck = GIN(3); GAS bf16_t* KL = wsp<bf16_t>(F, WS_KL);
                const bool loc = (F.G == 256);
                for (int id0 = loc ? (F.vcu & 31) * 512 + F.tid : F.vcu * 512 + F.tid; id0 < (loc ? PAST * 8 : NLATB * PAST * 8); id0 += (loc ? 32 : F.G) * 512) {
                    const int id = loc ? ((F.vcu >> 5) << 11) + id0 : id0;
                    const int ch = id & 7, j = (id >> 3) & 255, b = id >> 11, i0 = ch * 4;
                    const GAS float* src = ck + ((size_t)(b * DEPTH + l) * PAST + j) * 64;
                    const f32x4 a = *(const GAS f32x4*)(src + i0), c = *(const GAS f32x4*)(src + 32 + i0);
                    u32x4 w; w.x = cvt_pk_bf16(a[0], c[0]); w.y = cvt_pk_bf16(a[1], c[1]); w.z = cvt_pk_bf16(a[2], c[2]); w.w = cvt_pk_bf16(a[3], c[3]);
                    GAS bf16_t* kd = KL + ((size_t)(b * NH) * LKEY + j) * 192 + 128 + ch * 8;
#pragma unroll
                    for (int h = 0; h < NH; ++h) *(GAS u32x4*)(kd + (size_t)h * LKEY * 192) = w;
                }
            }
            if (sub == 2) { mix_lat_attn(F); if (PROBE_PHASE == 21) for (int r2 = 0; r2 < PROBE_REP; ++r2) mix_lat_attn(F); }
            { SchedSlot S; S.ws = F.ws; S.c = F.vcu; S.G = F.G; S.sub = sub; S.l = l; GEMM_CALL(F.lds, S, E); }
            if (DEFER_FF && sub == 5 && F.G == 256 && l + 1 < DEPTH && !dry) ff_convert(F, l + 1);
            if (FUSE_FINAL && F.G == 256 && l == DEPTH - 1 && sub >= 4 && !dry) {
                SchedSlot S; S.ws = F.ws; S.c = F.vcu; S.G = F.G; S.sub = sub; S.l = l; GUnit u0;
                if (S.next(0, u0) && u0.kind == K_FF2) final_tile(F, u0.pm, u0.pn);
            }
            if (sub == -1 && F.G == 256 && !dry && (F.vcu & 31) >= 12) { asm volatile("s_waitcnt vmcnt(0)" ::: "memory"); __syncthreads(); phase_p0a(F, 1, (F.vcu >> 5) * 20 + (F.vcu & 31) - 12); }
            if (sub == 1) mix_ctx(F, l, dry);
            if (sub == 1 && F.G == 256 && !dry) shw2_deferred(F, l);
            if (sub == 2) mix_lat_small(F, l);
        }
#if !MK_PER_PHASE
        if (threadIdx.x == 0) MISC[11] = (LOCAL_BAR && MISC[20] != 0u && ph >= SL_L0 && ph < SL_FINAL && (ph - SL_L0) % SL_PER_L <= 1) ? 1u : 0u;
        if (threadIdx.x == 0) MISC[10] = (MISC[20] != 0u && ph >= SL_L0 && ph + 1 < SL_FINAL) ? 1u : 0u;
        if (ph + 1 < hi || rep + 1 < reps) xcd_barrier(bar);
        if (ph == SL_P0A && rep == 0) {
            int bad = 0; int tq_ = threadIdx.x; asm volatile("" : "+v"(tq_));
            if (F.G != 256) bad = 1;
            else if (tq_ < 256) { gu32* cc = (gu32*)(F.ws + WS_CTL); const unsigned v = __hip_atomic_load(cc + CW_XCC + tq_, RLX_AGENT), h = __hip_atomic_load(cc + CW_XCC + (tq_ & ~31), RLX_AGENT); bad = (v == 0u || v != h); }
            const bool wbad = __ballot(bad) != 0ull;
            if ((tq_ & 63) == 0) MISC[24 + (tq_ >> 6)] = wbad ? 1u : 0u;
            __syncthreads();
            if (tq_ == 0) { unsigned a = 0u;
#pragma unroll
                for (int w8 = 0; w8 < 8; ++w8) a |= MISC[24 + w8];
                MISC[20] = a ? 0u : 1u; }
            __syncthreads();
        }
        if (PROBE_PHASE == 20 && ph >= SL_L0 && ph < SL_FINAL) { for (int r2 = 0; r2 < PROBE_REP; ++r2) xcd_barrier(bar); }
#endif
      }
    }
}

extern "C" void kernel_launch(void* const* d_in, const int* in_sizes, int n_in, void* d_out, int out_size, void* d_ws, size_t ws_size, hipStream_t stream) {
    static int grid = 0;
    if (grid == 0) {
        if (n_in != 24 || out_size != (int)OUT_END || ws_size < WS_END) { fprintf(stderr, "kernel_launch: unexpected shapes: n_in %d out %d ws %zu (need %zu)\n", n_in, out_size, ws_size, (size_t)WS_END); grid = -1; return; }
        int dev = 0, cus = 0, per_cu = 0;
        if (hipGetDevice(&dev) != hipSuccess || hipDeviceGetAttribute(&cus, hipDeviceAttributeMultiprocessorCount, dev) != hipSuccess) { grid = -1; return; }
        if (hipFuncSetAttribute((const void*)mega_fwd, hipFuncAttributeMaxDynamicSharedMemorySize, LDS_BYTES) != hipSuccess) { fprintf(stderr, "kernel_launch: hipFuncSetAttribute failed\n"); grid = -1; return; }
        if (hipOccupancyMaxActiveBlocksPerMultiprocessor(&per_cu, (const void*)mega_fwd, 512, LDS_BYTES) != hipSuccess || per_cu < 1) { fprintf(stderr, "kernel_launch: occupancy query says %d\n", per_cu); per_cu = 1; }
        (void)hipGetLastError();
        grid = cus;
    }
    if (grid < 0) return;
    (void)hipMemsetAsync((char*)d_ws + WS_CTL, 0, CTL_ZERO_BYTES, stream);
    Args a{};
    for (int i = 0; i < 24; ++i) a.in[i] = (const float*)d_in[i];
    a.out = (float*)d_out; a.ws = (unsigned char*)d_ws;
#if MK_PER_PHASE
    for (int ph = 0; ph < N_PHASES; ++ph) { a.ph_lo = ph; a.ph_hi = ph + 1; hipLaunchKernelGGL(mega_fwd, dim3(grid), dim3(512), LDS_BYTES, stream, a); }
#else
    a.ph_lo = 0; a.ph_hi = N_PHASES; hipLaunchKernelGGL(mega_fwd, dim3(grid), dim3(512), LDS_BYTES, stream, a);
#endif
    const hipError_t le = hipPeekAtLastError();
    if (le != hipSuccess) fprintf(stderr, "kernel_launch: launch failed: %s\n", hipGetErrorName(le));
}
```

```cpp
#include <hip/hip_runtime.h>
#include <cstdio>
#include <cstdint>

#define LAS __attribute__((address_space(3)))
#if defined(__HIP_DEVICE_COMPILE__)
#define GAS __attribute__((address_space(1)))
#else
#define GAS
#endif
typedef unsigned short bf16_t;
typedef short bf16x8 __attribute__((ext_vector_type(8)));
typedef short s16x4 __attribute__((ext_vector_type(4)));
typedef float f32x2 __attribute__((ext_vector_type(2)));
typedef float f32x4 __attribute__((ext_vector_type(4)));
typedef float f32x16 __attribute__((ext_vector_type(16)));
typedef unsigned u32x4 __attribute__((ext_vector_type(4)));
typedef unsigned u32x2 __attribute__((ext_vector_type(2)));
typedef GAS unsigned gu32;

#ifndef PROBE_PHASE
#define PROBE_PHASE -1
#endif
#ifndef PROBE_REP
#define PROBE_REP 0
#endif
#ifndef PROBE_FLUSH
#define PROBE_FLUSH 0
#endif
#ifndef MK_PER_PHASE
#define MK_PER_PHASE 0
#endif
#define FUSE_FINAL (!MK_PER_PHASE)
#ifndef LOCAL_BAR
#define LOCAL_BAR 1
#endif
#ifndef DEFER_FF
#define DEFER_FF 1
#endif

constexpr int DM = 1024, DEPTH = 4, NCTXB = 16, LCTX = 256, NLATB = 8, LLAT = 2048, PAST = 256;
constexpr int NCTX = NCTXB * LCTX  , NLAT = NLATB * LLAT  , MROWS = NCTX + NLAT  ;
constexpr int NSLOT = 9, MODW = 6 * DM;
constexpr int INW = 1472, INP = 1536, QRANK = 384, KVRANK = 256, QW = 768, KVW = 1024, DFF = 4096, NH = 4;
constexpr int LKEY = PAST + LLAT  ;
constexpr float EPS = 1e-6f;
constexpr float C2 = 0.07216878364870322f * 1.4426950408889634f;
constexpr int NTM = MROWS / 256;

constexpr size_t OUT_X = 0, OUT_CKV = (size_t)MROWS * DM, OUT_KR = OUT_CKV + (size_t)NCTXB * DEPTH * LCTX * KVRANK, OUT_END = OUT_KR + (size_t)NCTXB * DEPTH * LCTX * 64;

constexpr size_t al256(size_t x) { return (x + 255) / 256 * 256; }
constexpr size_t WS_CTL = 0, CTL_ZERO_BYTES = 1u << 20;
constexpr size_t WS_MODP = CTL_ZERO_BYTES;
constexpr size_t WS_SH1 = WS_MODP + al256((size_t)16 * NSLOT * DEPTH * MODW * 4);
constexpr size_t MODV = al256((size_t)DEPTH * NSLOT * DM * 4);
constexpr size_t WS_GM1 = WS_SH1 + MODV, WS_G1 = WS_GM1 + MODV, WS_SH2 = WS_G1 + MODV, WS_GM2 = WS_SH2 + MODV, WS_G2 = WS_GM2 + MODV;
constexpr size_t WS_SHW1 = WS_G2 + MODV;
constexpr size_t WS_SHW2 = WS_SHW1 + al256((size_t)DEPTH * NSLOT * INP * 4);
constexpr size_t WS_ROPE = WS_SHW2 + al256((size_t)DEPTH * NSLOT * DFF * 4);
constexpr size_t WS_ST1 = WS_ROPE + al256(64 * 16 * 8);
constexpr size_t WS_ST2 = WS_ST1 + al256((size_t)MROWS * 16 * 4);
constexpr size_t WS_STQ = WS_ST2 + al256((size_t)MROWS * 16 * 4);
constexpr size_t WS_STKV = WS_STQ + al256((size_t)MROWS * 8 * 4);
constexpr size_t WS_STG = WS_STKV + al256((size_t)MROWS * 4 * 4);
constexpr size_t WS_WIN = WS_STG + al256((size_t)MROWS * 4 * 4);
constexpr size_t WS_WUQ = WS_WIN + al256((size_t)DEPTH * INP * DM * 2);
constexpr size_t WS_WKVF = WS_WUQ + al256((size_t)DEPTH * QW * QRANK * 2);
constexpr size_t WS_WKVC = WS_WKVF + al256((size_t)DEPTH * KVW * KVRANK * 2);
constexpr size_t WS_WOUT = WS_WKVC + al256((size_t)DEPTH * KVW * KVRANK * 2);
constexpr size_t WS_WF1 = WS_WOUT + al256((size_t)DEPTH * DM * DM * 2);
constexpr size_t WS_WF2 = WS_WF1 + al256((size_t)DEPTH * DFF * DM * 2);
constexpr size_t WS_WPT = WS_WF2 + al256((size_t)DEPTH * DM * DFF * 2);
constexpr size_t WS_WSB = WS_WPT + al256((size_t)DEPTH * 4 * 64 * 64 * 2);
constexpr size_t WS_CCKV = WS_WSB + al256((size_t)DEPTH * 4 * 128 * 128 * 2);
constexpr size_t WS_XG = WS_CCKV + al256((size_t)DEPTH * NLATB * PAST * KVRANK * 2);
constexpr size_t cmax(size_t a, size_t b) { return a > b ? a : b; }
constexpr size_t LB(size_t base, size_t w) { return base - (size_t)NCTX * w * 2; }
constexpr size_t WS_XB = WS_XG + al256((size_t)MROWS * DM * 2);
constexpr size_t WS_RC = WS_XB + al256((size_t)MROWS * DM * 2);
constexpr size_t HP_C = WS_RC, CKVR_C = HP_C + (size_t)NCTX * 256 * 2, U_C = CKVR_C + (size_t)NCTX * 256 * 2, GL_C = U_C + (size_t)NCTX * 256 * 2;
constexpr size_t CQ_C = GL_C + (size_t)NCTX * 256 * 2, Q_C = CQ_C + (size_t)NCTX * QRANK * 2, WS_KC = Q_C + (size_t)NCTX * QW * 2;
constexpr size_t WS_VC = WS_KC + (size_t)NCTXB * NH * LCTX * 192 * 2, YCAT_C = WS_VC + (size_t)NCTXB * NH * LCTX * 128 * 2;
constexpr size_t HID_C = WS_RC;
constexpr size_t WS_RL = al256(cmax(YCAT_C + (size_t)NCTX * DM * 2, HID_C + (size_t)NCTX * DFF * 2));
constexpr size_t HP_L0 = WS_RL, CKVR_L0 = HP_L0 + (size_t)NLAT * 256 * 2, U_L0 = CKVR_L0 + (size_t)NLAT * 256 * 2, GL_L0 = U_L0 + (size_t)NLAT * 256 * 2;
constexpr size_t CQ_L0 = GL_L0 + (size_t)NLAT * 256 * 2, Q_L0 = CQ_L0 + (size_t)NLAT * QRANK * 2, WS_KL = Q_L0 + (size_t)NLAT * QW * 2;
constexpr size_t WS_VL = WS_KL + (size_t)NLATB * NH * LKEY * 192 * 2, YCAT_L0 = WS_VL + (size_t)NLATB * NH * LKEY * 128 * 2;
constexpr size_t HID_L0 = WS_RL;
constexpr size_t HP_L = LB(HP_L0, 256), CKVR_L = LB(CKVR_L0, 256), U_L = LB(U_L0, 256), GL_L = LB(GL_L0, 256), CQ_L = LB(CQ_L0, QRANK), Q_L = LB(Q_L0, QW), YCAT_L = LB(YCAT_L0, DM), HID_L = LB(HID_L0, DFF);
constexpr size_t WS_OVL = WS_RC;
constexpr size_t WS_END = al256(cmax(YCAT_L0 + (size_t)NLAT * DM * 2, HID_L0 + (size_t)NLAT * DFF * 2));
#define SPLIT(isctx, NAME) ((isctx) ? NAME##_C : NAME##_L)

constexpr int CW_BAR = 4096;
constexpr int CW_FIN = 16384;
constexpr int CW_XCC = 8192;

constexpr int RING_BYTES = 131072, MISC_OFF = RING_BYTES + 320, LDS_BYTES = 147456;

#define RLX_AGENT __ATOMIC_RELAXED, __HIP_MEMORY_SCOPE_AGENT
#define LDS_WAIT() asm volatile("s_waitcnt lgkmcnt(0)" ::: "memory")
#define VM_WAIT() asm volatile("s_waitcnt vmcnt(0)" ::: "memory")
#define SBAR() __builtin_amdgcn_sched_barrier(0)
__device__ __forceinline__ unsigned cvt_pk_bf16(float lo, float hi) { unsigned r; asm volatile("v_cvt_pk_bf16_f32 %0, %1, %2" : "=v"(r) : "v"(lo), "v"(hi)); return r; }
__device__ __forceinline__ float bf_lo(unsigned w) { return __uint_as_float(w << 16); }
__device__ __forceinline__ float bf_hi(unsigned w) { return __uint_as_float(w & 0xffff0000u); }
__device__ __forceinline__ float bf1(bf16_t h) { return __uint_as_float(((unsigned)h) << 16); }
__device__ __forceinline__ bf16_t f2bf(float f) { return (bf16_t)(cvt_pk_bf16(f, 0.f) & 0xffffu); }
__device__ __forceinline__ float fast_rsqrt(float x) { return __builtin_amdgcn_rsqf(x); }
__device__ __forceinline__ float gelu_tanh(float x) {
    const float z = x * (1.0f + 0.044715f * x * x);
    const float e = __builtin_amdgcn_exp2f(z * (-2.0f * 0.7978845608028654f * 1.4426950408889634f));
    return x * __builtin_amdgcn_rcpf(1.0f + e);
}
__device__ __forceinline__ float wave_sum(float v) {
#pragma unroll
    for (int o = 1; o < 64; o <<= 1) v += __shfl_xor(v, o);
    return v;
}
__device__ __forceinline__ float fq_sum(float q) {
    { auto r = __builtin_amdgcn_permlane16_swap(__float_as_uint(q), __float_as_uint(q), false, false); q = __uint_as_float(r[0]) + __uint_as_float(r[1]); }
    { auto r = __builtin_amdgcn_permlane32_swap(__float_as_uint(q), __float_as_uint(q), false, false); q = __uint_as_float(r[0]) + __uint_as_float(r[1]); }
    return q;
}
__device__ __forceinline__ int slot_of_tile(int pm) { return pm < 16 ? 0 : 1 + ((pm - 16) >> 3); }

#define XB_TMO      128
#define XB_XCNT(j)  (256  + 64 * (j))
#define XB_XSUB(j)  (1280 + 64 * (j))
#define XB_XGEN(j)  (2304 + 64 * (j))
#define XB_TOP      3328
#define XB_TOPGEN   3392
#define XCD_BAR_WORDS 3456
#define XB_SPIN_CAP (1u << 18)
__device__ __forceinline__ unsigned xb_ld(unsigned* p)              { return __hip_atomic_load(p, __ATOMIC_RELAXED, __HIP_MEMORY_SCOPE_AGENT); }
__device__ __forceinline__ unsigned xb_add(unsigned* p, unsigned v) { return __hip_atomic_fetch_add(p, v, __ATOMIC_RELAXED, __HIP_MEMORY_SCOPE_AGENT); }
__device__ __forceinline__ unsigned xb_xcc_id() { return (unsigned)__builtin_amdgcn_s_getreg((3 << 11) | 20) & 0xFu; }
#define XB_SPIN(cond, bar) do { unsigned _sp = 0; while (cond) { __builtin_amdgcn_s_sleep(1); \
    if ((++_sp & 255u) == 0u) { if (xb_ld(&(bar)[XB_TMO])) break; if (_sp > XB_SPIN_CAP) { atomicAdd(&(bar)[XB_TMO], 1u); break; } } } } while (0)
struct XcdBarrier { unsigned* bar; unsigned x; volatile LAS unsigned* st; };
__device__ __forceinline__ XcdBarrier xcd_barrier_post(unsigned* bar, volatile LAS unsigned* st) {
    XcdBarrier b; b.bar = bar; b.x = xb_xcc_id(); b.st = st;
    if (threadIdx.x == 0) (void)xb_add(&bar[XB_XCNT(b.x)], 1u);
    return b;
}
__device__ __forceinline__ void xcd_barrier_complete(unsigned* bar, unsigned x, unsigned& nloc, unsigned& nx) {
    const unsigned G = gridDim.x * gridDim.y * gridDim.z;
    unsigned sum, cnt, mine, sp = 0u;
    for (;;) {
        sum = 0u; cnt = 0u; mine = 0u;
#pragma unroll
        for (unsigned j = 0; j < 16; ++j) { const unsigned c = xb_ld(&bar[XB_XCNT(j)]); sum += c; cnt += (c > 0u) ? 1u : 0u; mine = (j == x) ? c : mine; }
        if (sum == G) break;
        __builtin_amdgcn_s_sleep(1);
        if ((++sp & 255u) == 0u) { if (xb_ld(&bar[XB_TMO])) break; if (sp > XB_SPIN_CAP) { atomicAdd(&bar[XB_TMO], 1u); break; } }
    }
    nloc = mine > 0u ? mine : 1u; nx = cnt > 0u ? cnt : 1u;
}
__device__ __forceinline__ void xcd_barrier(const XcdBarrier& b) {
    asm volatile("s_waitcnt vmcnt(0)" ::: "memory");
    __syncthreads();
    if (threadIdx.x == 0) {
        unsigned* bar = b.bar;
        __builtin_amdgcn_s_waitcnt(0);
        unsigned nloc = b.st[0], nx = b.st[1];
        if (nloc == 0u) { xcd_barrier_complete(bar, b.x, nloc, nx); b.st[0] = nloc; b.st[1] = nx; }
        const unsigned old = xb_add(&bar[XB_XSUB(b.x)], 1u);
        const unsigned gen = old / nloc;
        if (old + 1u == (gen + 1u) * nloc && b.st[3] != 0u) {
            asm volatile("s_waitcnt vmcnt(0)" ::: "memory");
            __builtin_amdgcn_fence(__ATOMIC_ACQUIRE, "agent");
            xb_add(&bar[XB_XGEN(b.x)], 1u);
            asm volatile("s_waitcnt vmcnt(0)" ::: "memory");
        } else if (old + 1u == (gen + 1u) * nloc) {
            if (b.st[2] == 0u) __builtin_amdgcn_fence(__ATOMIC_RELEASE, "agent");
            asm volatile("s_waitcnt vmcnt(0)" ::: "memory");
            const unsigned og = xb_add(&bar[XB_TOP], 1u);
            const unsigned tg = og / nx;
            if (og + 1u == (tg + 1u) * nx) xb_add(&bar[XB_TOPGEN], 1u);
            else XB_SPIN(xb_ld(&bar[XB_TOPGEN]) == tg, bar);
            __builtin_amdgcn_fence(__ATOMIC_ACQUIRE, "agent");
            xb_add(&bar[XB_XGEN(b.x)], 1u);
            asm volatile("s_waitcnt vmcnt(0)" ::: "memory");
        } else {
            XB_SPIN(xb_ld(&bar[XB_XGEN(b.x)]) == gen, bar);
            __builtin_amdgcn_fence(__ATOMIC_ACQUIRE, "agent");
            asm volatile("s_waitcnt vmcnt(0)" ::: "memory");
        }
    }
    __syncthreads();
}

struct Args { const float* in[24]; float* out; unsigned char* ws; int ph_lo, ph_hi; };

struct Ctx {
    const Args* a; GAS float* out; GAS unsigned char* ws;
    LAS unsigned char* lds;
    int tid, lane, wave, G, vcu;
};
template <class T> __device__ __forceinline__ GAS T* wsp(const Ctx& F, size_t off) { return (GAS T*)(F.ws + off); }
#define GIN(k) ((const GAS float*)F.a->in[k])

constexpr int BK = 64, HALF = 128, HTB = HALF * BK * 2;
__host__ __device__ __forceinline__ int lds_byte(int r, int c) { const int st = (r >> 4) * 2 + (c >> 5), rr = r & 15, cc = c & 31, ob = rr * 64 + cc * 2; return st * 1024 + (ob ^ (((ob >> 9) & 1) << 5)); }
__host__ __device__ __forceinline__ void stage_rc(int b, int& R, int& C) { const int st = b / 1024, sb = b % 1024, swz = sb ^ (((sb >> 9) & 1) << 5); R = (st >> 1) * 16 + swz / 64; C = (st & 1) * 32 + (swz % 64) / 2; }
__host__ __device__ __forceinline__ int perm32(int rho) { const int n = rho >> 4, i = rho & 15; return 8 * (i >> 2) + 4 * n + (i & 3); }

struct GUnit { unsigned A, B; int K, pm, pn, kind, l; };
__device__ __forceinline__ void map_unit(int L, int nM, int nN, int& pm, int& pn) {
    const int nwg = nM * nN; int wgid = L;
    { const int q = nwg / 8, r = nwg % 8, xcd = wgid % 8, off = wgid / 8; wgid = (xcd < r ? xcd * (q + 1) : r * (q + 1) + (xcd - r) * q) + off; }
    const int nig = 8 * nN, gid = wgid / nig, fm = gid * 8, gsz = (nM - fm) < 8 ? (nM - fm) : 8;
    pm = fm + ((wgid % nig) % gsz); pn = (wgid % nig) / gsz;
}

typedef f32x4 Acc[2][2][4][2];

template <class Sched, class Epi>
__device__ __forceinline__ void gemm_phase(LAS unsigned char* lds, const Sched& S, const Epi& E) {
    int tid_ = threadIdx.x; asm volatile("" : "+v"(tid_));
    const int tid = tid_, wid = __builtin_amdgcn_readfirstlane(tid >> 6), lane = tid & 63, wr = wid >> 2, wc = wid & 3, fr = lane & 15, fq = lane >> 4;
    int sR[2], sRb[2], sC[2];
#define PG8_LANECONST(t_) do { _Pragma("unroll") for (int i = 0; i < 2; ++i) { int R, C; stage_rc((t_) * 16 + i * 8192, R, C); sR[i] = R; sRb[i] = (R & ~31) + perm32(R & 31); sC[i] = C; } } while (0)
    PG8_LANECONST(tid);
    const unsigned kstep = (unsigned)(BK * 2);
    const GAS unsigned char* gws = S.ws;
    const unsigned ldsw = (unsigned)wid * 1024u;
    int aoff = lds_byte(wr * 64 + fr, fq * 8), boff = lds_byte(wc * 32 + fr, fq * 8);
#define PG8_SA(b, h) (((b) * 2 + (h)) * HTB)
#define PG8_SB(b, h) ((4 + (b) * 2 + (h)) * HTB)
#define PG8_STAGE(bufoff, goff, v0, v1) do { \
        __builtin_amdgcn_global_load_lds((const GAS unsigned*)(gws + (size_t)((goff) + (v0))), (LAS unsigned*)(lds + (bufoff) + ldsw), 16, 0, 0); \
        __builtin_amdgcn_global_load_lds((const GAS unsigned*)(gws + (size_t)((goff) + (v1))), (LAS unsigned*)(lds + (bufoff) + ldsw + 8192), 16, 0, 0); } while (0)
#define PG8_LDA(dst, b, h) do { _Pragma("unroll") for (int m = 0; m < 4; ++m) _Pragma("unroll") for (int k = 0; k < 2; ++k) dst[m][k] = *(const LAS bf16x8*)(lds + PG8_SA(b, h) + aoff + m * 2048 + k * 1024); } while (0)
#define PG8_LDB(dst, b, h) do { _Pragma("unroll") for (int n = 0; n < 2; ++n) _Pragma("unroll") for (int k = 0; k < 2; ++k) dst[n][k] = *(const LAS bf16x8*)(lds + PG8_SB(b, h) + boff + n * 2048 + k * 1024); } while (0)
#define PG8_MMA(ai, bj, At, Bt) do { __builtin_amdgcn_s_setprio(1); _Pragma("unroll") for (int m = 0; m < 4; ++m) _Pragma("unroll") for (int n = 0; n < 2; ++n) _Pragma("unroll") for (int k = 0; k < 2; ++k) \
        acc[ai][bj][m][n] = __builtin_amdgcn_mfma_f32_16x16x32_bf16(Bt[n][k], At[m][k], acc[ai][bj][m][n], 0, 0, 0); __builtin_amdgcn_s_setprio(0); } while (0)
#define PG8_WAIT_V(n) asm volatile("s_waitcnt vmcnt(" #n ")" ::: "memory")
#define PG8_WAIT_L(n) asm volatile("s_waitcnt lgkmcnt(" #n ")" ::: "memory")
#define PG8_BAR __builtin_amdgcn_s_barrier()
#define PG8_SCHED __builtin_amdgcn_sched_barrier(0)
    GUnit cur, nxt; int ui = 0;
    if (!S.next(0, cur)) return;
    Acc acc;
#pragma unroll
    for (int a = 0; a < 2; ++a)
#pragma unroll
        for (int b = 0; b < 2; ++b)
#pragma unroll
            for (int m = 0; m < 4; ++m)
#pragma unroll
                for (int n = 0; n < 2; ++n) acc[a][b][m][n] = (f32x4){0.f, 0.f, 0.f, 0.f};
    bf16x8 At[4][2], B0[2][2], B1[2][2];
    unsigned vA0 = (unsigned)(sR[0] * cur.K + sC[0]) * 2u, vA1 = (unsigned)(sR[1] * cur.K + sC[1]) * 2u;
    unsigned vB0 = (unsigned)(sRb[0] * cur.K + sC[0]) * 2u, vB1 = (unsigned)(sRb[1] * cur.K + sC[1]) * 2u;
    unsigned hs = (unsigned)HALF * cur.K * 2;
    unsigned cA = cur.A, cB = cur.B;
    PG8_STAGE(PG8_SB(0, 0), cB, vB0, vB1); PG8_STAGE(PG8_SB(0, 1), cB + hs, vB0, vB1); PG8_STAGE(PG8_SA(0, 0), cA, vA0, vA1); PG8_STAGE(PG8_SA(0, 1), cA + hs, vA0, vA1);
    if (wr == 1) PG8_BAR;
    PG8_WAIT_V(2); PG8_BAR;
    PG8_STAGE(PG8_SB(1, 0), cB + kstep, vB0, vB1); PG8_STAGE(PG8_SA(1, 0), cA + kstep, vA0, vA1); PG8_STAGE(PG8_SB(1, 1), cB + hs + kstep, vB0, vB1);
    PG8_WAIT_V(6); PG8_BAR;
    for (;;) {
        { int tq = tid; asm volatile("" : "+v"(tq)); PG8_LANECONST(tq); const int fr_ = tq & 15, fq_ = (tq & 63) >> 4; aoff = lds_byte(wr * 64 + fr_, fq_ * 8); boff = lds_byte(wc * 32 + fr_, fq_ * 8);
          vA0 = (unsigned)(sR[0] * cur.K + sC[0]) * 2u; vA1 = (unsigned)(sR[1] * cur.K + sC[1]) * 2u; vB0 = (unsigned)(sRb[0] * cur.K + sC[0]) * 2u; vB1 = (unsigned)(sRb[1] * cur.K + sC[1]) * 2u; }
        const bool has_next = S.next(ui + 1, nxt);
        if (!has_next) nxt = cur;
        const unsigned nvA0 = (unsigned)(sR[0] * nxt.K + sC[0]) * 2u, nvA1 = (unsigned)(sR[1] * nxt.K + sC[1]) * 2u;
        const unsigned nvB0 = (unsigned)(sRb[0] * nxt.K + sC[0]) * 2u, nvB1 = (unsigned)(sRb[1] * nxt.K + sC[1]) * 2u;
        const unsigned nhs = (unsigned)HALF * nxt.K * 2;
        const unsigned nA = nxt.A, nB = nxt.B;
        const int nt = cur.K >> 6;
        for (int t = 0; t < nt; t += 2) {
            const bool last = (t == nt - 2);
            const unsigned a1 = cA + (unsigned)(t + 1) * kstep;
            const unsigned a2 = last ? nA : cA + (unsigned)(t + 2) * kstep, b2 = last ? nB : cB + (unsigned)(t + 2) * kstep;
            const unsigned a3 = a2 + kstep, b3 = b2 + kstep;
            const unsigned wA0 = last ? nvA0 : vA0, wA1 = last ? nvA1 : vA1, wB0 = last ? nvB0 : vB0, wB1 = last ? nvB1 : vB1;
            const unsigned hs2 = last ? nhs : hs;
            PG8_LDB(B0, 0, 0); PG8_LDB(B1, 0, 1); PG8_SCHED; PG8_LDA(At, 0, 0); PG8_STAGE(PG8_SA(1, 1), a1 + hs, vA0, vA1);
            PG8_WAIT_V(8); PG8_WAIT_L(0); PG8_BAR; PG8_MMA(0, 0, At, B0); PG8_MMA(0, 1, At, B1); PG8_BAR; PG8_SCHED;
            PG8_LDA(At, 0, 1); PG8_STAGE(PG8_SB(0, 0), b2, wB0, wB1); PG8_STAGE(PG8_SB(0, 1), b2 + hs2, wB0, wB1); PG8_STAGE(PG8_SA(0, 0), a2, wA0, wA1);
            PG8_WAIT_V(8); PG8_WAIT_L(0); PG8_BAR; PG8_MMA(1, 0, At, B0); PG8_MMA(1, 1, At, B1); PG8_BAR; PG8_SCHED;
            PG8_LDB(B0, 1, 0); PG8_LDB(B1, 1, 1); PG8_SCHED; PG8_LDA(At, 1, 0); PG8_STAGE(PG8_SA(0, 1), a2 + hs2, wA0, wA1);
            PG8_WAIT_V(8); PG8_WAIT_L(0); PG8_BAR; PG8_MMA(0, 0, At, B0); PG8_MMA(0, 1, At, B1); PG8_BAR; PG8_SCHED;
            PG8_LDA(At, 1, 1); PG8_STAGE(PG8_SB(1, 0), b3, wB0, wB1); PG8_STAGE(PG8_SB(1, 1), b3 + hs2, wB0, wB1); PG8_STAGE(PG8_SA(1, 0), a3, wA0, wA1);
            PG8_WAIT_V(8); PG8_WAIT_L(0); PG8_BAR; PG8_MMA(1, 0, At, B0); PG8_MMA(1, 1, At, B1); PG8_BAR; PG8_SCHED;
        }
        if (wr == 0) PG8_BAR;
        E(acc, cur, wr, wc, fr, fq, tid, (LAS float*)(lds + RING_BYTES + 2048));
        if (!has_next) break;
#pragma unroll
        for (int a = 0; a < 2; ++a)
#pragma unroll
            for (int b = 0; b < 2; ++b)
#pragma unroll
                for (int m = 0; m < 4; ++m)
#pragma unroll
                    for (int n = 0; n < 2; ++n) acc[a][b][m][n] = (f32x4){0.f, 0.f, 0.f, 0.f};
        cur = nxt; cA = nA; cB = nB; hs = nhs; ++ui;
        if (wr == 1) PG8_BAR;
    }
    PG8_WAIT_V(0);
    PG8_BAR;
#undef PG8_SA
#undef PG8_LANECONST
#undef PG8_SB
#undef PG8_STAGE
#undef PG8_LDA
#undef PG8_LDB
#undef PG8_MMA
#undef PG8_WAIT_V
#undef PG8_WAIT_L
#undef PG8_BAR
#undef PG8_SCHED
}

enum Kind { K_HP = 0, K_CKV = 1, K_U = 2, K_VG = 3, K_CQ0 = 4, K_CQ1 = 5, K_Q = 6, K_KV = 7, K_KVC = 8, K_OUT = 9, K_FF1 = 10, K_FF2 = 11 };

__device__ __forceinline__ u32x4 pack8(const f32x4 a, const f32x4 b) { u32x4 w; w.x = cvt_pk_bf16(a[0], a[1]); w.y = cvt_pk_bf16(a[2], a[3]); w.z = cvt_pk_bf16(b[0], b[1]); w.w = cvt_pk_bf16(b[2], b[3]); return w; }
__device__ __forceinline__ float sum4(const f32x4 v) { return (v[0] + v[1]) + (v[2] + v[3]); }
__device__ __forceinline__ float sq8(const f32x4 a, const f32x4 b) { return (a[0] * a[0] + a[1] * a[1]) + (a[2] * a[2] + a[3] * a[3]) + (b[0] * b[0] + b[1] * b[1]) + (b[2] * b[2] + b[3] * b[3]); }

struct Epi {
    GAS unsigned char* ws; GAS float* out; const GAS float* xp; const GAS float* xs;
    bool dry;

    __device__ __forceinline__ void operator()(Acc& acc, const GUnit& u, int wr, int wc, int fr, int fq, int tid, LAS float* tab) const {
        int rowb_ = u.pm * 256 + wr * 64 + fr, colw_ = wc * 32 + 8 * fq;
        asm volatile("" : "+v"(rowb_), "+v"(colw_));
        const int rowb = rowb_, colw = colw_, s = slot_of_tile(u.pm), l = u.l;
        const bool isctx = u.pm < 16;
        GAS float* xout = out + OUT_X;
        const GAS float* stin = nullptr;
        if (u.kind <= K_CQ1) stin = (const GAS float*)(ws + WS_ST1);
        else if (u.kind == K_Q) stin = (const GAS float*)(ws + WS_STQ);
        else if (u.kind == K_KV) stin = (const GAS float*)(ws + WS_STKV);
        else if (u.kind == K_FF1) stin = (const GAS float*)(ws + WS_ST2);
        const int tagv = ((u.kind <= K_CQ1 ? 0 : u.kind) << 20) | (l << 12) | (u.pm << 2) | 1;
        const bool fresh = stin && __builtin_amdgcn_readfirstlane(*(volatile LAS int*)(tab + 256)) != tagv;
        if (fresh) {
            int tq = tid; asm volatile("" : "+v"(tq));
            if (tq < 256) { const int row = u.pm * 256 + tq; float rs;
                if (u.kind == K_Q) { const GAS f32x4* sp = (const GAS f32x4*)(stin + (size_t)row * 8); rs = fast_rsqrt((sum4(sp[0]) + sum4(sp[1])) * (1.0f / QRANK) + EPS) * C2; }
                else if (u.kind == K_KV) { const f32x4 t0 = *(const GAS f32x4*)(stin + (size_t)row * 4); rs = fast_rsqrt(sum4(t0) * (1.0f / KVRANK) + EPS); }
                else { const GAS f32x4* sp = (const GAS f32x4*)(stin + (size_t)row * 16); rs = fast_rsqrt(((sum4(sp[0]) + sum4(sp[1])) + (sum4(sp[2]) + sum4(sp[3]))) * (1.0f / DM) + EPS); }
                tab[tq] = rs; }
            asm volatile("s_waitcnt lgkmcnt(0)" ::: "memory"); __builtin_amdgcn_s_barrier(); asm volatile("" ::: "memory");
            if (tq == 0) *(volatile LAS int*)(tab + 256) = tagv;
        }
        const int rl0 = wr * 64 + fr;
        switch (u.kind) {
        case K_HP: case K_CKV: case K_U: case K_VG: case K_CQ0: case K_CQ1: {
            const GAS float* shw = (const GAS float*)(ws + WS_SHW1) + (size_t)l * NSLOT * INP; const int ldshw = INP;
            const LAS f32x2* rope = (const LAS f32x2*)(tab + 512);
            f32x4 sw[2][2];
#pragma unroll
            for (int bj = 0; bj < 2; ++bj) { const float* p = shw + (size_t)s * ldshw + u.pn * 256 + bj * 128 + colw; sw[bj][0] = *(const f32x4*)p; sw[bj][1] = *(const f32x4*)(p + 4); }
            bf16_t* dst; int ldd, coff = 0; float* st = nullptr; int sto = 0, stw = 4;
            if (u.kind == K_HP) { dst = (bf16_t*)(ws + SPLIT(isctx, HP)); ldd = 256; }
            else if (u.kind == K_CKV) { dst = (bf16_t*)(ws + SPLIT(isctx, CKVR)); ldd = 256; st = (float*)(ws + WS_STKV); }
            else if (u.kind == K_U) { dst = (bf16_t*)(ws + SPLIT(isctx, U)); ldd = 256; }
            else if (u.kind == K_VG) { dst = (bf16_t*)(ws + SPLIT(isctx, GL)); ldd = 256; st = (float*)(ws + WS_STG); }
            else if (u.kind == K_CQ0) { dst = (bf16_t*)(ws + SPLIT(isctx, CQ)); ldd = QRANK; st = (float*)(ws + WS_STQ); stw = 8; }
            else { dst = (bf16_t*)(ws + SPLIT(isctx, CQ)); ldd = QRANK; coff = 256; st = (float*)(ws + WS_STQ); stw = 8; sto = 4; }
            const bool act = (u.kind == K_U || u.kind == K_VG);
#pragma unroll
            for (int ai = 0; ai < 2; ++ai)
#pragma unroll
                for (int m = 0; m < 4; ++m) {
                    asm volatile("" ::: "memory");
                    const int row = rowb + ai * 128 + m * 16;
                    const float rs = tab[rl0 + ai * 128 + m * 16];
                    f32x4 v[2][2];
#pragma unroll
                    for (int bj = 0; bj < 2; ++bj)
#pragma unroll
                        for (int n = 0; n < 2; ++n) { v[bj][n] = acc[ai][bj][m][n] * rs + sw[bj][n];
                            if (act) {
#pragma unroll
                                for (int j = 0; j < 4; ++j) v[bj][n][j] = gelu_tanh(v[bj][n][j]); } }
                    if (u.kind != K_CQ1) {
                        *(u32x4*)(dst + (size_t)row * ldd + coff + colw) = pack8(v[0][0], v[0][1]);
                        *(u32x4*)(dst + (size_t)row * ldd + coff + 128 + colw) = pack8(v[1][0], v[1][1]);
                        if (st) { float q = sq8(v[0][0], v[0][1]) + sq8(v[1][0], v[1][1]); q = fq_sum(q); if (fq == 0) st[(size_t)row * stw + sto + wc] = q; }
                        if (u.kind == K_CKV && isctx) {
                            float* o = out + OUT_CKV + ((size_t)(u.pm * DEPTH + l) * LCTX + (row & 255)) * KVRANK + colw;
                            *(f32x4*)o = v[0][0]; *(f32x4*)(o + 4) = v[0][1]; *(f32x4*)(o + 128) = v[1][0]; *(f32x4*)(o + 132) = v[1][1];
                        }
                    } else {
                        *(u32x4*)(dst + (size_t)row * ldd + coff + colw) = pack8(v[0][0], v[0][1]);
                        { float q = sq8(v[0][0], v[0][1]); q = fq_sum(q); if (fq == 0) st[(size_t)row * stw + sto + wc] = q; }
                        if (wc < 2) {
                            const int p0 = colw, i0 = p0 >> 1, t = row & 255;
                            float x[8] = {v[1][0][0], v[1][0][1], v[1][0][2], v[1][0][3], v[1][1][0], v[1][1][1], v[1][1][2], v[1][1][3]};
                            if (isctx) {
                                float* o = out + OUT_KR + ((size_t)(u.pm * DEPTH + l) * LCTX + t) * 64;
#pragma unroll
                                for (int j = 0; j < 4; ++j) { o[i0 + j] = x[2 * j]; o[32 + i0 + j] = x[2 * j + 1]; }
                                u32x4 w; w.x = cvt_pk_bf16(x[0], x[1]); w.y = cvt_pk_bf16(x[2], x[3]); w.z = cvt_pk_bf16(x[4], x[5]); w.w = cvt_pk_bf16(x[6], x[7]);
                                bf16_t* kd = (bf16_t*)(ws + WS_KC) + ((size_t)(u.pm * NH) * LCTX + t) * 192 + 128 + p0;
#pragma unroll
                                for (int h = 0; h < NH; ++h) *(u32x4*)(kd + (size_t)h * LCTX * 192) = w;
                            } else {
                                const int b = (u.pm - 16) >> 3, tl = ((u.pm - 16) & 7) * 256 + t;
                                const int pos = (wc == 0) ? (tl >> 6) : (tl & 63);
                                float y[8];
#pragma unroll
                                for (int j = 0; j < 4; ++j) { const f32x2 cs = rope[pos * 16 + ((i0 + j) & 15)]; y[2 * j] = x[2 * j] * cs.x - x[2 * j + 1] * cs.y; y[2 * j + 1] = x[2 * j + 1] * cs.x + x[2 * j] * cs.y; }
                                u32x4 w; w.x = cvt_pk_bf16(y[0], y[1]); w.y = cvt_pk_bf16(y[2], y[3]); w.z = cvt_pk_bf16(y[4], y[5]); w.w = cvt_pk_bf16(y[6], y[7]);
                                bf16_t* kd = (bf16_t*)(ws + WS_KL) + ((size_t)(b * NH) * LKEY + PAST + tl) * 192 + 128 + p0;
#pragma unroll
                                for (int h = 0; h < NH; ++h) *(u32x4*)(kd + (size_t)h * LKEY * 192) = w;
                            }
                        }
                    }
                }
        } break;
        case K_Q: {
            const LAS f32x2* rope = (const LAS f32x2*)(tab + 512);
            bf16_t* dst = (bf16_t*)(ws + SPLIT(isctx, Q));
#pragma unroll
            for (int ai = 0; ai < 2; ++ai)
#pragma unroll
                for (int m = 0; m < 4; ++m) {
                    asm volatile("" ::: "memory");
                    const int row = rowb + ai * 128 + m * 16;
                    const float rs = tab[rl0 + ai * 128 + m * 16];
#pragma unroll
                    for (int bj = 0; bj < 2; ++bj) {
                        const int c = u.pn * 256 + bj * 128 + colw, w192 = c % 192;
                        f32x4 v0 = acc[ai][bj][m][0] * rs, v1 = acc[ai][bj][m][1] * rs;
                        if (!isctx && w192 >= 128) {
                            const int i0 = (w192 - 128) >> 1, tl = ((u.pm - 16) & 7) * 256 + (row & 255);
                            const int pos = (i0 < 16) ? (tl >> 6) : (tl & 63);
                            float x[8] = {v0[0], v0[1], v0[2], v0[3], v1[0], v1[1], v1[2], v1[3]}, y[8];
#pragma unroll
                            for (int j = 0; j < 4; ++j) { const f32x2 cs = rope[pos * 16 + ((i0 + j) & 15)]; y[2 * j] = x[2 * j] * cs.x - x[2 * j + 1] * cs.y; y[2 * j + 1] = x[2 * j + 1] * cs.x + x[2 * j] * cs.y; }
                            v0 = (f32x4){y[0], y[1], y[2], y[3]}; v1 = (f32x4){y[4], y[5], y[6], y[7]};
                        }
                        *(u32x4*)(dst + (size_t)row * QW + c) = pack8(v0, v1);
                    }
                }
        } break;
        case K_KV: case K_KVC: {
            const int h = u.pn;
            bf16_t *kd, *vd; int ldrow;
            if (u.kind == K_KVC) { kd = (bf16_t*)(ws + WS_KL) + ((size_t)(u.pm * NH + h) * LKEY) * 192; vd = (bf16_t*)(ws + WS_VL) + ((size_t)(u.pm * NH + h) * LKEY) * 128; }
            else if (isctx) { kd = (bf16_t*)(ws + WS_KC) + ((size_t)(u.pm * NH + h) * LCTX) * 192; vd = (bf16_t*)(ws + WS_VC) + ((size_t)(u.pm * NH + h) * LCTX) * 128; }
            else { const int b = (u.pm - 16) >> 3, k0 = PAST + ((u.pm - 16) & 7) * 256; kd = (bf16_t*)(ws + WS_KL) + ((size_t)(b * NH + h) * LKEY + k0) * 192; vd = (bf16_t*)(ws + WS_VL) + ((size_t)(b * NH + h) * LKEY + k0) * 128; }
            (void)ldrow;
#pragma unroll
            for (int ai = 0; ai < 2; ++ai)
#pragma unroll
                for (int m = 0; m < 4; ++m) {
                    asm volatile("" ::: "memory");
                    const int row = rowb + ai * 128 + m * 16, rl = row & 255;
                    float rs = 1.0f;
                    if (u.kind == K_KV) rs = tab[rl0 + ai * 128 + m * 16];
                    *(u32x4*)(kd + (size_t)rl * 192 + colw) = pack8(acc[ai][0][m][0] * rs, acc[ai][0][m][1] * rs);
                    *(u32x4*)(vd + (size_t)rl * 128 + colw) = pack8(acc[ai][1][m][0] * rs, acc[ai][1][m][1] * rs);
                }
        } break;
        case K_OUT: case K_FF2: {
            const GAS float *gate, *gmn; GAS float* stout;
            if (u.kind == K_OUT) { gate = (const GAS float*)(ws + WS_G1) + (size_t)l * NSLOT * DM; gmn = (const GAS float*)(ws + WS_GM2) + (size_t)l * NSLOT * DM; stout = (GAS float*)(ws + WS_ST2); }
            else { gate = (const GAS float*)(ws + WS_G2) + (size_t)l * NSLOT * DM; gmn = (l + 1 < DEPTH) ? (const GAS float*)(ws + WS_GM1) + (size_t)(l + 1) * NSLOT * DM : nullptr; stout = (GAS float*)(ws + WS_ST1); }
            const bool in32 = (u.kind == K_OUT && l == 0);
            const GAS float* xin = isctx ? xp : xs - (size_t)NCTX * DM;
            GAS bf16_t* xb = (GAS bf16_t*)(ws + WS_XB);
            bf16_t* xg = (bf16_t*)(ws + WS_XG);
            const unsigned cb = (unsigned)(u.pn * 256 + colw);
            const float* gp = gate + (size_t)s * DM + cb; const float* mp_ = gmn ? gmn + (size_t)s * DM + cb : gp;
            if (!in32) {
                GAS unsigned char* const XBB = (GAS unsigned char*)xb; GAS unsigned char* const XGB = (GAS unsigned char*)xg;
                float qa[8];
#pragma unroll
                for (int bj = 0; bj < 2; ++bj) {
                    asm volatile("" ::: "memory");
                    const f32x4 gtA = *(const f32x4*)(gp + bj * 128), gtB = *(const f32x4*)(gp + bj * 128 + 4), gmA = *(const f32x4*)(mp_ + bj * 128), gmB = *(const f32x4*)(mp_ + bj * 128 + 4);
                    u32x4 rb[8];
#pragma unroll
                    for (int r = 0; r < 8; ++r) { const unsigned eb = ((unsigned)(rowb + (r >> 2) * 128 + (r & 3) * 16) * (unsigned)DM + cb + (unsigned)(bj * 128)) * 2u; rb[r] = *(const GAS u32x4*)(XBB + eb); }
                    asm volatile("" ::: "memory");
#pragma unroll
                    for (int r = 0; r < 8; ++r) { const int ai = r >> 2, m = r & 3; const unsigned eb = ((unsigned)(rowb + ai * 128 + m * 16) * (unsigned)DM + cb + (unsigned)(bj * 128)) * 2u;
                        const u32x4 b = rb[r];
                        const f32x4 x0 = (f32x4){bf_lo(b.x), bf_hi(b.x), bf_lo(b.y), bf_hi(b.y)} + gtA * acc[ai][bj][m][0], x1 = (f32x4){bf_lo(b.z), bf_hi(b.z), bf_lo(b.w), bf_hi(b.w)} + gtB * acc[ai][bj][m][1];
                        if (!dry) *(GAS u32x4*)(XBB + eb) = pack8(x0, x1);
                        if (gmn && !dry) *(GAS u32x4*)(XGB + eb) = pack8(x0 * gmA, x1 * gmB);
                        float q_ = sq8(x0, x1); asm volatile("" : "+v"(q_));
                        if (bj == 0) qa[r] = q_;
                        else { const float q = fq_sum(qa[r] + q_); if (fq == 0 && !dry) stout[(size_t)(rowb + ai * 128 + m * 16) * 16 + u.pn * 4 + wc] = q; }
                        asm volatile("" ::: "memory"); }
                }
            } else {
            const f32x4 gt00 = *(const f32x4*)gp, gt01 = *(const f32x4*)(gp + 4), gt10 = *(const f32x4*)(gp + 128), gt11 = *(const f32x4*)(gp + 132);
#pragma unroll
            for (int ai = 0; ai < 2; ++ai)
#pragma unroll
                for (int mp = 0; mp < 2; ++mp) {
                    asm volatile("" ::: "memory");
                    const unsigned e0 = (unsigned)(rowb + ai * 128 + (2 * mp) * 16) * (unsigned)DM + cb, e1 = e0 + 16u * DM;
                    f32x4 r000, r001, r010, r011, r100, r101, r110, r111;
                    if (in32) {
                        r000 = *(const GAS f32x4*)(xin + e0); r001 = *(const GAS f32x4*)(xin + e0 + 4); r010 = *(const GAS f32x4*)(xin + e0 + 128); r011 = *(const GAS f32x4*)(xin + e0 + 132);
                        r100 = *(const GAS f32x4*)(xin + e1); r101 = *(const GAS f32x4*)(xin + e1 + 4); r110 = *(const GAS f32x4*)(xin + e1 + 128); r111 = *(const GAS f32x4*)(xin + e1 + 132);
                    } else {
                        const u32x4 b00 = *(const GAS u32x4*)(xb + e0), b01 = *(const GAS u32x4*)(xb + e0 + 128), b10 = *(const GAS u32x4*)(xb + e1), b11 = *(const GAS u32x4*)(xb + e1 + 128);
                        r000 = (f32x4){bf_lo(b00.x), bf_hi(b00.x), bf_lo(b00.y), bf_hi(b00.y)}; r001 = (f32x4){bf_lo(b00.z), bf_hi(b00.z), bf_lo(b00.w), bf_hi(b00.w)};
                        r010 = (f32x4){bf_lo(b01.x), bf_hi(b01.x), bf_lo(b01.y), bf_hi(b01.y)}; r011 = (f32x4){bf_lo(b01.z), bf_hi(b01.z), bf_lo(b01.w), bf_hi(b01.w)};
                        r100 = (f32x4){bf_lo(b10.x), bf_hi(b10.x), bf_lo(b10.y), bf_hi(b10.y)}; r101 = (f32x4){bf_lo(b10.z), bf_hi(b10.z), bf_lo(b10.w), bf_hi(b10.w)};
                        r110 = (f32x4){bf_lo(b11.x), bf_hi(b11.x), bf_lo(b11.y), bf_hi(b11.y)}; r111 = (f32x4){bf_lo(b11.z), bf_hi(b11.z), bf_lo(b11.w), bf_hi(b11.w)};
                    }
                    const f32x4 gm00 = *(const f32x4*)mp_, gm01 = *(const f32x4*)(mp_ + 4), gm10 = *(const f32x4*)(mp_ + 128), gm11 = *(const f32x4*)(mp_ + 132);
                    {   const int m = 2 * mp;
                        const f32x4 x00 = r000 + gt00 * acc[ai][0][m][0], x01 = r001 + gt01 * acc[ai][0][m][1], x10 = r010 + gt10 * acc[ai][1][m][0], x11 = r011 + gt11 * acc[ai][1][m][1];
                        if (!dry) { *(GAS u32x4*)(xb + e0) = pack8(x00, x01); *(GAS u32x4*)(xb + e0 + 128) = pack8(x10, x11); }
                        if (gmn && !dry) { *(u32x4*)(xg + e0) = pack8(x00 * gm00, x01 * gm01); *(u32x4*)(xg + e0 + 128) = pack8(x10 * gm10, x11 * gm11); }
                        float q = sq8(x00, x01) + sq8(x10, x11); q = fq_sum(q);
                        if (fq == 0 && !dry) stout[(size_t)(rowb + ai * 128 + m * 16) * 16 + u.pn * 4 + wc] = q; }
                    {   const int m = 2 * mp + 1;
                        const f32x4 x00 = r100 + gt00 * acc[ai][0][m][0], x01 = r101 + gt01 * acc[ai][0][m][1], x10 = r110 + gt10 * acc[ai][1][m][0], x11 = r111 + gt11 * acc[ai][1][m][1];
                        if (!dry) { *(GAS u32x4*)(xb + e1) = pack8(x00, x01); *(GAS u32x4*)(xb + e1 + 128) = pack8(x10, x11); }
                        if (gmn && !dry) { *(u32x4*)(xg + e1) = pack8(x00 * gm00, x01 * gm01); *(u32x4*)(xg + e1 + 128) = pack8(x10 * gm10, x11 * gm11); }
                        float q = sq8(x00, x01) + sq8(x10, x11); q = fq_sum(q);
                        if (fq == 0 && !dry) stout[(size_t)(rowb + ai * 128 + m * 16) * 16 + u.pn * 4 + wc] = q; }
                }
            }
        } break;
        case K_FF1: {
            const GAS float* shw = (const GAS float*)(ws + WS_SHW2) + (size_t)l * NSLOT * DFF; const int ldshw = DFF;
            f32x4 sw[2][2];
#pragma unroll
            for (int bj = 0; bj < 2; ++bj) { const float* p = shw + (size_t)s * ldshw + u.pn * 256 + bj * 128 + colw; sw[bj][0] = *(const f32x4*)p; sw[bj][1] = *(const f32x4*)(p + 4); }
            bf16_t* dst = (bf16_t*)(ws + SPLIT(isctx, HID));
#pragma unroll
            for (int ai = 0; ai < 2; ++ai)
#pragma unroll
                for (int m = 0; m < 4; ++m) {
                    asm volatile("" ::: "memory");
                    const int row = rowb + ai * 128 + m * 16;
                    const float rs = tab[rl0 + ai * 128 + m * 16];
#pragma unroll
                    for (int bj = 0; bj < 2; ++bj) {
                        f32x4 v0 = acc[ai][bj][m][0] * rs + sw[bj][0], v1 = acc[ai][bj][m][1] * rs + sw[bj][1];
#pragma unroll
                        for (int j = 0; j < 4; ++j) { const float a = fmaxf(v0[j], 0.f), b = fmaxf(v1[j], 0.f); v0[j] = a * a; v1[j] = b * b; }
                        *(u32x4*)(dst + (size_t)row * DFF + u.pn * 256 + bj * 128 + colw) = pack8(v0, v1);
                    }
                }
        } break;
        default: break;
        }
    }
};

struct GList { size_t aoff, boff; int K, nM, nN, pm0, kind, l, n0, q0, q1; };
#define GL_(ao, bo, K_, nM_, nN_, pm0_, kind_, l_, n0_, q0_, q1_) do { g.aoff = (ao); g.boff = (bo); g.K = (K_); g.nM = (nM_); g.nN = (nN_); g.pm0 = (pm0_); g.kind = (kind_); g.l = (l_); g.n0 = (n0_); g.q0 = (q0_); g.q1 = (q1_); return true; } while (0)
__device__ __forceinline__ bool slot_list(int sub, int j, int l, GList& g) {
    const size_t oWIN = WS_WIN + (size_t)l * INP * DM * 2, oWUQ = WS_WUQ + (size_t)l * QW * QRANK * 2, oWKVF = WS_WKVF + (size_t)l * KVW * KVRANK * 2, oWKVC = WS_WKVC + (size_t)l * KVW * KVRANK * 2;
    const size_t oWOUT = WS_WOUT + (size_t)l * DM * DM * 2, oWF1 = WS_WF1 + (size_t)l * DFF * DM * 2, oWF2 = WS_WF2 + (size_t)l * DM * DFF * 2;
    switch (sub) {
    case -1: if (j == 0) GL_(WS_XG, oWIN, DM, 16, 6, 0, -1, 0, 12, 1, 0); break;
    case 0:  if (j == 0) GL_(WS_XG, oWIN, DM, 64, 6, 16, -1, l, 16, 2, 1);
             if (j == 1) GL_(CQ_C, oWUQ, QRANK, 16, 3, 0, K_Q, l, 16, 0, 1);
             if (j == 2) GL_(CKVR_C, oWKVF, KVRANK, 16, 4, 0, K_KV, l, 22, 0, 1); break;
    case 1:  if (j == 0) GL_(CQ_L, oWUQ, QRANK, 64, 3, 16, K_Q, l, 24, 1, 0);
             if (j == 1) GL_(CKVR_L, oWKVF, KVRANK, 64, 4, 16, K_KV, l, 32, 1, 0);
             if (j == 2) GL_(WS_CCKV + (size_t)l * NLATB * PAST * KVRANK * 2, oWKVC, KVRANK, 8, 4, 0, K_KVC, l, 4, 1, 0); break;
    case 2:  if (j == 0) GL_(YCAT_C, oWOUT, DM, 16, 4, 0, K_OUT, l, 8, 1, 0); break;
    case 3:  if (j == 0) GL_(YCAT_L, oWOUT, DM, 64, 4, 16, K_OUT, l, 32, 1, 0);
             if (j == 1) GL_(WS_XG, oWF1, DM, 16, 16, 0, K_FF1, l, 32, 1, 0); break;
    case 4:  if (j == 0) GL_(HID_C, oWF2, DFF, 16, 4, 0, K_FF2, l, 8, 1, 0);
             if (j == 1) GL_(WS_XG, oWF1, DM, 64, 16, 16, K_FF1, l, 8, 1, -5); break;
    default: if (j == 0) GL_(HID_L, oWF2, DFF, 64, 4, 16, K_FF2, l, 32, 1, 0);
             if (j == 1 && l + 1 < DEPTH) GL_(WS_XG, oWIN + (size_t)INP * DM * 2, DM, 16, 6, 0, -1, l + 1, 12, 1, 0); break;
    }
    return false;
}
#undef GL_
struct SchedSlot {
    const GAS unsigned char* ws; int c, G, sub, l;
    __device__ __forceinline__ bool next(int i, GUnit& u) const {
        int k = i;
        const int x = c >> 5, li = c & 31;
#pragma unroll
        for (int j = 0; j < 3; ++j) {
            GList g; if (!slot_list(sub, (sub == 3 && (c & 1)) ? (j ^ 1) : j, l, g)) { if (sub == 3 && j < 2) continue; return false; }
            int pm, pn; bool hit = false;
            if (G == 256) {
                const int rM = g.nM >> 3, n = rM * g.nN;
                if (g.q1 < 0) {
                    const int qa = -g.q1, t = li - g.n0, qe = li < g.n0 ? g.q0 : qa;
                    if (k < qe) { pm = g.pm0 + rM * x + (li < g.n0 ? li % rM : t % rM); pn = li < g.n0 ? ((32 - g.n0) / rM) * qa + li / rM : (t / rM) * qa + k; hit = true; } else k -= qe;
                } else {
                const int q = li < g.n0 ? g.q0 : g.q1, start = li < g.n0 ? li * g.q0 : g.n0 * g.q0 + (li - g.n0) * g.q1;
                int qe = n - start; qe = qe < 0 ? 0 : (qe < q ? qe : q);
                if (k < qe) { const int lidx = start + k; pm = g.pm0 + rM * x + (lidx % rM); pn = lidx / rM; hit = true; } else k -= qe;
                }
            } else {
                const int n = g.nM * g.nN, q = (n + G - 1) / G, start = c * q;
                int qe = n - start; qe = qe < 0 ? 0 : (qe < q ? qe : q);
                if (k < qe) { const int idx = start + k; pm = g.pm0 + idx % g.nM; pn = idx / g.nM; hit = true; } else k -= qe;
            }
            if (hit) { u.A = (unsigned)(g.aoff + (size_t)pm * 256 * g.K * 2); u.B = (unsigned)(g.boff + (size_t)pn * 256 * g.K * 2); u.K = g.K; u.pm = pm; u.pn = pn; u.kind = g.kind < 0 ? pn : g.kind; u.l = g.l; return true; }
        }
        return false;
    }
};

#define KSWZ(row, colB) ((row) * 256 + ((colB) ^ (((row) & 15) << 4)))
#define KRSWZ(row, colB) ((row) * 128 + ((colB) ^ ((((row) >> 1) & 7) << 4)))
__device__ __forceinline__ int crow(int r, int hi) { return (r & 3) + 8 * (r >> 2) + 4 * hi; }
__device__ __forceinline__ int v_rd_base(int lane) { return ((lane & 3) << 3) | (((lane >> 2) & 3) << 6) | (((lane >> 4) & 1) << 5) | (((lane >> 5) & 1) << 8); }
constexpr int v_rd_off(int d0, int ks, int half) { return d0 * 512 + ks * 4096 + half * 2048; }
template <int OFF> __device__ __forceinline__ s16x4 tr_read(int vb) { s16x4 r; asm volatile("ds_read_b64_tr_b16 %0, %1 offset:%2" : "=&v"(r) : "v"(vb), "i"(OFF) : "memory"); return r; }
struct VFrag { s16x4 l0, h0, l1, h1, l2, h2, l3, h3; };
template <int D0> __device__ __forceinline__ void pv_read(VFrag& f, int vb) {
    f.l0 = tr_read<v_rd_off(D0, 0, 0)>(vb); f.h0 = tr_read<v_rd_off(D0, 0, 1)>(vb); f.l1 = tr_read<v_rd_off(D0, 1, 0)>(vb); f.h1 = tr_read<v_rd_off(D0, 1, 1)>(vb);
    f.l2 = tr_read<v_rd_off(D0, 2, 0)>(vb); f.h2 = tr_read<v_rd_off(D0, 2, 1)>(vb); f.l3 = tr_read<v_rd_off(D0, 3, 0)>(vb); f.h3 = tr_read<v_rd_off(D0, 3, 1)>(vb);
}
__device__ __forceinline__ void pv_wait(VFrag& f) {
    asm volatile("s_waitcnt lgkmcnt(0)" : "+v"(f.l0), "+v"(f.h0), "+v"(f.l1), "+v"(f.h1), "+v"(f.l2), "+v"(f.h2), "+v"(f.l3), "+v"(f.h3) :: "memory"); SBAR();
}
__device__ __forceinline__ void pv_mma(f32x16& od, const VFrag& f, bf16x8 pa0, bf16x8 pa1, bf16x8 pa2, bf16x8 pa3) {
#define PK(L, H) (bf16x8){L[0], L[1], L[2], L[3], H[0], H[1], H[2], H[3]}
    od = __builtin_amdgcn_mfma_f32_32x32x16_bf16(pa0, PK(f.l0, f.h0), od, 0, 0, 0);
    od = __builtin_amdgcn_mfma_f32_32x32x16_bf16(pa1, PK(f.l1, f.h1), od, 0, 0, 0);
    od = __builtin_amdgcn_mfma_f32_32x32x16_bf16(pa2, PK(f.l2, f.h2), od, 0, 0, 0);
    od = __builtin_amdgcn_mfma_f32_32x32x16_bf16(pa3, PK(f.l3, f.h3), od, 0, 0, 0);
#undef PK
}
constexpr int A_V = 0, A_KN = 32768, A_KR = 65536, A_WS = 81920, A_OST = 0;
constexpr float ATT_THR = 6.0f;
__device__ __forceinline__ void attn_unit(LAS unsigned char* ldsb, const GAS bf16_t* __restrict__ Qb, const GAS bf16_t* __restrict__ Kh, const GAS bf16_t* __restrict__ Vh, GAS bf16_t* __restrict__ Ob, int seq) {
    int tid_ = threadIdx.x; asm volatile("" : "+v"(tid_));
    const int tid = tid_, wid = __builtin_amdgcn_readfirstlane(tid >> 6), lane = tid & 63, r32 = lane & 31, hi = lane >> 5;
    char* lds = (char*)ldsb;
    char* Kn_lds = lds + A_KN; char* Kr_lds = lds + A_KR;
    float* wsf = (float*)(lds + A_WS) + wid * 64; float* li_l = wsf; float* al_l = wsf + 32;
    float m_reg = -1e30f, l_reg = 0.f; f32x16 o[4] = {}; bf16x8 qr[12];
    const GAS bf16_t* Qw = Qb + (size_t)(wid * 32 + r32) * QW + hi * 8;
#pragma unroll
    for (int d0 = 0; d0 < 12; ++d0) qr[d0] = *(const GAS bf16x8*)(Qw + d0 * 16);
#pragma unroll
    for (int d0 = 0; d0 < 12; ++d0) asm volatile("" : "+v"(qr[d0]));
    unsigned gk0, gk1, gkr, gv0, gv1;
    { int r = 4 * wid + (lane >> 4), c = (lane & 15) ^ (r & 15); gk0 = (unsigned)(r * 192 + c * 8);
      r = 4 * (wid + 8) + (lane >> 4); c = (lane & 15) ^ (r & 15); gk1 = (unsigned)(r * 192 + c * 8);
      r = 8 * wid + (lane >> 3); c = (lane & 7) ^ ((r >> 1) & 7); gkr = (unsigned)(r * 192 + 128 + c * 8);
      int p = wid, kk = (p >> 1) * 8 + ((lane & 31) >> 2), k = (kk & ~0xC) | ((kk & 4) << 1) | ((kk & 8) >> 1); gv0 = (unsigned)(k * 128 + (2 * (p & 1) + (lane >> 5)) * 32 + (lane & 3) * 8);
      p = wid + 8; kk = (p >> 1) * 8 + ((lane & 31) >> 2); k = (kk & ~0xC) | ((kk & 4) << 1) | ((kk & 8) >> 1); gv1 = (unsigned)(k * 128 + (2 * (p & 1) + (lane >> 5)) * 32 + (lane & 3) * 8); }
    const int vb0 = (int)(uintptr_t)(lds + A_V) + v_rd_base(lane);
#define ADMA(k0, b) do { const GAS bf16_t* kt = Kh + (size_t)(k0) * 192; const GAS bf16_t* vt = Vh + (size_t)(k0) * 128; \
        __builtin_amdgcn_global_load_lds((const GAS unsigned*)(kt + gk0), (LAS unsigned*)(ldsb + A_KN + (b) * 16384 + wid * 1024), 16, 0, 0); \
        __builtin_amdgcn_global_load_lds((const GAS unsigned*)(kt + gk1), (LAS unsigned*)(ldsb + A_KN + (b) * 16384 + (wid + 8) * 1024), 16, 0, 0); \
        __builtin_amdgcn_global_load_lds((const GAS unsigned*)(kt + gkr), (LAS unsigned*)(ldsb + A_KR + (b) * 8192 + wid * 1024), 16, 0, 0); \
        __builtin_amdgcn_global_load_lds((const GAS unsigned*)(vt + gv0), (LAS unsigned*)(ldsb + A_V + (b) * 16384 + wid * 1024), 16, 0, 0); \
        __builtin_amdgcn_global_load_lds((const GAS unsigned*)(vt + gv1), (LAS unsigned*)(ldsb + A_V + (b) * 16384 + (wid + 8) * 1024), 16, 0, 0); } while (0)
#define AWAITBAR() do { asm volatile("s_waitcnt vmcnt(0) lgkmcnt(0)" ::: "memory"); __builtin_amdgcn_s_barrier(); asm volatile("" ::: "memory"); } while (0)
    const int NT = seq / 64;
    ADMA(0, 0); AWAITBAR();
    for (int j = 0; j < NT; ++j) {
        const int cb = j & 1;
        if (j + 1 < NT) ADMA((j + 1) * 64, cb ^ 1);
        f32x16 p0 = {}, p1 = {};
        { const char* Kn = Kn_lds + cb * 16384; const char* Kr = Kr_lds + cb * 8192;
#define KFRAG(G, I, ROWOFF) ((G) < 4 ? *(const bf16x8*)(Kn + KSWZ((ROWOFF) + r32, ((2 * (G) + (I)) * 16 + hi * 8) * 2)) : *(const bf16x8*)(Kr + KRSWZ((ROWOFF) + r32, ((2 * ((G) - 4) + (I)) * 16 + hi * 8) * 2)))
#define KLOADG(G, X0, X1, Y0, Y1) do { X0 = KFRAG(G, 0, 0); Y0 = KFRAG(G, 0, 32); X1 = KFRAG(G, 1, 0); Y1 = KFRAG(G, 1, 32); } while (0)
#define KPIN(X0, X1, Y0, Y1) asm volatile("" : "+v"(X0), "+v"(Y0), "+v"(X1), "+v"(Y1))
#define KMMAG(G, X0, X1, Y0, Y1) do { \
              p0 = __builtin_amdgcn_mfma_f32_32x32x16_bf16(X0, qr[2 * (G)], p0, 0, 0, 0); p1 = __builtin_amdgcn_mfma_f32_32x32x16_bf16(Y0, qr[2 * (G)], p1, 0, 0, 0); \
              p0 = __builtin_amdgcn_mfma_f32_32x32x16_bf16(X1, qr[2 * (G) + 1], p0, 0, 0, 0); p1 = __builtin_amdgcn_mfma_f32_32x32x16_bf16(Y1, qr[2 * (G) + 1], p1, 0, 0, 0); } while (0)
          bf16x8 fa0, fa1, fb0, fb1, ga0, ga1, gb0, gb1;
          KLOADG(0, fa0, fa1, fb0, fb1); SBAR(); KPIN(fa0, fa1, fb0, fb1); SBAR();
          KLOADG(1, ga0, ga1, gb0, gb1); SBAR(); KMMAG(0, fa0, fa1, fb0, fb1); SBAR(); KPIN(ga0, ga1, gb0, gb1); SBAR();
          KLOADG(2, fa0, fa1, fb0, fb1); SBAR(); KMMAG(1, ga0, ga1, gb0, gb1); SBAR(); KPIN(fa0, fa1, fb0, fb1); SBAR();
          KLOADG(3, ga0, ga1, gb0, gb1); SBAR(); KMMAG(2, fa0, fa1, fb0, fb1); SBAR(); KPIN(ga0, ga1, gb0, gb1); SBAR();
          KLOADG(4, fa0, fa1, fb0, fb1); SBAR(); KMMAG(3, ga0, ga1, gb0, gb1); SBAR(); KPIN(fa0, fa1, fb0, fb1); SBAR();
          KLOADG(5, ga0, ga1, gb0, gb1); SBAR(); KMMAG(4, fa0, fa1, fb0, fb1); SBAR(); KPIN(ga0, ga1, gb0, gb1); SBAR();
          KMMAG(5, ga0, ga1, gb0, gb1); SBAR();
#undef KPIN
#undef KFRAG
#undef KLOADG
#undef KMMAG
        }
        float pmax = p0[0];
#pragma unroll
        for (int r = 1; r < 16; ++r) pmax = fmaxf(pmax, p0[r]);
#pragma unroll
        for (int r = 0; r < 16; ++r) pmax = fmaxf(pmax, p1[r]);
        { auto rr = __builtin_amdgcn_permlane32_swap(__float_as_uint(pmax), __float_as_uint(pmax), false, false); pmax = fmaxf(__uint_as_float(rr[0]), __uint_as_float(rr[1])); }
        float alpha = 1.f;
        if (!__all(pmax - m_reg <= ATT_THR)) { const float mn = fmaxf(m_reg, pmax); alpha = __builtin_amdgcn_exp2f(m_reg - mn); m_reg = mn; }
        float ps = 0.f;
#pragma unroll
        for (int r = 0; r < 16; ++r) { p0[r] = __builtin_amdgcn_exp2f(p0[r] - m_reg); p1[r] = __builtin_amdgcn_exp2f(p1[r] - m_reg); ps += p0[r] + p1[r]; }
        { auto rr = __builtin_amdgcn_permlane32_swap(__float_as_uint(ps), __float_as_uint(ps), false, false); ps = __uint_as_float(rr[0]) + __uint_as_float(rr[1]); }
        l_reg = l_reg * alpha + ps;
        bf16x8 pa0, pa1, pa2, pa3;
#define PK4(P, BASE, OUT) do { unsigned a0 = cvt_pk_bf16(P[BASE + 0], P[BASE + 1]), a1 = cvt_pk_bf16(P[BASE + 2], P[BASE + 3]);   \
        unsigned b0 = cvt_pk_bf16(P[BASE + 4], P[BASE + 5]), b1 = cvt_pk_bf16(P[BASE + 6], P[BASE + 7]);                              \
        auto r0 = __builtin_amdgcn_permlane32_swap(a0, b0, false, false); auto r1 = __builtin_amdgcn_permlane32_swap(a1, b1, false, false); \
        u32x4 w = {r0[0], r1[0], r0[1], r1[1]}; OUT = *reinterpret_cast<bf16x8*>(&w); } while (0)
        PK4(p0, 0, pa0); PK4(p0, 8, pa1); PK4(p1, 0, pa2); PK4(p1, 8, pa3);
#undef PK4
        if (__any(alpha < 1.f)) { if (hi == 0) al_l[r32] = alpha; LDS_WAIT();
#pragma unroll
            for (int d = 0; d < 4; ++d)
#pragma unroll
                for (int r = 0; r < 16; ++r) o[d][r] *= al_l[crow(r, hi)]; }
        { const int vb = vb0 + cb * 16384;
          VFrag va, vc;
          pv_read<0>(va, vb); pv_wait(va);
          pv_read<1>(vc, vb); SBAR(); pv_mma(o[0], va, pa0, pa1, pa2, pa3); SBAR(); pv_wait(vc);
          pv_read<2>(va, vb); SBAR(); pv_mma(o[1], vc, pa0, pa1, pa2, pa3); SBAR(); pv_wait(va);
          pv_read<3>(vc, vb); SBAR(); pv_mma(o[2], va, pa0, pa1, pa2, pa3); SBAR(); pv_wait(vc);
          pv_mma(o[3], vc, pa0, pa1, pa2, pa3); SBAR(); }
        AWAITBAR();
    }
#undef ADMA
#undef AWAITBAR
    if (hi == 0) li_l[r32] = l_reg; LDS_WAIT();
    float rli[16];
#pragma unroll
    for (int r = 0; r < 16; ++r) rli[r] = __builtin_amdgcn_rcpf(li_l[crow(r, hi)]);
    bf16_t* stg = (bf16_t*)(lds + A_OST) + wid * 4096;
#pragma unroll
    for (int r = 0; r < 16; ++r) { const int orow = crow(r, hi);
#pragma unroll
        for (int d0 = 0; d0 < 4; ++d0) stg[orow * 128 + d0 * 32 + r32] = f2bf(o[d0][r] * rli[r]); }
    LDS_WAIT();
#pragma unroll
    for (int i = 0; i < 8; ++i) { const int id = lane + 64 * i, row = id >> 4, ch = id & 15; const u32x4 v = *(const u32x4*)(stg + row * 128 + ch * 8); *(GAS u32x4*)(Ob + (size_t)(wid * 32 + row) * DM + ch * 8) = v; }
    LDS_WAIT();
    __syncthreads();
}

__device__ __forceinline__ void pool_unit(const Ctx& F, int l, int pm, int g0, int g1) {
    char* lds = (char*)F.lds;
    int tid_ = threadIdx.x; asm volatile("" : "+v"(tid_));
    const int tid = tid_, lane = tid & 63, wid = __builtin_amdgcn_readfirstlane(tid >> 6), fr = lane & 15, fq = lane >> 4;
    const bool isctx0 = pm < 16;
    const bf16_t* HP = wsp<const bf16_t>(F, SPLIT(isctx0, HP)); bf16_t* Y = wsp<bf16_t>(F, SPLIT(isctx0, YCAT));
    const bf16_t* WPT = wsp<const bf16_t>(F, WS_WPT) + (size_t)l * 4 * 4096;
    const float* pscale = GIN(11) + (size_t)l * 256;
    const int row0 = pm * 256; const bool isctx = pm < 16;
    const int L = isctx ? LCTX : LLAT, t0 = isctx ? 0 : ((pm - 16) & 7) * 256, seq0 = row0 - t0;
    bf16_t* hbuf = (bf16_t*)lds; bf16_t* abuf = (bf16_t*)(lds + 36864);
    for (int g = g0; g < g1; ++g) {
        const int w = 2 << g, hw = w >> 1;
        u32x4 hv[5];
#pragma unroll
        for (int i = 0; i < 5; ++i) { const int id = tid + 512 * i, rr = id >> 3, ch = id & 7, t = t0 - 8 + rr;
            hv[i] = (u32x4){0u, 0u, 0u, 0u}; if (id < 272 * 8 && t >= 0 && t < L) hv[i] = *(const u32x4*)(HP + (size_t)(seq0 + t) * 256 + g * 64 + ch * 8); }
        bf16x8 xa[2][4]; f32x4 psc[4];
#pragma unroll
        for (int ks = 0; ks < 2; ++ks)
#pragma unroll
            for (int nb = 0; nb < 4; ++nb) xa[ks][nb] = *(const bf16x8*)(WPT + (size_t)g * 4096 + (nb * 16 + fr) * 64 + ks * 32 + fq * 8);
#pragma unroll
        for (int nb = 0; nb < 4; ++nb) psc[nb] = *(const f32x4*)(pscale + g * 64 + nb * 16 + 4 * fq);
#pragma unroll
        for (int i = 0; i < 5; ++i) { const int id = tid + 512 * i, rr = id >> 3, ch = id & 7; if (id < 272 * 8) *(u32x4*)(hbuf + rr * 64 + ch * 8) = hv[i]; }
        __syncthreads();
#pragma unroll
        for (int it = 0; it < 4; ++it) { const int id = tid + 512 * it, tt = id >> 3, ch = id & 7, t = t0 + tt;
            const int lo = max(t - hw, 0), hiw = min(t + hw, L); float s[8] = {0, 0, 0, 0, 0, 0, 0, 0};
            for (int dq = -hw; dq < hw; ++dq) { const int q = t + dq; if (q >= lo && q < hiw) { const u32x4 v = *(const u32x4*)(hbuf + (tt + dq + 8) * 64 + ch * 8);
                s[0] += bf_lo(v.x); s[1] += bf_hi(v.x); s[2] += bf_lo(v.y); s[3] += bf_hi(v.y); s[4] += bf_lo(v.z); s[5] += bf_hi(v.z); s[6] += bf_lo(v.w); s[7] += bf_hi(v.w); } }
            const float ic = __builtin_amdgcn_rcpf((float)(hiw - lo)); const u32x4 c = *(const u32x4*)(hbuf + (tt + 8) * 64 + ch * 8);
            u32x4 o; o.x = cvt_pk_bf16(s[0] * ic - bf_lo(c.x), s[1] * ic - bf_hi(c.x)); o.y = cvt_pk_bf16(s[2] * ic - bf_lo(c.y), s[3] * ic - bf_hi(c.y));
            o.z = cvt_pk_bf16(s[4] * ic - bf_lo(c.z), s[5] * ic - bf_hi(c.z)); o.w = cvt_pk_bf16(s[6] * ic - bf_lo(c.w), s[7] * ic - bf_hi(c.w));
            *(u32x4*)(abuf + tt * 64 + ch * 8) = o; }
        __syncthreads();
        f32x4 acc[2][4];
#pragma unroll
        for (int mb = 0; mb < 2; ++mb)
#pragma unroll
            for (int nb = 0; nb < 4; ++nb) acc[mb][nb] = (f32x4){0.f, 0.f, 0.f, 0.f};
#pragma unroll
        for (int ks = 0; ks < 2; ++ks) {
            bf16x8 ya[2];
#pragma unroll
            for (int mb = 0; mb < 2; ++mb) ya[mb] = *(const bf16x8*)(abuf + (wid * 32 + mb * 16 + fr) * 64 + ks * 32 + fq * 8);
#pragma unroll
            for (int mb = 0; mb < 2; ++mb)
#pragma unroll
                for (int nb = 0; nb < 4; ++nb) acc[mb][nb] = __builtin_amdgcn_mfma_f32_16x16x32_bf16(xa[ks][nb], ya[mb], acc[mb][nb], 0, 0, 0);
        }
#pragma unroll
        for (int mb = 0; mb < 2; ++mb)
#pragma unroll
            for (int nb = 0; nb < 4; ++nb) { const int d = nb * 16 + 4 * fq; const f32x4 v = acc[mb][nb] * psc[nb];
                u32x2 o; o.x = cvt_pk_bf16(v[0], v[1]); o.y = cvt_pk_bf16(v[2], v[3]);
                *(u32x2*)(Y + (size_t)(row0 + wid * 32 + mb * 16 + fr) * DM + g * 64 + d) = o; }
        __syncthreads();
    }
}

__device__ __forceinline__ void gmlp_unit(const Ctx& F, int l, int chunk) {
    char* lds = (char*)F.lds;
    int tid_ = threadIdx.x; asm volatile("" : "+v"(tid_));
    const int tid = tid_, lane = tid & 63, wid = __builtin_amdgcn_readfirstlane(tid >> 6), fr = lane & 15, fq = lane >> 4;
    const bool isctx0 = chunk < 32;
    const bf16_t* GL = wsp<const bf16_t>(F, SPLIT(isctx0, GL)); const bf16_t* U = wsp<const bf16_t>(F, SPLIT(isctx0, U)); bf16_t* Y = wsp<bf16_t>(F, SPLIT(isctx0, YCAT));
    const float* STG = wsp<const float>(F, WS_STG);
    const bf16_t* WSB = wsp<const bf16_t>(F, WS_WSB) + (size_t)l * 4 * 16384;
    const float* gsgu = GIN(16) + (size_t)l * 256; const float* bs = GIN(18) + (size_t)l * 4 * 128;
    const int r0 = chunk * 128;
    float* rsg = (float*)lds; bf16_t* vT = (bf16_t*)(lds + 1024); constexpr int LDT = 136, VTG = 64 * LDT;
    u32x4 gv[4][2]; f32x4 g0v[4][2], g1v[4][2]; u32x2 uu[4][4]; float bp[4];
#pragma unroll
    for (int g = 0; g < 4; ++g)
#pragma unroll
        for (int i = 0; i < 2; ++i) { const int id = tid + 512 * i, q = id >> 3, cc = (id & 7) * 8;
            gv[g][i] = *(const u32x4*)(GL + (size_t)(r0 + q) * 256 + g * 64 + cc); g0v[g][i] = *(const f32x4*)(gsgu + g * 64 + cc); g1v[g][i] = *(const f32x4*)(gsgu + g * 64 + cc + 4); }
    const int p = wid * 16 + fr;
#pragma unroll
    for (int g = 0; g < 4; ++g) { bp[g] = bs[g * 128 + p];
#pragma unroll
        for (int nb = 0; nb < 4; ++nb) uu[g][nb] = *(const u32x2*)(U + (size_t)(r0 + p) * 256 + g * 64 + nb * 16 + 4 * fq); }
    if (tid < 128) { const f32x4 t = *(const f32x4*)(STG + (size_t)(r0 + tid) * 4); rsg[tid] = fast_rsqrt(sum4(t) * (1.0f / 256.0f) + EPS); }
    __syncthreads();
#pragma unroll
    for (int g = 0; g < 4; ++g)
#pragma unroll
        for (int i = 0; i < 2; ++i) { const int id = tid + 512 * i, q = id >> 3, cc = (id & 7) * 8; const float rs = rsg[q]; bf16_t* vt = vT + g * VTG; const u32x4 v = gv[g][i]; const f32x4 g0 = g0v[g][i], g1 = g1v[g][i];
            vt[(cc + 0) * LDT + q] = f2bf(bf_lo(v.x) * rs * g0[0]); vt[(cc + 1) * LDT + q] = f2bf(bf_hi(v.x) * rs * g0[1]);
            vt[(cc + 2) * LDT + q] = f2bf(bf_lo(v.y) * rs * g0[2]); vt[(cc + 3) * LDT + q] = f2bf(bf_hi(v.y) * rs * g0[3]);
            vt[(cc + 4) * LDT + q] = f2bf(bf_lo(v.z) * rs * g1[0]); vt[(cc + 5) * LDT + q] = f2bf(bf_hi(v.z) * rs * g1[1]);
            vt[(cc + 6) * LDT + q] = f2bf(bf_lo(v.w) * rs * g1[2]); vt[(cc + 7) * LDT + q] = f2bf(bf_hi(v.w) * rs * g1[3]); }
    __syncthreads();
#pragma unroll
    for (int g = 0; g < 4; ++g) {
        bf16x8 ya[4];
#pragma unroll
        for (int ks = 0; ks < 4; ++ks) ya[ks] = *(const bf16x8*)(WSB + (size_t)g * 16384 + (wid * 16 + fr) * 128 + ks * 32 + fq * 8);
        f32x4 acc[4];
#pragma unroll
        for (int nb = 0; nb < 4; ++nb) acc[nb] = (f32x4){0.f, 0.f, 0.f, 0.f};
#pragma unroll
        for (int ks = 0; ks < 4; ++ks)
#pragma unroll
            for (int nb = 0; nb < 4; ++nb) { const bf16x8 xa = *(const bf16x8*)(vT + g * VTG + (nb * 16 + fr) * LDT + ks * 32 + fq * 8);
                acc[nb] = __builtin_amdgcn_mfma_f32_16x16x32_bf16(xa, ya[ks], acc[nb], 0, 0, 0); }
#pragma unroll
        for (int nb = 0; nb < 4; ++nb) { const int c = nb * 16 + 4 * fq; const u32x2 u2 = uu[g][nb];
            u32x2 o; o.x = cvt_pk_bf16(bf_lo(u2.x) * (acc[nb][0] + bp[g]), bf_hi(u2.x) * (acc[nb][1] + bp[g])); o.y = cvt_pk_bf16(bf_lo(u2.y) * (acc[nb][2] + bp[g]), bf_hi(u2.y) * (acc[nb][3] + bp[g]));
            *(u32x2*)(Y + (size_t)(r0 + p) * DM + 768 + g * 64 + c) = o; }
    }
    __syncthreads();
}

enum MapKind { MAP_ID = 0, MAP_WIN = 1, MAP_WUQ = 2 };
__device__ __forceinline__ int colmap(int kind, int n) {
    if (kind == MAP_ID) return n;
    if (kind == MAP_WIN) {
        if (n < 256) return n;
        if (n < 512) return 640 + (n - 256);
        if (n < 768) return 960 + (n - 512);
        if (n < 1024) return 1216 + (n - 768);
        if (n < 1280) return 256 + (n - 1024);
        if (n < 1408) return 512 + (n - 1280);
        if (n < 1472) { const int p = n - 1408, i = p >> 1; return (p & 1) ? 896 + 32 + i : 896 + i; }
        return -1;
    }
    { const int hh = n / 192, w = n % 192; if (w < 128) return hh * 192 + w; const int p = w - 128, i = p >> 1; return hh * 192 + 128 + ((p & 1) ? 32 + i : i); }
}
template <bool WTHRU = false>
__device__ __forceinline__ void transpose_item(const float* W, int K, int Nsrc, int Ndst, bf16_t* WT, int mapk, const float* kscale, LAS float* scr, int item, int lane) {
    const int nblk = Ndst / 64, kb = item / nblk, nb = item % nblk, k0 = 64 * kb, n0 = 64 * nb;
    const int srcA = colmap(mapk, n0 + (lane & 31)), srcB = colmap(mapk, n0 + 32 + (lane & 31));
    float tvA[32], tvB[32];
    const int sa = srcA >= 0 ? srcA : 0, sb = srcB >= 0 ? srcB : 0;
#pragma unroll
    for (int i = 0; i < 32; ++i) { const int kk = 2 * i + (lane >> 5); tvA[i] = W[(size_t)(k0 + kk) * Nsrc + sa]; }
#pragma unroll
    for (int i = 0; i < 32; ++i) { const int kk = 2 * i + (lane >> 5); tvB[i] = W[(size_t)(k0 + kk) * Nsrc + sb]; }
    if (kscale) {
#pragma unroll
        for (int i = 0; i < 32; ++i) { const float ks = kscale[k0 + 2 * i + (lane >> 5)]; tvA[i] *= ks; tvB[i] *= ks; } }
    const int c = lane & 7;
#pragma unroll
    for (int h = 0; h < 2; ++h) {
#pragma unroll
        for (int i = 0; i < 32; ++i) { const int kk = 2 * i + (lane >> 5); scr[kk * 33 + (lane & 31)] = h == 0 ? (srcA >= 0 ? tvA[i] : 0.f) : (srcB >= 0 ? tvB[i] : 0.f); }
        LDS_WAIT(); asm volatile("" ::: "memory");
#pragma unroll
        for (int j = 0; j < 4; ++j) { const int n = (lane >> 3) + 8 * j; const LAS float* sp = scr + (8 * c) * 33 + n;
            u32x4 o; o.x = cvt_pk_bf16(sp[0 * 33], sp[1 * 33]); o.y = cvt_pk_bf16(sp[2 * 33], sp[3 * 33]); o.z = cvt_pk_bf16(sp[4 * 33], sp[5 * 33]); o.w = cvt_pk_bf16(sp[6 * 33], sp[7 * 33]);
            bf16_t* dp = WT + (size_t)(n0 + 32 * h + n) * K + k0 + 8 * c;
            if (WTHRU) asm volatile("global_store_dwordx4 %0, %1, off sc0 sc1" :: "v"((GAS u32x4*)dp), "v"(o) : "memory");
            else *(u32x4*)dp = o; }
        LDS_WAIT(); asm volatile("" ::: "memory");
    }
}
__device__ __forceinline__ float silu(float x) { return x / (1.0f + __expf(-x)); }

__device__ __forceinline__ void phase_p0a(const Ctx& F, int part = 0, int widx = 0, int nW = 1) {
    LAS float* scr = (LAS float*)(F.lds + F.wave * 16384);
    const int gw = F.vcu * 8 + F.wave, NGW = F.G * 8, lane = F.lane;
    constexpr int I_WIN = (DM / 64) * (INP / 64), I_WUQ = (QRANK / 64) * (QW / 64), I_WKV = (KVRANK / 64) * (KVW / 64), I_WOUT = (DM / 64) * (DM / 64), I_WF1 = (DM / 64) * (DFF / 64), I_WF2 = (DFF / 64) * (DM / 64), I_WP = 1;
    constexpr int PER_L = I_WIN + I_WUQ + 2 * I_WKV + I_WOUT + I_WF1 + I_WF2 + 4 * I_WP;
    constexpr int N_T = DEPTH * PER_L, N_MOD = 96 * 16, N_WS = (DEPTH * 4 * 128 * 128) / 512, N_CK = (DEPTH * NLATB * PAST * KVRANK) / 512, N_ROPE = 16;
    constexpr int NITEMS = N_MOD + N_T + N_WS + N_CK + N_ROPE;
    const bool spread = (F.G == 256);
    volatile LAS unsigned* MISCq = (volatile LAS unsigned*)(F.lds + MISC_OFF);
    if (F.tid == 0) MISCq[40] = 0u;
    __syncthreads();
    constexpr int NB_L = I_WUQ + 2 * I_WKV + I_WOUT + 4 * I_WP, NB_G = I_WUQ + 2 * I_WKV + I_WOUT, NFF = I_WF1 + I_WF2, NFFL = DEFER_FF ? 1 : DEPTH;
    bool first = true;
    for (int it = gw; ; it += NGW) {
        int r;
        if (spread) {
            if (part == 0 && first && F.wave < 6) r = F.vcu * 6 + F.wave;
            else { unsigned j = 0u; if (lane == 0) j = __hip_atomic_fetch_add((LAS unsigned*)(F.lds + MISC_OFF) + 40, 1u, __ATOMIC_RELAXED, __HIP_MEMORY_SCOPE_WORKGROUP);
                   j = (unsigned)__builtin_amdgcn_readfirstlane((int)j);
                   int d = part == 0 ? F.vcu + (int)j * F.G : widx + (int)j * nW; r = -1;
                   if (part == 0) { if (d < DEPTH * I_WIN) r = N_MOD + (d / I_WIN) * PER_L + d % I_WIN; else if (d < DEPTH * I_WIN + N_ROPE) r = NITEMS - N_ROPE + (d - DEPTH * I_WIN); }
                   else { if (d < DEPTH * NB_L) { const int q = d % NB_L; r = N_MOD + (d / NB_L) * PER_L + I_WIN + (q < NB_G ? q : q + NFF); }
                          else if ((d -= DEPTH * NB_L) < NFFL * NFF) r = N_MOD + (d / NFF) * PER_L + I_WIN + NB_G + d % NFF;
                          else if ((d -= NFFL * NFF) < N_WS + N_CK) r = N_MOD + N_T + d; }
                   if (r < 0) break; }
            first = false;
        } else { if (part != 0) break; r = it; if (r >= NITEMS) break; }
        if (r < N_MOD) {
            const int cg = r >> 4, kc = r & 15, n = cg * 256 + lane * 4, l = n / MODW, nn = n % MODW;
            { float cv[NSLOT]; const int k = kc * 64 + lane;
#pragma unroll
              for (int s = 0; s < NSLOT; ++s) cv[s] = (s == 0) ? GIN(5)[k] : GIN(4)[(size_t)(s - 1) * DM + k];
#pragma unroll
              for (int s = 0; s < NSLOT; ++s) scr[s * 64 + lane] = silu(cv[s]); }
            LDS_WAIT(); asm volatile("" ::: "memory");
            f32x4 a[NSLOT];
#pragma unroll
            for (int s = 0; s < NSLOT; ++s) a[s] = (f32x4){0.f, 0.f, 0.f, 0.f};
            const float* wp = GIN(6) + ((size_t)l * DM + kc * 64) * MODW + nn;
#pragma unroll 32
            for (int kk = 0; kk < 64; ++kk) { const f32x4 w = *(const f32x4*)(wp + (size_t)kk * MODW);
#pragma unroll
                for (int s = 0; s < NSLOT; ++s) a[s] += w * scr[s * 64 + kk]; }
            float* mp = wsp<float>(F, WS_MODP);
#pragma unroll
            for (int s = 0; s < NSLOT; ++s) *(f32x4*)(mp + ((size_t)(kc * NSLOT + s)) * (DEPTH * MODW) + n) = a[s];
            LDS_WAIT(); asm volatile("" ::: "memory");
            continue;
        }
        r -= N_MOD;
        if (r < N_T) {
            const int l = r / PER_L; int q = r % PER_L;
            if (q < I_WIN) { transpose_item(GIN(9) + (size_t)l * DM * INW, DM, INW, INP, wsp<bf16_t>(F, WS_WIN) + (size_t)l * INP * DM, MAP_WIN, nullptr, scr, q, lane); continue; } q -= I_WIN;
            if (q < I_WUQ) { transpose_item(GIN(13) + (size_t)l * QRANK * QW, QRANK, QW, QW, wsp<bf16_t>(F, WS_WUQ) + (size_t)l * QW * QRANK, MAP_WUQ, GIN(12) + (size_t)l * QRANK, scr, q, lane); continue; } q -= I_WUQ;
            if (q < I_WKV) { transpose_item(GIN(15) + (size_t)l * KVRANK * KVW, KVRANK, KVW, KVW, wsp<bf16_t>(F, WS_WKVF) + (size_t)l * KVW * KVRANK, MAP_ID, GIN(14) + (size_t)l * KVRANK, scr, q, lane); continue; } q -= I_WKV;
            if (q < I_WKV) { transpose_item(GIN(15) + (size_t)l * KVRANK * KVW, KVRANK, KVW, KVW, wsp<bf16_t>(F, WS_WKVC) + (size_t)l * KVW * KVRANK, MAP_ID, nullptr, scr, q, lane); continue; } q -= I_WKV;
            if (q < I_WOUT) { transpose_item(GIN(19) + (size_t)l * DM * DM, DM, DM, DM, wsp<bf16_t>(F, WS_WOUT) + (size_t)l * DM * DM, MAP_ID, nullptr, scr, q, lane); continue; } q -= I_WOUT;
            if (DEFER_FF && spread && l >= 1 && q < I_WF1 + I_WF2) continue;
            if (q < I_WF1) { transpose_item(GIN(21) + (size_t)l * DM * DFF, DM, DFF, DFF, wsp<bf16_t>(F, WS_WF1) + (size_t)l * DFF * DM, MAP_ID, nullptr, scr, q, lane); continue; } q -= I_WF1;
            if (q < I_WF2) { transpose_item(GIN(22) + (size_t)l * DFF * DM, DFF, DM, DM, wsp<bf16_t>(F, WS_WF2) + (size_t)l * DM * DFF, MAP_ID, nullptr, scr, q, lane); continue; } q -= I_WF2;
            { const int g = q / I_WP, it2 = q % I_WP; transpose_item(GIN(10) + ((size_t)l * 4 + g) * 4096, 64, 64, 64, wsp<bf16_t>(F, WS_WPT) + ((size_t)l * 4 + g) * 4096, MAP_ID, nullptr, scr, it2, lane); continue; }
        }
        r -= N_T;
        if (r < N_WS) {
            const float* src = GIN(17) + (size_t)r * 512 + lane * 8; const f32x4 a = *(const f32x4*)src, b = *(const f32x4*)(src + 4);
            *(u32x4*)(wsp<bf16_t>(F, WS_WSB) + (size_t)r * 512 + lane * 8) = pack8(a, b); continue;
        }
        r -= N_WS;
        if (r < N_CK) {
            const size_t e = (size_t)r * 512 + lane * 8; const int c = (int)(e % 256), j = (int)((e / 256) % 256), l = (int)((e / 65536) % 4), b = (int)(e / 262144);
            const float* src = GIN(2) + e; const f32x4 a = *(const f32x4*)src, bb = *(const f32x4*)(src + 4);
            *(u32x4*)(wsp<bf16_t>(F, WS_CCKV) + ((size_t)(l * NLATB + b) * PAST + j) * KVRANK + c) = pack8(a, bb); continue;
        }
        r -= N_CK;
        { const int id = r * 64 + lane, pos = id >> 4, j = id & 15;
          const double inv = (double)__builtin_amdgcn_exp2f(-(float)j * (13.287712379549449f / 16.0f));
          const double ang = (double)pos * inv, rev = ang * 0.15915494309189535;
          const float fr_ = (float)(rev - (double)(long long)rev);
          wsp<f32x2>(F, WS_ROPE)[id] = (f32x2){__builtin_amdgcn_cosf(fr_), __builtin_amdgcn_sinf(fr_)}; }
    }
}
__device__ __forceinline__ void ff_convert(const Ctx& F, int l) {
    constexpr int I_WF1 = (DM / 64) * (DFF / 64), I_WF2 = (DFF / 64) * (DM / 64);
    const int li = F.vcu & 31, x = F.vcu >> 5; if (li < 12) return;
    asm volatile("s_waitcnt vmcnt(0)" ::: "memory"); __syncthreads();
    LAS float* scr = (LAS float*)(F.lds + F.wave * 16384);
    const int gw = (x * 20 + (li - 12)) * 8 + F.wave, NGW = 160 * 8, lane = F.lane;
    for (int it = gw; it < I_WF1 + I_WF2; it += NGW) {
        if (it < I_WF1) transpose_item<true>(GIN(21) + (size_t)l * DM * DFF, DM, DFF, DFF, wsp<bf16_t>(F, WS_WF1) + (size_t)l * DFF * DM, MAP_ID, nullptr, scr, it, lane);
        else transpose_item<true>(GIN(22) + (size_t)l * DFF * DM, DFF, DM, DM, wsp<bf16_t>(F, WS_WF2) + (size_t)l * DM * DFF, MAP_ID, nullptr, scr, it - I_WF1, lane);
    }
}
__device__ __forceinline__ void phase_p0b(const Ctx& F) {
    const int gt = F.vcu * 512 + F.tid, NT = F.G * 512;
    const float* mp = wsp<const float>(F, WS_MODP);
    for (int id = gt; id < DEPTH * NSLOT * MODW; id += NT) {
        const int nn = id % MODW, s = (id / MODW) % NSLOT, l = id / (MODW * NSLOT);
        float v = GIN(7)[(size_t)l * MODW + nn];
#pragma unroll
        for (int kc = 0; kc < 16; ++kc) v += mp[((size_t)(kc * NSLOT + s)) * (DEPTH * MODW) + (size_t)l * MODW + nn];
        const int part = nn >> 10, k = nn & 1023; const size_t o = ((size_t)l * NSLOT + s) * DM + k;
        if (part == 0) wsp<float>(F, WS_SH1)[o] = v;
        else if (part == 1) wsp<float>(F, WS_GM1)[o] = GIN(8)[(size_t)l * DM + k] * (1.0f + v);
        else if (part == 2) wsp<float>(F, WS_G1)[o] = v;
        else if (part == 3) wsp<float>(F, WS_SH2)[o] = v;
        else if (part == 4) wsp<float>(F, WS_GM2)[o] = GIN(20)[(size_t)l * DM + k] * (1.0f + v);
        else wsp<float>(F, WS_G2)[o] = v;
    }
}
template <bool WTHRU>
__device__ __forceinline__ void shw_item(const float* SH, const GAS bf16_t* WT, float* out, int ldo, int n0, int lane) {
    const int r16 = lane & 15, kg = lane >> 4; const bool live = r16 < NSLOT;
    f32x4 acc = (f32x4){0.f, 0.f, 0.f, 0.f};
    const GAS bf16_t* bp = WT + (size_t)(n0 + r16) * DM + kg * 8;
    const float* ap = SH + (size_t)(live ? r16 : 0) * DM + kg * 8;
    for (int k0 = 0; k0 < DM; k0 += 256) {
        u32x4 b[8]; f32x4 a0[8], a1[8];
#pragma unroll
        for (int j = 0; j < 8; ++j) { b[j] = *(const GAS u32x4*)(bp + k0 + 32 * j); a0[j] = *(const f32x4*)(ap + k0 + 32 * j); a1[j] = *(const f32x4*)(ap + k0 + 32 * j + 4); }
#pragma unroll
        for (int j = 0; j < 8; ++j) {
            u32x4 hi, lo;
            hi.x = cvt_pk_bf16(a0[j][0], a0[j][1]); hi.y = cvt_pk_bf16(a0[j][2], a0[j][3]); hi.z = cvt_pk_bf16(a1[j][0], a1[j][1]); hi.w = cvt_pk_bf16(a1[j][2], a1[j][3]);
            lo.x = cvt_pk_bf16(a0[j][0] - bf_lo(hi.x), a0[j][1] - bf_hi(hi.x)); lo.y = cvt_pk_bf16(a0[j][2] - bf_lo(hi.y), a0[j][3] - bf_hi(hi.y));
            lo.z = cvt_pk_bf16(a1[j][0] - bf_lo(hi.z), a1[j][1] - bf_hi(hi.z)); lo.w = cvt_pk_bf16(a1[j][2] - bf_lo(hi.w), a1[j][3] - bf_hi(hi.w));
            if (!live) { hi = (u32x4){0u, 0u, 0u, 0u}; lo = hi; }
            const bf16x8 bv = __builtin_bit_cast(bf16x8, b[j]);
            acc = __builtin_amdgcn_mfma_f32_16x16x32_bf16(__builtin_bit_cast(bf16x8, hi), bv, acc, 0, 0, 0);
            acc = __builtin_amdgcn_mfma_f32_16x16x32_bf16(__builtin_bit_cast(bf16x8, lo), bv, acc, 0, 0, 0);
        }
    }
#pragma unroll
    for (int r = 0; r < 4; ++r) { const int sr = 4 * kg + r;
        if (sr < NSLOT) { float* o = out + (size_t)sr * ldo + n0 + r16;
            if (WTHRU) __hip_atomic_store(o, acc[r], __ATOMIC_RELAXED, __HIP_MEMORY_SCOPE_AGENT); else *o = acc[r]; } }
}
__device__ __forceinline__ void shw2_deferred(const Ctx& F, int l) {
    const int li = F.vcu & 31, x = F.vcu >> 5; if (li < 4 || li >= 16) return;
    const int item = (x * 12 + (li - 4)) * 8 + F.wave;
    if (item < DFF / 16) shw_item<true>(wsp<const float>(F, WS_SH2) + (size_t)l * NSLOT * DM, wsp<const bf16_t>(F, WS_WF1) + (size_t)l * DFF * DM, wsp<float>(F, WS_SHW2) + (size_t)l * NSLOT * DFF, DFF, item * 16, F.lane);
}
__device__ __forceinline__ const float* xrow_in(const Ctx& F, int row) { return row < NCTX ? GIN(0) + (size_t)row * DM : GIN(1) + (size_t)(row - NCTX) * DM; }
__device__ __forceinline__ void xg_rows(const Ctx& F, int lo, int hi, int gw, int NGW) {
    const int lane = F.lane;
    const float* GM = wsp<const float>(F, WS_GM1);
    bf16_t* XG = wsp<bf16_t>(F, WS_XG); float* ST1 = wsp<float>(F, WS_ST1);
    constexpr int RB = 5;
    for (int row0 = lo + gw; row0 < hi; row0 += NGW * RB) {
        f32x4 v[RB][4];
#pragma unroll
        for (int i = 0; i < RB; ++i) { const int row = row0 + i * NGW; const f32x4* xr = (const f32x4*)xrow_in(F, row < hi ? row : row0) + lane;
#pragma unroll
            for (int j = 0; j < 4; ++j) v[i][j] = xr[64 * j]; }
#pragma unroll
        for (int i = 0; i < RB; ++i) { const int row = row0 + i * NGW;
            if (row < hi) {
                const int s = slot_of_tile(row >> 8); const f32x4* gr = (const f32x4*)(GM + (size_t)s * DM) + lane;
                float q = 0.f;
#pragma unroll
                for (int j = 0; j < 4; ++j) { const f32x4 vv = v[i][j], g = gr[64 * j]; q += (vv[0] * vv[0] + vv[1] * vv[1]) + (vv[2] * vv[2] + vv[3] * vv[3]); const f32x4 y = vv * g;
                    u32x2 o; o.x = cvt_pk_bf16(y[0], y[1]); o.y = cvt_pk_bf16(y[2], y[3]); *(u32x2*)(XG + (size_t)row * DM + (64 * j + lane) * 4) = o; }
                q = wave_sum(q);
                if (lane < 16) ST1[(size_t)row * 16 + lane] = (lane == 0) ? q : 0.f;
            } }
    }
}
__device__ __forceinline__ void phase_p0c(const Ctx& F) {
    const int lane = F.lane, wid = F.wave, tid = F.tid;
    {
        constexpr int I1 = INP / 16, I2 = DFF / 16;
        const bool defer = F.G == 256;
        const int n2 = defer ? 0 : DEPTH, total = DEPTH * I1 + n2 * I2;
        for (int it = F.vcu * 8 + wid; it < total; it += F.G * 8) {
            if (it < DEPTH * I1) { const int l = it / I1, c = it % I1;
                shw_item<false>(wsp<const float>(F, WS_SH1) + (size_t)l * NSLOT * DM, wsp<const bf16_t>(F, WS_WIN) + (size_t)l * INP * DM, wsp<float>(F, WS_SHW1) + (size_t)l * NSLOT * INP, INP, c * 16, lane); }
            else { const int q = it - DEPTH * I1, l = q / I2, c = q % I2;
                shw_item<false>(wsp<const float>(F, WS_SH2) + (size_t)l * NSLOT * DM, wsp<const bf16_t>(F, WS_WF1) + (size_t)l * DFF * DM, wsp<float>(F, WS_SHW2) + (size_t)l * NSLOT * DFF, DFF, c * 16, lane); }
        }
    }
    if (F.G == 256) { xg_rows(F, 0, NCTX, F.vcu * 8 + wid, F.G * 8); __syncthreads(); phase_p0a(F, 1, F.vcu, 256); }
    else xg_rows(F, 0, MROWS, F.vcu * 8 + wid, F.G * 8);
}
__device__ __forceinline__ void final_tile(const Ctx& F, int pm, int pn) {
    asm volatile("s_waitcnt vmcnt(0)" ::: "memory");
    __syncthreads();
    if (F.tid == 0) {
        unsigned* bar = (unsigned*)((gu32*)(F.ws + WS_CTL) + CW_BAR); unsigned* cw = (unsigned*)((gu32*)(F.ws + WS_CTL) + CW_FIN + 32 * pm);
        __builtin_amdgcn_fence(__ATOMIC_RELEASE, "agent");
        asm volatile("s_waitcnt vmcnt(0)" ::: "memory");
        xb_add(cw, 1u);
        XB_SPIN(xb_ld(cw) < 4u, bar);
        __builtin_amdgcn_fence(__ATOMIC_ACQUIRE, "agent");
        asm volatile("s_waitcnt vmcnt(0)" ::: "memory");
    }
    __syncthreads();
    __builtin_amdgcn_fence(__ATOMIC_ACQUIRE, "workgroup");
    LAS float* S = (LAS float*)(F.lds + RING_BYTES + 2048);
    int t_ = F.tid; asm volatile("" : "+v"(t_));
    if (t_ == 0) *(volatile LAS int*)(S + 256) = 0;
    if (t_ < 256) { const GAS f32x4* sp = (const GAS f32x4*)(wsp<const float>(F, WS_ST1) + (size_t)(pm * 256 + t_) * 16);
        S[t_] = fast_rsqrt(((sum4(sp[0]) + sum4(sp[1])) + (sum4(sp[2]) + sum4(sp[3]))) * (1.0f / DM) + EPS); }
    __syncthreads();
    const int c16 = t_ & 31, r0 = t_ >> 5;
    const GAS float* gf = GIN(23) + pn * 256 + c16 * 8; const f32x4 g0 = *(const GAS f32x4*)gf, g1 = *(const GAS f32x4*)(gf + 4);
    const GAS bf16_t* xb = wsp<const bf16_t>(F, WS_XB) + (size_t)(pm * 256 + r0) * DM + pn * 256 + c16 * 8;
    GAS float* y = F.out + OUT_X + (size_t)(pm * 256 + r0) * DM + pn * 256 + c16 * 8;
    u32x4 b[16];
#pragma unroll
    for (int p = 0; p < 16; ++p) b[p] = *(const GAS u32x4*)(xb + (size_t)p * 16 * DM);
#pragma unroll
    for (int p = 0; p < 16; ++p) { const float rs = S[p * 16 + r0]; GAS float* yr = y + (size_t)p * 16 * DM; const u32x4 v = b[p];
        *(GAS f32x4*)yr = (f32x4){bf_lo(v.x), bf_hi(v.x), bf_lo(v.y), bf_hi(v.y)} * rs * g0; *(GAS f32x4*)(yr + 4) = (f32x4){bf_lo(v.z), bf_hi(v.z), bf_lo(v.w), bf_hi(v.w)} * rs * g1; }
}
__device__ __forceinline__ void phase_final(const Ctx& F) {
    const int gw = F.vcu * 8 + F.wave, NGW = F.G * 8, lane = F.lane;
    const float* ST1 = wsp<const float>(F, WS_ST1); const f32x4* gf = (const f32x4*)GIN(23) + lane;
    const GAS bf16_t* XB = wsp<const bf16_t>(F, WS_XB);
    for (int row = gw; row < MROWS; row += NGW) {
        const f32x4* sp = (const f32x4*)(ST1 + (size_t)row * 16);
        const float rs = fast_rsqrt(((sum4(sp[0]) + sum4(sp[1])) + (sum4(sp[2]) + sum4(sp[3]))) * (1.0f / DM) + EPS);
        const GAS u32x2* xr = (const GAS u32x2*)(XB + (size_t)row * DM) + lane;
        f32x4* yr = (f32x4*)(F.out + OUT_X + (size_t)row * DM) + lane;
#pragma unroll
        for (int j = 0; j < 4; ++j) { const u32x2 b = xr[64 * j]; const f32x4 v = (f32x4){bf_lo(b.x), bf_hi(b.x), bf_lo(b.y), bf_hi(b.y)}; yr[64 * j] = v * rs * gf[64 * j]; }
    }
}

#ifdef DIS_ATTN
#define ATTN_CALL(...) do {} while (0)
#else
#define ATTN_CALL(...) attn_unit(__VA_ARGS__)
#endif
#ifdef DIS_POOL
#define POOL_CALL(...) do {} while (0)
#else
#define POOL_CALL(...) pool_unit(__VA_ARGS__)
#endif
#ifdef DIS_GMLP
#define GMLP_CALL(...) do {} while (0)
#else
#define GMLP_CALL(...) gmlp_unit(__VA_ARGS__)
#endif
__device__ __forceinline__ void mix_fix(const Ctx& F, int l, int L, bool dry) {
    if (dry) return;
    const float* STKV = wsp<const float>(F, WS_STKV); const float* gkv = GIN(14) + (size_t)l * KVRANK;
    float* o = F.out + OUT_CKV + ((size_t)(L * DEPTH + l) * LCTX) * KVRANK;
    int tid0_ = threadIdx.x; asm volatile("" : "+v"(tid0_));
    const int c4 = (tid0_ & 63) * 4; const f32x4 g = *(const f32x4*)(gkv + c4);
    for (int t0 = tid0_ >> 6; t0 < LCTX; t0 += 64) {
        f32x4 st[8], v[8];
#pragma unroll
        for (int k = 0; k < 8; ++k) { const int t = t0 + 8 * k; st[k] = *(const f32x4*)(STKV + (size_t)(L * LCTX + t) * 4); v[k] = *(const f32x4*)(o + (size_t)t * KVRANK + c4); }
#pragma unroll
        for (int k = 0; k < 8; ++k) { const int t = t0 + 8 * k; const float rs = fast_rsqrt(sum4(st[k]) * (1.0f / KVRANK) + EPS); *(f32x4*)(o + (size_t)t * KVRANK + c4) = v[k] * rs * g; }
    }
}
__device__ __forceinline__ void mix_attn_ctx(const Ctx& F, int b, int h) {
    const GAS bf16_t* Q = wsp<const bf16_t>(F, Q_C); GAS bf16_t* Y = wsp<bf16_t>(F, YCAT_C);
    const int L = b * 4 + h; const size_t row0 = (size_t)b * LCTX;
    ATTN_CALL(F.lds, Q + row0 * QW + h * 192, wsp<const bf16_t>(F, WS_KC) + (size_t)L * LCTX * 192, wsp<const bf16_t>(F, WS_VC) + (size_t)L * LCTX * 128, Y + row0 * DM + 256 + h * 128, LCTX);
}
__device__ __forceinline__ void mix_ctx(const Ctx& F, int l, bool dry) {
    if (F.G == 256) { const int x = F.vcu >> 5, li = F.vcu & 31;
        if (li >= 16 && li < 24) { const int m = li - 16; mix_attn_ctx(F, 2 * x + (m >> 2), m & 3); }
        else if (li >= 24 && li < 28) { const int m = li - 24; POOL_CALL(F, l, 2 * x, m, m + 1); GMLP_CALL(F, l, 4 * x + m); }
        else if (li >= 28) { const int m = li - 28; POOL_CALL(F, l, 2 * x + 1, m, m + 1); if (m < 2) mix_fix(F, l, 2 * x + m, dry); }
    } else for (int j = F.vcu; j < 128; j += F.G) { const int x = j >> 4, m = j & 15;
        if (m < 2) POOL_CALL(F, l, 2 * x + m, 0, 4); else if (m < 10) mix_attn_ctx(F, 2 * x + ((m - 2) >> 2), (m - 2) & 3); else if (m < 14) GMLP_CALL(F, l, 4 * x + (m - 10)); else mix_fix(F, l, 2 * x + (m - 14), dry); }
}
__device__ __forceinline__ void mix_lat_attn(const Ctx& F) {
    const GAS bf16_t* Q = wsp<const bf16_t>(F, Q_L); GAS bf16_t* Y = wsp<bf16_t>(F, YCAT_L);
    for (int L = F.vcu; L < 256; L += F.G) {
        const int bh = L >> 3, qb = L & 7, b = bh >> 2, h = bh & 3; const size_t row0 = (size_t)NCTX + (size_t)b * LLAT + qb * 256;
        ATTN_CALL(F.lds, Q + row0 * QW + h * 192, wsp<const bf16_t>(F, WS_KL) + (size_t)bh * LKEY * 192, wsp<const bf16_t>(F, WS_VL) + (size_t)bh * LKEY * 128, Y + row0 * DM + 256 + h * 128, LKEY);
    }
}
__device__ __forceinline__ void mix_lat_small(const Ctx& F, int l) {
    if (F.G == 256) { const int x = F.vcu >> 5, li = F.vcu & 31;
        if (li >= 8 && li < 24) { const int m = li - 8; POOL_CALL(F, l, 16 + 8 * x + (m >> 1), 2 * (m & 1), 2 * (m & 1) + 2); }
        else if (li >= 24) { const int m = li - 24; GMLP_CALL(F, l, 32 + 16 * x + 2 * m); GMLP_CALL(F, l, 32 + 16 * x + 2 * m + 1); } }
    else for (int j = F.vcu; j < 192; j += F.G) { if (j < 64) POOL_CALL(F, l, 16 + j, 0, 4); else GMLP_CALL(F, l, 32 + (j - 64)); }
}

#ifdef DIS_GEMM
#define GEMM_CALL(a, b, c) do { (void)(b); (void)(c); } while (0)
#else
#define GEMM_CALL(a, b, c) gemm_phase(a, b, c)
#endif
constexpr int SL_P0A = 0, SL_P0B = 1, SL_P0C = 2, SL_PRE = 3, SL_L0 = 4, SL_PER_L = 6, SL_FINAL = SL_L0 + DEPTH * SL_PER_L, N_PHASES = SL_FINAL + 1;

__global__ void __launch_bounds__(512, 2) mega_fwd(const Args args) {
    extern __shared__ __attribute__((aligned(16))) unsigned char lds_raw[];
    Ctx F;
    F.a = &args; F.out = (GAS float*)args.out; F.ws = (GAS unsigned char*)args.ws; F.lds = (LAS unsigned char*)lds_raw;
    F.tid = threadIdx.x; F.lane = F.tid & 63; F.wave = __builtin_amdgcn_readfirstlane(F.tid >> 6);
    F.G = gridDim.x; { const int bx = blockIdx.x; F.vcu = (F.G % 8 == 0) ? (bx % 8) * (F.G / 8) + bx / 8 : bx; }
    volatile LAS unsigned* MISC = (volatile LAS unsigned*)(F.lds + MISC_OFF);
    for (int u = F.tid; u < (LDS_BYTES - RING_BYTES) / 4; u += 512) ((LAS unsigned*)(F.lds + RING_BYTES))[u] = 0u;
    __syncthreads();
    gu32* ctl = (gu32*)(F.ws + WS_CTL);
    XcdBarrier bar; bar.bar = (unsigned*)(ctl + CW_BAR); bar.x = 0; bar.st = nullptr;
#if !MK_PER_PHASE
    bar = xcd_barrier_post((unsigned*)(ctl + CW_BAR), MISC + 8);
    if (threadIdx.x == 0) __hip_atomic_store(ctl + CW_XCC + F.vcu, xb_xcc_id() + 1u, RLX_AGENT);
#endif
    const int lo = args.ph_lo, hi = (FUSE_FINAL && F.G == 256 && args.ph_hi == N_PHASES) ? (int)SL_FINAL : args.ph_hi;
    for (int ph = lo; ph < hi; ++ph) {
      int reps = 1;
      if (PROBE_PHASE >= 0) { const int key = ph == SL_P0A ? 10 : ph == SL_P0B ? 11 : ph == SL_P0C ? 12 : ph == SL_FINAL ? 13 : ph == SL_PRE ? 9 : (ph - SL_L0) % SL_PER_L; if (key == PROBE_PHASE) reps += PROBE_REP; }
      for (int rep = 0; rep < reps; ++rep) {
        const bool dry = rep > 0;
        if (PROBE_PHASE == 13 && dry) break;
#if PROBE_FLUSH && !MK_PER_PHASE
        if (dry) {
            GAS u32x4* z = (GAS u32x4*)(F.ws + WS_OVL); const size_t n16 = (size_t)180 * 1024 * 1024 / 16;
            for (size_t i = (size_t)F.vcu * 512 + threadIdx.x; i < n16; i += (size_t)F.G * 512) z[i] = (u32x4){0u, 0u, 0u, 0u};
            GAS u32x4* z2 = (GAS u32x4*)(F.out); const size_t m16 = (size_t)100 * 1024 * 1024 / 16;
            for (size_t i = (size_t)F.vcu * 512 + threadIdx.x; i < m16; i += (size_t)F.G * 512) z2[i] = (u32x4){0u, 0u, 0u, 0u};
            xcd_barrier(bar);
        }
#endif
        { int t_ = threadIdx.x; asm volatile("" : "+v"(t_)); F.tid = t_; F.lane = t_ & 63; F.wave = __builtin_amdgcn_readfirstlane(t_ >> 6);
          unsigned char* w_ = args.ws; asm volatile("" : "+s"(w_)); F.ws = (GAS unsigned char*)w_; float* o_ = args.out; asm volatile("" : "+s"(o_)); F.out = (GAS float*)o_; }
#ifndef DIS_P0
        if (ph == SL_P0A) phase_p0a(F);
        else if (ph == SL_P0B) { phase_p0b(F);
            { int t_ = threadIdx.x; asm volatile("" : "+v"(t_)); const GAS u32x4* src = (const GAS u32x4*)(F.ws + WS_ROPE); LAS u32x4* dl = (LAS u32x4*)(F.lds + RING_BYTES + 4096); dl[t_] = src[t_]; } }
        else if (ph == SL_P0C) phase_p0c(F);
        else if (ph == SL_FINAL) phase_final(F);
#else
        if (ph < SL_PRE || ph == SL_FINAL) {}
#endif
        else {
            Epi E; E.ws = F.ws; E.out = F.out; E.xp = GIN(0); E.xs = GIN(1); E.dry = dry;
            const int l = ph == SL_PRE ? 0 : (ph - SL_L0) / SL_PER_L, sub = ph == SL_PRE ? -1 : (ph - SL_L0) % SL_PER_L;
            if (sub == 1) {
                const GAS float* ck = GIN(3); GAS bf16_t* KL = wsp<bf16_t>(F, WS_KL);
                const bool loc = (F.G == 256);
                for (int id0 = loc ? (F.vcu & 31) * 512 + F.tid : F.vcu * 512 + F.tid; id0 < (loc ? PAST * 8 : NLATB * PAST * 8); id0 += (loc ? 32 : F.G) * 512) {
                    const int id = loc ? ((F.vcu >> 5) << 11) + id0 : id0;
                    const int ch = id & 7, j = (id >> 3) & 255, b = id >> 11, i0 = ch * 4;
                    const GAS float* src = ck + ((size_t)(b * DEPTH + l) * PAST + j) * 64;
                    const f32x4 a = *(const GAS f32x4*)(src + i0), c = *(const GAS f32x4*)(src + 32 + i0);
                    u32x4 w; w.x = cvt_pk_bf16(a[0], c[0]); w.y = cvt_pk_bf16(a[1], c[1]); w.z = cvt_pk_bf16(a[2], c[2]); w.w = cvt_pk_bf16(a[3], c[3]);
                    GAS bf16_t* kd = KL + ((size_t)(b * NH) * LKEY + j) * 192 + 128 + ch * 8;
#pragma unroll
                    for (int h = 0; h < NH; ++h) *(GAS u32x4*)(kd + (size_t)h * LKEY * 192) = w;
                }
            }
            if (sub == 2) { mix_lat_attn(F); if (PROBE_PHASE == 21) for (int r2 = 0; r2 < PROBE_REP; ++r2) mix_lat_attn(F); }
            { SchedSlot S; S.ws = F.ws; S.c = F.vcu; S.G = F.G; S.sub = sub; S.l = l; GEMM_CALL(F.lds, S, E); }
            if (DEFER_FF && sub == 5 && F.G == 256 && l + 1 < DEPTH && !dry) ff_convert(F, l + 1);
            if (FUSE_FINAL && F.G == 256 && l == DEPTH - 1 && sub >= 4 && !dry) {
                SchedSlot S; S.ws = F.ws; S.c = F.vcu; S.G = F.G; S.sub = sub; S.l = l; GUnit u0;
                if (S.next(0, u0) && u0.kind == K_FF2) final_tile(F, u0.pm, u0.pn);
            }
            if (sub == -1 && F.G == 256 && !dry && (F.vcu & 31) >= 12) { asm volatile("s_waitcnt vmcnt(0)" ::: "memory"); __syncthreads(); xg_rows(F, NCTX, MROWS, ((F.vcu >> 5) * 20 + (F.vcu & 31) - 12) * 8 + F.wave, 160 * 8); }
            if (sub == 1) mix_ctx(F, l, dry);
            if (sub == 1 && F.G == 256 && !dry) shw2_deferred(F, l);
            if (sub == 2) mix_lat_small(F, l);
        }
#if !MK_PER_PHASE
        if (threadIdx.x == 0) MISC[11] = (LOCAL_BAR && MISC[20] != 0u && ph >= SL_L0 && ph < SL_FINAL && (ph - SL_L0) % SL_PER_L <= 1) ? 1u : 0u;
        if (threadIdx.x == 0) MISC[10] = (MISC[20] != 0u && ph >= SL_L0 && ph + 1 < SL_FINAL) ? 1u : 0u;
        if (ph + 1 < hi || rep + 1 < reps) xcd_barrier(bar);
        if (ph == SL_P0A && rep == 0) {
            int bad = 0; int tq_ = threadIdx.x; asm volatile("" : "+v"(tq_));
            if (F.G != 256) bad = 1;
            else if (tq_ < 256) { gu32* cc = (gu32*)(F.ws + WS_CTL); const unsigned v = __hip_atomic_load(cc + CW_XCC + tq_, RLX_AGENT), h = __hip_atomic_load(cc + CW_XCC + (tq_ & ~31), RLX_AGENT); bad = (v == 0u || v != h); }
            const bool wbad = __ballot(bad) != 0ull;
            if ((tq_ & 63) == 0) MISC[24 + (tq_ >> 6)] = wbad ? 1u : 0u;
            __syncthreads();
            if (tq_ == 0) { unsigned a = 0u;
#pragma unroll
                for (int w8 = 0; w8 < 8; ++w8) a |= MISC[24 + w8];
                MISC[20] = a ? 0u : 1u; }
            __syncthreads();
        }
        if (PROBE_PHASE == 20 && ph >= SL_L0 && ph < SL_FINAL) { for (int r2 = 0; r2 < PROBE_REP; ++r2) xcd_barrier(bar); }
#endif
      }
    }
}

extern "C" void kernel_launch(void* const* d_in, const int* in_sizes, int n_in, void* d_out, int out_size, void* d_ws, size_t ws_size, hipStream_t stream) {
    static int grid = 0;
    if (grid == 0) {
        if (n_in != 24 || out_size != (int)OUT_END || ws_size < WS_END) { fprintf(stderr, "kernel_launch: unexpected shapes: n_in %d out %d ws %zu (need %zu)\n", n_in, out_size, ws_size, (size_t)WS_END); grid = -1; return; }
        int dev = 0, cus = 0, per_cu = 0;
        if (hipGetDevice(&dev) != hipSuccess || hipDeviceGetAttribute(&cus, hipDeviceAttributeMultiprocessorCount, dev) != hipSuccess) { grid = -1; return; }
        if (hipFuncSetAttribute((const void*)mega_fwd, hipFuncAttributeMaxDynamicSharedMemorySize, LDS_BYTES) != hipSuccess) { fprintf(stderr, "kernel_launch: hipFuncSetAttribute failed\n"); grid = -1; return; }
        if (hipOccupancyMaxActiveBlocksPerMultiprocessor(&per_cu, (const void*)mega_fwd, 512, LDS_BYTES) != hipSuccess || per_cu < 1) { fprintf(stderr, "kernel_launch: occupancy query says %d\n", per_cu); per_cu = 1; }
        (void)hipGetLastError();
        grid = cus;
    }
    if (grid < 0) return;
    (void)hipMemsetAsync((char*)d_ws + WS_CTL, 0, CTL_ZERO_BYTES, stream);
    Args a{};
    for (int i = 0; i < 24; ++i) a.in[i] = (const float*)d_in[i];
    a.out = (float*)d_out; a.ws = (unsigned char*)d_ws;
#if MK_PER_PHASE
    for (int ph = 0; ph < N_PHASES; ++ph) { a.ph_lo = ph; a.ph_hi = ph + 1; hipLaunchKernelGGL(mega_fwd, dim3(grid), dim3(512), LDS_BYTES, stream, a); }
#else
    a.ph_lo = 0; a.ph_hi = N_PHASES; hipLaunchKernelGGL(mega_fwd, dim3(grid), dim3(512), LDS_BYTES, stream, a);
#endif
    const hipError_t le = hipPeekAtLastError();
    if (le != hipSuccess) fprintf(stderr, "kernel_launch: launch failed: %s\n", hipGetErrorName(le));
}
```

```cpp
#include <hip/hip_runtime.h>
#include <cstdio>
#include <cstdint>

#define LAS __attribute__((address_space(3)))
#if defined(__HIP_DEVICE_COMPILE__)
#define GAS __attribute__((address_space(1)))
#else
#define GAS
#endif
typedef unsigned short bf16_t;
typedef short bf16x8 __attribute__((ext_vector_type(8)));
typedef short s16x4 __attribute__((ext_vector_type(4)));
typedef float f32x2 __attribute__((ext_vector_type(2)));
typedef float f32x4 __attribute__((ext_vector_type(4)));
typedef float f32x16 __attribute__((ext_vector_type(16)));
typedef unsigned u32x4 __attribute__((ext_vector_type(4)));
typedef unsigned u32x2 __attribute__((ext_vector_type(2)));
typedef GAS unsigned gu32;

#ifndef PROBE_PHASE
#define PROBE_PHASE -1
#endif
#ifndef PROBE_REP
#define PROBE_REP 0
#endif
#ifndef PROBE_FLUSH
#define PROBE_FLUSH 0
#endif
#ifndef MK_PER_PHASE
#define MK_PER_PHASE 0
#endif
#define FUSE_FINAL (!MK_PER_PHASE)
#ifndef LOCAL_BAR
#define LOCAL_BAR 1
#endif
#ifndef DEFER_FF
#define DEFER_FF 1
#endif

constexpr int DM = 1024, DEPTH = 4, NCTXB = 16, LCTX = 256, NLATB = 8, LLAT = 2048, PAST = 256;
constexpr int NCTX = NCTXB * LCTX  , NLAT = NLATB * LLAT  , MROWS = NCTX + NLAT  ;
constexpr int NSLOT = 9, MODW = 6 * DM;
constexpr int INW = 1472, INP = 1536, QRANK = 384, KVRANK = 256, QW = 768, KVW = 1024, DFF = 4096, NH = 4;
constexpr int LKEY = PAST + LLAT  ;
constexpr float EPS = 1e-6f;
constexpr float C2 = 0.07216878364870322f * 1.4426950408889634f;
constexpr int NTM = MROWS / 256;

constexpr size_t OUT_X = 0, OUT_CKV = (size_t)MROWS * DM, OUT_KR = OUT_CKV + (size_t)NCTXB * DEPTH * LCTX * KVRANK, OUT_END = OUT_KR + (size_t)NCTXB * DEPTH * LCTX * 64;

constexpr size_t al256(size_t x) { return (x + 255) / 256 * 256; }
constexpr size_t WS_CTL = 0, CTL_ZERO_BYTES = 1u << 20;
constexpr size_t WS_SH1 = CTL_ZERO_BYTES;
constexpr size_t MODV = al256((size_t)DEPTH * NSLOT * DM * 4);
constexpr size_t WS_GM1 = WS_SH1 + MODV, WS_G1 = WS_GM1 + MODV, WS_SH2 = WS_G1 + MODV, WS_GM2 = WS_SH2 + MODV, WS_G2 = WS_GM2 + MODV;
constexpr size_t WS_SHW1 = WS_G2 + MODV;
constexpr size_t WS_SHW2 = WS_SHW1 + al256((size_t)DEPTH * NSLOT * INP * 4);
constexpr size_t WS_ROPE = WS_SHW2 + al256((size_t)DEPTH * NSLOT * DFF * 4);
constexpr size_t WS_ST1 = WS_ROPE + al256(64 * 16 * 8);
constexpr size_t WS_ST2 = WS_ST1 + al256((size_t)MROWS * 16 * 4);
constexpr size_t WS_STQ = WS_ST2 + al256((size_t)MROWS * 16 * 4);
constexpr size_t WS_STKV = WS_STQ + al256((size_t)MROWS * 8 * 4);
constexpr size_t WS_STG = WS_STKV + al256((size_t)MROWS * 4 * 4);
constexpr size_t WS_WIN = WS_STG + al256((size_t)MROWS * 4 * 4);
constexpr size_t WS_WUQ = WS_WIN + al256((size_t)DEPTH * INP * DM * 2);
constexpr size_t WS_WKVF = WS_WUQ + al256((size_t)DEPTH * QW * QRANK * 2);
constexpr size_t WS_WKVC = WS_WKVF + al256((size_t)DEPTH * KVW * KVRANK * 2);
constexpr size_t WS_WOUT = WS_WKVC + al256((size_t)DEPTH * KVW * KVRANK * 2);
constexpr size_t WS_WF1 = WS_WOUT + al256((size_t)DEPTH * DM * DM * 2);
constexpr size_t WS_WF2 = WS_WF1 + al256((size_t)DEPTH * DFF * DM * 2);
constexpr size_t WS_WPT = WS_WF2 + al256((size_t)DEPTH * DM * DFF * 2);
constexpr size_t WS_WSB = WS_WPT + al256((size_t)DEPTH * 4 * 64 * 64 * 2);
constexpr size_t WS_CCKV = WS_WSB + al256((size_t)DEPTH * 4 * 128 * 128 * 2);
constexpr size_t WS_XG = WS_CCKV + al256((size_t)DEPTH * NLATB * PAST * KVRANK * 2);
constexpr size_t cmax(size_t a, size_t b) { return a > b ? a : b; }
constexpr size_t LB(size_t base, size_t w) { return base - (size_t)NCTX * w * 2; }
constexpr size_t WS_XB = WS_XG + al256((size_t)MROWS * DM * 2);
constexpr size_t WS_RC = WS_XB + al256((size_t)MROWS * DM * 2);
constexpr size_t HP_C = WS_RC, CKVR_C = HP_C + (size_t)NCTX * 256 * 2, U_C = CKVR_C + (size_t)NCTX * 256 * 2, GL_C = U_C + (size_t)NCTX * 256 * 2;
constexpr size_t CQ_C = GL_C + (size_t)NCTX * 256 * 2, Q_C = CQ_C + (size_t)NCTX * QRANK * 2, WS_KC = Q_C + (size_t)NCTX * QW * 2;
constexpr size_t WS_VC = WS_KC + (size_t)NCTXB * NH * LCTX * 192 * 2, YCAT_C = WS_VC + (size_t)NCTXB * NH * LCTX * 128 * 2;
constexpr size_t HID_C = WS_RC;
constexpr size_t WS_RL = al256(cmax(YCAT_C + (size_t)NCTX * DM * 2, HID_C + (size_t)NCTX * DFF * 2));
constexpr size_t HP_L0 = WS_RL, CKVR_L0 = HP_L0 + (size_t)NLAT * 256 * 2, U_L0 = CKVR_L0 + (size_t)NLAT * 256 * 2, GL_L0 = U_L0 + (size_t)NLAT * 256 * 2;
constexpr size_t CQ_L0 = GL_L0 + (size_t)NLAT * 256 * 2, Q_L0 = CQ_L0 + (size_t)NLAT * QRANK * 2, WS_KL = Q_L0 + (size_t)NLAT * QW * 2;
constexpr size_t WS_VL = WS_KL + (size_t)NLATB * NH * LKEY * 192 * 2;
constexpr size_t HID_L0 = WS_RL;
constexpr size_t YCAT_L0 = al256(cmax(WS_VL + (size_t)NLATB * NH * LKEY * 128 * 2, HID_L0 + (size_t)NLAT * DFF * 2));
constexpr size_t WS_MODP = WS_RL;
constexpr size_t HP_L = LB(HP_L0, 256), CKVR_L = LB(CKVR_L0, 256), U_L = LB(U_L0, 256), GL_L = LB(GL_L0, 256), CQ_L = LB(CQ_L0, QRANK), Q_L = LB(Q_L0, QW), YCAT_L = LB(YCAT_L0, DM), HID_L = LB(HID_L0, DFF);
constexpr size_t WS_OVL = WS_RC;
constexpr size_t WS_END = al256(cmax(YCAT_L0 + (size_t)NLAT * DM * 2, HID_L0 + (size_t)NLAT * DFF * 2));
#define SPLIT(isctx, NAME) ((isctx) ? NAME##_C : NAME##_L)

constexpr int CW_BAR = 4096;
constexpr int CW_FIN = 16384;
constexpr int CW_XCC = 8192;

constexpr int RING_BYTES = 131072, MISC_OFF = RING_BYTES + 320, LDS_BYTES = 147456;

#define RLX_AGENT __ATOMIC_RELAXED, __HIP_MEMORY_SCOPE_AGENT
#define LDS_WAIT() asm volatile("s_waitcnt lgkmcnt(0)" ::: "memory")
#define VM_WAIT() asm volatile("s_waitcnt vmcnt(0)" ::: "memory")
#define SBAR() __builtin_amdgcn_sched_barrier(0)
__device__ __forceinline__ unsigned cvt_pk_bf16(float lo, float hi) { unsigned r; asm volatile("v_cvt_pk_bf16_f32 %0, %1, %2" : "=v"(r) : "v"(lo), "v"(hi)); return r; }
__device__ __forceinline__ float bf_lo(unsigned w) { return __uint_as_float(w << 16); }
__device__ __forceinline__ float bf_hi(unsigned w) { return __uint_as_float(w & 0xffff0000u); }
__device__ __forceinline__ float bf1(bf16_t h) { return __uint_as_float(((unsigned)h) << 16); }
__device__ __forceinline__ bf16_t f2bf(float f) { return (bf16_t)(cvt_pk_bf16(f, 0.f) & 0xffffu); }
__device__ __forceinline__ float fast_rsqrt(float x) { return __builtin_amdgcn_rsqf(x); }
__device__ __forceinline__ float gelu_tanh(float x) {
    const float z = x * (1.0f + 0.044715f * x * x);
    const float e = __builtin_amdgcn_exp2f(z * (-2.0f * 0.7978845608028654f * 1.4426950408889634f));
    return x * __builtin_amdgcn_rcpf(1.0f + e);
}
__device__ __forceinline__ float wave_sum(float v) {
#pragma unroll
    for (int o = 1; o < 64; o <<= 1) v += __shfl_xor(v, o);
    return v;
}
__device__ __forceinline__ float fq_sum(float q) {
    { auto r = __builtin_amdgcn_permlane16_swap(__float_as_uint(q), __float_as_uint(q), false, false); q = __uint_as_float(r[0]) + __uint_as_float(r[1]); }
    { auto r = __builtin_amdgcn_permlane32_swap(__float_as_uint(q), __float_as_uint(q), false, false); q = __uint_as_float(r[0]) + __uint_as_float(r[1]); }
    return q;
}
__device__ __forceinline__ int tid_now() { int t = threadIdx.x; asm volatile("" : "+v"(t)); return t; }
__device__ __forceinline__ int lane_now() { return tid_now() & 63; }
__device__ __forceinline__ int slot_of_tile(int pm) { return pm < 16 ? 0 : 1 + ((pm - 16) >> 3); }

#define XB_TMO      128
#define XB_XCNT(j)  (256  + 64 * (j))
#define XB_XSUB(j)  (1280 + 64 * (j))
#define XB_XGEN(j)  (2304 + 64 * (j))
#define XB_TOP      3328
#define XB_TOPGEN   3392
#define XCD_BAR_WORDS 3456
#define XB_ARR(j)   (16384 + 64 * (j))
#define XB_SPIN_CAP (1u << 18)
__device__ __forceinline__ unsigned xb_ld(unsigned* p)              { return __hip_atomic_load(p, __ATOMIC_RELAXED, __HIP_MEMORY_SCOPE_AGENT); }
__device__ __forceinline__ unsigned xb_add(unsigned* p, unsigned v) { return __hip_atomic_fetch_add(p, v, __ATOMIC_RELAXED, __HIP_MEMORY_SCOPE_AGENT); }
__device__ __forceinline__ unsigned xb_xcc_id() { return (unsigned)__builtin_amdgcn_s_getreg((3 << 11) | 20) & 0xFu; }
#define XB_SPIN(cond, bar) do { unsigned _sp = 0; while (cond) { __builtin_amdgcn_s_sleep(1); \
    if ((++_sp & 255u) == 0u) { if (xb_ld(&(bar)[XB_TMO])) break; if (_sp > XB_SPIN_CAP) { atomicAdd(&(bar)[XB_TMO], 1u); break; } } } } while (0)
struct XcdBarrier { unsigned* bar; unsigned x; volatile LAS unsigned* st; };
__device__ __forceinline__ XcdBarrier xcd_barrier_post(unsigned* bar, volatile LAS unsigned* st) {
    XcdBarrier b; b.bar = bar; b.x = xb_xcc_id(); b.st = st;
    if (threadIdx.x == 0) (void)xb_add(&bar[XB_XCNT(b.x)], 1u);
    return b;
}
__device__ __forceinline__ void xcd_barrier_complete(unsigned* bar, unsigned x, unsigned& nloc, unsigned& nx, unsigned& mask) {
    const unsigned G = gridDim.x * gridDim.y * gridDim.z;
    unsigned sum, cnt, mine, sp = 0u;
    for (;;) {
        sum = 0u; cnt = 0u; mine = 0u; mask = 0u;
#pragma unroll
        for (unsigned j = 0; j < 16; ++j) { const unsigned c = xb_ld(&bar[XB_XCNT(j)]); sum += c; cnt += (c > 0u) ? 1u : 0u; mask |= (c > 0u) ? (1u << j) : 0u; mine = (j == x) ? c : mine; }
        if (sum == G) break;
        __builtin_amdgcn_s_sleep(1);
        if ((++sp & 255u) == 0u) { if (xb_ld(&bar[XB_TMO])) break; if (sp > XB_SPIN_CAP) { atomicAdd(&bar[XB_TMO], 1u); break; } }
    }
    nloc = mine > 0u ? mine : 1u; nx = cnt > 0u ? cnt : 1u;
}
__device__ __forceinline__ void xcd_barrier(const XcdBarrier& b) {
    asm volatile("s_waitcnt vmcnt(0)" ::: "memory");
    __syncthreads();
    if (threadIdx.x == 0) {
        unsigned* bar = b.bar;
        __builtin_amdgcn_s_waitcnt(0);
        const bool fast = (b.st[2] != 0u) || (b.st[3] != 0u);
        if (fast) asm volatile("buffer_inv sc1" ::: "memory");
        unsigned nloc = b.st[0], nx = b.st[1];
        if (nloc == 0u) { unsigned mk = 0u; xcd_barrier_complete(bar, b.x, nloc, nx, mk); b.st[0] = nloc; b.st[1] = nx; b.st[4] = mk; }
        const unsigned old = xb_add(&bar[XB_XSUB(b.x)], 1u);
        const unsigned gen = old / nloc;
        if (old + 1u == (gen + 1u) * nloc && b.st[3] != 0u) {
            asm volatile("s_waitcnt vmcnt(0)" ::: "memory");
            if (!fast) __builtin_amdgcn_fence(__ATOMIC_ACQUIRE, "agent");
            xb_add(&bar[XB_XGEN(b.x)], 1u);
            asm volatile("s_waitcnt vmcnt(0)" ::: "memory");
        } else if (old + 1u == (gen + 1u) * nloc) {
            if (b.st[2] == 0u) __builtin_amdgcn_fence(__ATOMIC_RELEASE, "agent");
            asm volatile("s_waitcnt vmcnt(0)" ::: "memory");
            const unsigned mk = b.st[4];
#pragma unroll
            for (unsigned j = 0; j < 16; ++j) if ((mk >> j) & 1u) __hip_atomic_fetch_add(&bar[XB_ARR(j)], 1u, __ATOMIC_RELAXED, __HIP_MEMORY_SCOPE_AGENT);
            { const unsigned tgt = nx * (b.st[7] + 1u); XB_SPIN(xb_ld(&bar[XB_ARR(b.x)]) < tgt, bar); }
            if (!fast) __builtin_amdgcn_fence(__ATOMIC_ACQUIRE, "agent");
            asm volatile("s_waitcnt vmcnt(0)" ::: "memory");
        } else if (b.st[3] != 0u) {
            { const unsigned lg = b.st[8]; XB_SPIN(xb_ld(&bar[XB_XGEN(b.x)]) == lg, bar); }
            if (!fast) __builtin_amdgcn_fence(__ATOMIC_ACQUIRE, "agent");
            asm volatile("s_waitcnt vmcnt(0)" ::: "memory");
        } else {
            { const unsigned tgt = nx * (b.st[7] + 1u); XB_SPIN(xb_ld(&bar[XB_ARR(b.x)]) < tgt, bar); }
            if (!fast) __builtin_amdgcn_fence(__ATOMIC_ACQUIRE, "agent");
            asm volatile("s_waitcnt vmcnt(0)" ::: "memory");
        }
        if (b.st[3] != 0u) b.st[8] = b.st[8] + 1u; else b.st[7] = b.st[7] + 1u;
    }
    __syncthreads();
}

struct Args { const float* in[24]; float* out; unsigned char* ws; int ph_lo, ph_hi; };

struct Ctx {
    const Args* a; GAS float* out; GAS unsigned char* ws;
    LAS unsigned char* lds;
    int tid, lane, wave, G, vcu;
};
template <class T> __device__ __forceinline__ GAS T* wsp(const Ctx& F, size_t off) { return (GAS T*)(F.ws + off); }
#define GIN(k) ((const GAS float*)F.a->in[k])

constexpr int BK = 64, HALF = 128, HTB = HALF * BK * 2;
__host__ __device__ __forceinline__ int lds_byte(int r, int c) { const int st = (r >> 4) * 2 + (c >> 5), rr = r & 15, cc = c & 31, ob = rr * 64 + cc * 2; return st * 1024 + (ob ^ (((ob >> 9) & 1) << 5)); }
__host__ __device__ __forceinline__ void stage_rc(int b, int& R, int& C) { const int st = b / 1024, sb = b % 1024, swz = sb ^ (((sb >> 9) & 1) << 5); R = (st >> 1) * 16 + swz / 64; C = (st & 1) * 32 + (swz % 64) / 2; }
__host__ __device__ __forceinline__ int perm32(int rho) { const int n = rho >> 4, i = rho & 15; return 8 * (i >> 2) + 4 * n + (i & 3); }

struct GUnit { unsigned A, B; int K, pm, pn, kind, l; };
__device__ __forceinline__ void map_unit(int L, int nM, int nN, int& pm, int& pn) {
    const int nwg = nM * nN; int wgid = L;
    { const int q = nwg / 8, r = nwg % 8, xcd = wgid % 8, off = wgid / 8; wgid = (xcd < r ? xcd * (q + 1) : r * (q + 1) + (xcd - r) * q) + off; }
    const int nig = 8 * nN, gid = wgid / nig, fm = gid * 8, gsz = (nM - fm) < 8 ? (nM - fm) : 8;
    pm = fm + ((wgid % nig) % gsz); pn = (wgid % nig) / gsz;
}

typedef f32x4 Acc[2][2][4][2];

template <class Sched, class Epi>
__device__ __forceinline__ void gemm_phase(LAS unsigned char* lds, const Sched& S, const Epi& E) {
    int tid_ = threadIdx.x; asm volatile("" : "+v"(tid_));
    const int tid = tid_, wid = __builtin_amdgcn_readfirstlane(tid >> 6), lane = tid & 63, wr = wid >> 2, wc = wid & 3, fr = lane & 15, fq = lane >> 4;
    int sR[2], sRb[2], sC[2];
#define PG8_LANECONST(t_) do { _Pragma("unroll") for (int i = 0; i < 2; ++i) { int R, C; stage_rc((t_) * 16 + i * 8192, R, C); sR[i] = R; sRb[i] = (R & ~31) + perm32(R & 31); sC[i] = C; } } while (0)
    PG8_LANECONST(tid);
    const unsigned kstep = (unsigned)(BK * 2);
    const GAS unsigned char* gws = S.ws;
    const unsigned ldsw = (unsigned)wid * 1024u;
    int aoff = lds_byte(wr * 64 + fr, fq * 8), boff = lds_byte(wc * 32 + fr, fq * 8);
#define PG8_SA(b, h) (((b) * 2 + (h)) * HTB)
#define PG8_SB(b, h) ((4 + (b) * 2 + (h)) * HTB)
#define PG8_STAGE(bufoff, goff, v0, v1) do { \
        __builtin_amdgcn_global_load_lds((const GAS unsigned*)(gws + (size_t)((goff) + (v0))), (LAS unsigned*)(lds + (bufoff) + ldsw), 16, 0, 0); \
        __builtin_amdgcn_global_load_lds((const GAS unsigned*)(gws + (size_t)((goff) + (v1))), (LAS unsigned*)(lds + (bufoff) + ldsw + 8192), 16, 0, 0); } while (0)
#define PG8_LDA(dst, b, h) do { _Pragma("unroll") for (int m = 0; m < 4; ++m) _Pragma("unroll") for (int k = 0; k < 2; ++k) dst[m][k] = *(const LAS bf16x8*)(lds + PG8_SA(b, h) + aoff + m * 2048 + k * 1024); } while (0)
#define PG8_LDB(dst, b, h) do { _Pragma("unroll") for (int n = 0; n < 2; ++n) _Pragma("unroll") for (int k = 0; k < 2; ++k) dst[n][k] = *(const LAS bf16x8*)(lds + PG8_SB(b, h) + boff + n * 2048 + k * 1024); } while (0)
#define PG8_MMA(ai, bj, At, Bt) do { __builtin_amdgcn_s_setprio(1); _Pragma("unroll") for (int m = 0; m < 4; ++m) _Pragma("unroll") for (int n = 0; n < 2; ++n) _Pragma("unroll") for (int k = 0; k < 2; ++k) \
        acc[ai][bj][m][n] = __builtin_amdgcn_mfma_f32_16x16x32_bf16(Bt[n][k], At[m][k], acc[ai][bj][m][n], 0, 0, 0); __builtin_amdgcn_s_setprio(0); } while (0)
#define PG8_WAIT_V(n) asm volatile("s_waitcnt vmcnt(" #n ")" ::: "memory")
#define PG8_WAIT_L(n) asm volatile("s_waitcnt lgkmcnt(" #n ")" ::: "memory")
#define PG8_BAR __builtin_amdgcn_s_barrier()
#define PG8_SCHED __builtin_amdgcn_sched_barrier(0)
    GUnit cur, nxt; int ui = 0;
    if (!S.next(0, cur)) return;
    Acc acc;
#pragma unroll
    for (int a = 0; a < 2; ++a)
#pragma unroll
        for (int b = 0; b < 2; ++b)
#pragma unroll
            for (int m = 0; m < 4; ++m)
#pragma unroll
                for (int n = 0; n < 2; ++n) acc[a][b][m][n] = (f32x4){0.f, 0.f, 0.f, 0.f};
    bf16x8 At[4][2], B0[2][2], B1[2][2];
    unsigned vA0 = (unsigned)(sR[0] * cur.K + sC[0]) * 2u, vA1 = (unsigned)(sR[1] * cur.K + sC[1]) * 2u;
    unsigned vB0 = (unsigned)(sRb[0] * cur.K + sC[0]) * 2u, vB1 = (unsigned)(sRb[1] * cur.K + sC[1]) * 2u;
    unsigned hs = (unsigned)HALF * cur.K * 2;
    unsigned cA = cur.A, cB = cur.B;
    PG8_STAGE(PG8_SB(0, 0), cB, vB0, vB1); PG8_STAGE(PG8_SB(0, 1), cB + hs, vB0, vB1); PG8_STAGE(PG8_SA(0, 0), cA, vA0, vA1); PG8_STAGE(PG8_SA(0, 1), cA + hs, vA0, vA1);
    if (wr == 1) PG8_BAR;
    PG8_WAIT_V(2); PG8_BAR;
    PG8_STAGE(PG8_SB(1, 0), cB + kstep, vB0, vB1); PG8_STAGE(PG8_SA(1, 0), cA + kstep, vA0, vA1); PG8_STAGE(PG8_SB(1, 1), cB + hs + kstep, vB0, vB1);
    PG8_WAIT_V(6); PG8_BAR;
    for (;;) {
        { int tq = tid; asm volatile("" : "+v"(tq)); PG8_LANECONST(tq); const int fr_ = tq & 15, fq_ = (tq & 63) >> 4; aoff = lds_byte(wr * 64 + fr_, fq_ * 8); boff = lds_byte(wc * 32 + fr_, fq_ * 8);
          vA0 = (unsigned)(sR[0] * cur.K + sC[0]) * 2u; vA1 = (unsigned)(sR[1] * cur.K + sC[1]) * 2u; vB0 = (unsigned)(sRb[0] * cur.K + sC[0]) * 2u; vB1 = (unsigned)(sRb[1] * cur.K + sC[1]) * 2u; }
        const bool has_next = S.next(ui + 1, nxt);
        if (!has_next) nxt = cur;
        const unsigned nvA0 = (unsigned)(sR[0] * nxt.K + sC[0]) * 2u, nvA1 = (unsigned)(sR[1] * nxt.K + sC[1]) * 2u;
        const unsigned nvB0 = (unsigned)(sRb[0] * nxt.K + sC[0]) * 2u, nvB1 = (unsigned)(sRb[1] * nxt.K + sC[1]) * 2u;
        const unsigned nhs = (unsigned)HALF * nxt.K * 2;
        const unsigned nA = nxt.A, nB = nxt.B;
        const int nt = cur.K >> 6;
        for (int t = 0; t < nt; t += 2) {
            const bool last = (t == nt - 2);
            const unsigned a1 = cA + (unsigned)(t + 1) * kstep;
            const unsigned a2 = last ? nA : cA + (unsigned)(t + 2) * kstep, b2 = last ? nB : cB + (unsigned)(t + 2) * kstep;
            const unsigned a3 = a2 + kstep, b3 = b2 + kstep;
            const unsigned wA0 = last ? nvA0 : vA0, wA1 = last ? nvA1 : vA1, wB0 = last ? nvB0 : vB0, wB1 = last ? nvB1 : vB1;
            const unsigned hs2 = last ? nhs : hs;
            PG8_LDB(B0, 0, 0); PG8_LDB(B1, 0, 1); PG8_SCHED; PG8_LDA(At, 0, 0); PG8_STAGE(PG8_SA(1, 1), a1 + hs, vA0, vA1);
            PG8_WAIT_V(8); PG8_WAIT_L(0); PG8_BAR; PG8_MMA(0, 0, At, B0); PG8_MMA(0, 1, At, B1); PG8_BAR; PG8_SCHED;
            PG8_LDA(At, 0, 1); PG8_STAGE(PG8_SB(0, 0), b2, wB0, wB1); PG8_STAGE(PG8_SB(0, 1), b2 + hs2, wB0, wB1); PG8_STAGE(PG8_SA(0, 0), a2, wA0, wA1);
            PG8_WAIT_V(8); PG8_WAIT_L(0); PG8_BAR; PG8_MMA(1, 0, At, B0); PG8_MMA(1, 1, At, B1); PG8_BAR; PG8_SCHED;
            PG8_LDB(B0, 1, 0); PG8_LDB(B1, 1, 1); PG8_SCHED; PG8_LDA(At, 1, 0); PG8_STAGE(PG8_SA(0, 1), a2 + hs2, wA0, wA1);
            PG8_WAIT_V(8); PG8_WAIT_L(0); PG8_BAR; PG8_MMA(0, 0, At, B0); PG8_MMA(0, 1, At, B1); PG8_BAR; PG8_SCHED;
            PG8_LDA(At, 1, 1); PG8_STAGE(PG8_SB(1, 0), b3, wB0, wB1); PG8_STAGE(PG8_SB(1, 1), b3 + hs2, wB0, wB1); PG8_STAGE(PG8_SA(1, 0), a3, wA0, wA1);
            PG8_WAIT_V(8); PG8_WAIT_L(0); PG8_BAR; PG8_MMA(1, 0, At, B0); PG8_MMA(1, 1, At, B1); PG8_BAR; PG8_SCHED;
        }
        if (wr == 0) PG8_BAR;
        E(acc, cur, wr, wc, fr, fq, tid, (LAS float*)(lds + RING_BYTES + 2048));
        if (!has_next) break;
#pragma unroll
        for (int a = 0; a < 2; ++a)
#pragma unroll
            for (int b = 0; b < 2; ++b)
#pragma unroll
                for (int m = 0; m < 4; ++m)
#pragma unroll
                    for (int n = 0; n < 2; ++n) acc[a][b][m][n] = (f32x4){0.f, 0.f, 0.f, 0.f};
        cur = nxt; cA = nA; cB = nB; hs = nhs; ++ui;
        if (wr == 1) PG8_BAR;
    }
    PG8_WAIT_V(0);
    PG8_BAR;
#undef PG8_SA
#undef PG8_LANECONST
#undef PG8_SB
#undef PG8_STAGE
#undef PG8_LDA
#undef PG8_LDB
#undef PG8_MMA
#undef PG8_WAIT_V
#undef PG8_WAIT_L
#undef PG8_BAR
#undef PG8_SCHED
}

enum Kind { K_HP = 0, K_CKV = 1, K_U = 2, K_VG = 3, K_CQ0 = 4, K_CQ1 = 5, K_Q = 6, K_KV = 7, K_KVC = 8, K_OUT = 9, K_FF1 = 10, K_FF2 = 11 };

__device__ __forceinline__ u32x4 pack8(const f32x4 a, const f32x4 b) { u32x4 w; w.x = cvt_pk_bf16(a[0], a[1]); w.y = cvt_pk_bf16(a[2], a[3]); w.z = cvt_pk_bf16(b[0], b[1]); w.w = cvt_pk_bf16(b[2], b[3]); return w; }
__device__ __forceinline__ float sum4(const f32x4 v) { return (v[0] + v[1]) + (v[2] + v[3]); }
__device__ __forceinline__ float sq8(const f32x4 a, const f32x4 b) { return (a[0] * a[0] + a[1] * a[1]) + (a[2] * a[2] + a[3] * a[3]) + (b[0] * b[0] + b[1] * b[1]) + (b[2] * b[2] + b[3] * b[3]); }

struct Epi {
    GAS unsigned char* ws; GAS float* out; const GAS float* xp; const GAS float* xs;
    bool dry;

    __device__ __forceinline__ void operator()(Acc& acc, const GUnit& u, int wr, int wc, int fr, int fq, int tid, LAS float* tab) const {
        int rowb_ = u.pm * 256 + wr * 64 + fr, colw_ = wc * 32 + 8 * fq;
        asm volatile("" : "+v"(rowb_), "+v"(colw_));
        const int rowb = rowb_, colw = colw_, s = slot_of_tile(u.pm), l = u.l;
        const bool isctx = u.pm < 16;
        GAS float* xout = out + OUT_X;
        const GAS float* stin = nullptr;
        if (u.kind <= K_CQ1) stin = (const GAS float*)(ws + WS_ST1);
        else if (u.kind == K_Q) stin = (const GAS float*)(ws + WS_STQ);
        else if (u.kind == K_KV) stin = (const GAS float*)(ws + WS_STKV);
        else if (u.kind == K_FF1) stin = (const GAS float*)(ws + WS_ST2);
        const int tagv = ((u.kind <= K_CQ1 ? 0 : u.kind) << 20) | (l << 12) | (u.pm << 2) | 1;
        const bool fresh = stin && __builtin_amdgcn_readfirstlane(*(volatile LAS int*)(tab + 256)) != tagv;
        if (fresh) {
            int tq = tid; asm volatile("" : "+v"(tq));
            if (tq < 256) { const int row = u.pm * 256 + tq; float rs;
                if (u.kind == K_Q) { const GAS f32x4* sp = (const GAS f32x4*)(stin + (size_t)row * 8); rs = fast_rsqrt((sum4(sp[0]) + sum4(sp[1])) * (1.0f / QRANK) + EPS) * C2; }
                else if (u.kind == K_KV) { const f32x4 t0 = *(const GAS f32x4*)(stin + (size_t)row * 4); rs = fast_rsqrt(sum4(t0) * (1.0f / KVRANK) + EPS); }
                else { const GAS f32x4* sp = (const GAS f32x4*)(stin + (size_t)row * 16); rs = fast_rsqrt(((sum4(sp[0]) + sum4(sp[1])) + (sum4(sp[2]) + sum4(sp[3]))) * (1.0f / DM) + EPS); }
                tab[tq] = rs; }
            asm volatile("s_waitcnt lgkmcnt(0)" ::: "memory"); __builtin_amdgcn_s_barrier(); asm volatile("" ::: "memory");
            if (tq == 0) *(volatile LAS int*)(tab + 256) = tagv;
        }
        const int rl0 = wr * 64 + fr;
        switch (u.kind) {
        case K_HP: case K_CKV: case K_U: case K_VG: case K_CQ0: case K_CQ1: {
            const GAS float* shw = (const GAS float*)(ws + WS_SHW1) + (size_t)l * NSLOT * INP; const int ldshw = INP;
            const LAS f32x2* rope = (const LAS f32x2*)(tab + 512);
            f32x4 sw[2][2];
#pragma unroll
            for (int bj = 0; bj < 2; ++bj) { const float* p = shw + (size_t)s * ldshw + u.pn * 256 + bj * 128 + colw; sw[bj][0] = *(const f32x4*)p; sw[bj][1] = *(const f32x4*)(p + 4); }
            bf16_t* dst; int ldd, coff = 0; float* st = nullptr; int sto = 0, stw = 4;
            if (u.kind == K_HP) { dst = (bf16_t*)(ws + SPLIT(isctx, HP)); ldd = 256; }
            else if (u.kind == K_CKV) { dst = (bf16_t*)(ws + SPLIT(isctx, CKVR)); ldd = 256; st = (float*)(ws + WS_STKV); }
            else if (u.kind == K_U) { dst = (bf16_t*)(ws + SPLIT(isctx, U)); ldd = 256; }
            else if (u.kind == K_VG) { dst = (bf16_t*)(ws + SPLIT(isctx, GL)); ldd = 256; st = (float*)(ws + WS_STG); }
            else if (u.kind == K_CQ0) { dst = (bf16_t*)(ws + SPLIT(isctx, CQ)); ldd = QRANK; st = (float*)(ws + WS_STQ); stw = 8; }
            else { dst = (bf16_t*)(ws + SPLIT(isctx, CQ)); ldd = QRANK; coff = 256; st = (float*)(ws + WS_STQ); stw = 8; sto = 4; }
            const bool act = (u.kind == K_U || u.kind == K_VG);
#pragma unroll
            for (int ai = 0; ai < 2; ++ai)
#pragma unroll
                for (int m = 0; m < 4; ++m) {
                    asm volatile("" ::: "memory");
                    const int row = rowb + ai * 128 + m * 16;
                    const float rs = tab[rl0 + ai * 128 + m * 16];
                    f32x4 v[2][2];
#pragma unroll
                    for (int bj = 0; bj < 2; ++bj)
#pragma unroll
                        for (int n = 0; n < 2; ++n) { v[bj][n] = acc[ai][bj][m][n] * rs + sw[bj][n];
                            if (act) {
#pragma unroll
                                for (int j = 0; j < 4; ++j) v[bj][n][j] = gelu_tanh(v[bj][n][j]); } }
                    if (u.kind != K_CQ1) {
                        *(u32x4*)(dst + (size_t)row * ldd + coff + colw) = pack8(v[0][0], v[0][1]);
                        *(u32x4*)(dst + (size_t)row * ldd + coff + 128 + colw) = pack8(v[1][0], v[1][1]);
                        if (st) { float q = sq8(v[0][0], v[0][1]) + sq8(v[1][0], v[1][1]); q = fq_sum(q); if (fq == 0) st[(size_t)row * stw + sto + wc] = q; }
                        if (u.kind == K_CKV && isctx) {
                            float* o = out + OUT_CKV + ((size_t)(u.pm * DEPTH + l) * LCTX + (row & 255)) * KVRANK + colw;
                            *(f32x4*)o = v[0][0]; *(f32x4*)(o + 4) = v[0][1]; *(f32x4*)(o + 128) = v[1][0]; *(f32x4*)(o + 132) = v[1][1];
                        }
                    } else {
                        *(u32x4*)(dst + (size_t)row * ldd + coff + colw) = pack8(v[0][0], v[0][1]);
                        { float q = sq8(v[0][0], v[0][1]); q = fq_sum(q); if (fq == 0) st[(size_t)row * stw + sto + wc] = q; }
                        if (wc < 2) {
                            const int p0 = colw, i0 = p0 >> 1, t = row & 255;
                            float x[8] = {v[1][0][0], v[1][0][1], v[1][0][2], v[1][0][3], v[1][1][0], v[1][1][1], v[1][1][2], v[1][1][3]};
                            if (isctx) {
                                float* o = out + OUT_KR + ((size_t)(u.pm * DEPTH + l) * LCTX + t) * 64;
#pragma unroll
                                for (int j = 0; j < 4; ++j) { o[i0 + j] = x[2 * j]; o[32 + i0 + j] = x[2 * j + 1]; }
                                u32x4 w; w.x = cvt_pk_bf16(x[0], x[1]); w.y = cvt_pk_bf16(x[2], x[3]); w.z = cvt_pk_bf16(x[4], x[5]); w.w = cvt_pk_bf16(x[6], x[7]);
                                bf16_t* kd = (bf16_t*)(ws + WS_KC) + ((size_t)(u.pm * NH) * LCTX + t) * 192 + 128 + p0;
#pragma unroll
                                for (int h = 0; h < NH; ++h) *(u32x4*)(kd + (size_t)h * LCTX * 192) = w;
                            } else {
                                const int b = (u.pm - 16) >> 3, tl = ((u.pm - 16) & 7) * 256 + t;
                                const int pos = (wc == 0) ? (tl >> 6) : (tl & 63);
                                float y[8];
#pragma unroll
                                for (int j = 0; j < 4; ++j) { const f32x2 cs = rope[pos * 16 + ((i0 + j) & 15)]; y[2 * j] = x[2 * j] * cs.x - x[2 * j + 1] * cs.y; y[2 * j + 1] = x[2 * j + 1] * cs.x + x[2 * j] * cs.y; }
                                u32x4 w; w.x = cvt_pk_bf16(y[0], y[1]); w.y = cvt_pk_bf16(y[2], y[3]); w.z = cvt_pk_bf16(y[4], y[5]); w.w = cvt_pk_bf16(y[6], y[7]);
                                bf16_t* kd = (bf16_t*)(ws + WS_KL) + ((size_t)(b * NH) * LKEY + PAST + tl) * 192 + 128 + p0;
#pragma unroll
                                for (int h = 0; h < NH; ++h) *(u32x4*)(kd + (size_t)h * LKEY * 192) = w;
                            }
                        }
                    }
                }
        } break;
        case K_Q: {
            const LAS f32x2* rope = (const LAS f32x2*)(tab + 512);
            bf16_t* dst = (bf16_t*)(ws + SPLIT(isctx, Q));
#pragma unroll
            for (int ai = 0; ai < 2; ++ai)
#pragma unroll
                for (int m = 0; m < 4; ++m) {
                    asm volatile("" ::: "memory");
                    const int row = rowb + ai * 128 + m * 16;
                    const float rs = tab[rl0 + ai * 128 + m * 16];
#pragma unroll
                    for (int bj = 0; bj < 2; ++bj) {
                        const int c = u.pn * 256 + bj * 128 + colw, w192 = c % 192;
                        f32x4 v0 = acc[ai][bj][m][0] * rs, v1 = acc[ai][bj][m][1] * rs;
                        if (!isctx && w192 >= 128) {
                            const int i0 = (w192 - 128) >> 1, tl = ((u.pm - 16) & 7) * 256 + (row & 255);
                            const int pos = (i0 < 16) ? (tl >> 6) : (tl & 63);
                            float x[8] = {v0[0], v0[1], v0[2], v0[3], v1[0], v1[1], v1[2], v1[3]}, y[8];
#pragma unroll
                            for (int j = 0; j < 4; ++j) { const f32x2 cs = rope[pos * 16 + ((i0 + j) & 15)]; y[2 * j] = x[2 * j] * cs.x - x[2 * j + 1] * cs.y; y[2 * j + 1] = x[2 * j + 1] * cs.x + x[2 * j] * cs.y; }
                            v0 = (f32x4){y[0], y[1], y[2], y[3]}; v1 = (f32x4){y[4], y[5], y[6], y[7]};
                        }
                        *(u32x4*)(dst + (size_t)row * QW + c) = pack8(v0, v1);
                    }
                }
        } break;
        case K_KV: case K_KVC: {
            const int h = u.pn;
            bf16_t *kd, *vd; int ldrow;
            if (u.kind == K_KVC) { kd = (bf16_t*)(ws + WS_KL) + ((size_t)(u.pm * NH + h) * LKEY) * 192; vd = (bf16_t*)(ws + WS_VL) + ((size_t)(u.pm * NH + h) * LKEY) * 128; }
            else if (isctx) { kd = (bf16_t*)(ws + WS_KC) + ((size_t)(u.pm * NH + h) * LCTX) * 192; vd = (bf16_t*)(ws + WS_VC) + ((size_t)(u.pm * NH + h) * LCTX) * 128; }
            else { const int b = (u.pm - 16) >> 3, k0 = PAST + ((u.pm - 16) & 7) * 256; kd = (bf16_t*)(ws + WS_KL) + ((size_t)(b * NH + h) * LKEY + k0) * 192; vd = (bf16_t*)(ws + WS_VL) + ((size_t)(b * NH + h) * LKEY + k0) * 128; }
            (void)ldrow;
#pragma unroll
            for (int ai = 0; ai < 2; ++ai)
#pragma unroll
                for (int m = 0; m < 4; ++m) {
                    asm volatile("" ::: "memory");
                    const int row = rowb + ai * 128 + m * 16, rl = row & 255;
                    float rs = 1.0f;
                    if (u.kind == K_KV) rs = tab[rl0 + ai * 128 + m * 16];
                    *(u32x4*)(kd + (size_t)rl * 192 + colw) = pack8(acc[ai][0][m][0] * rs, acc[ai][0][m][1] * rs);
                    *(u32x4*)(vd + (size_t)rl * 128 + colw) = pack8(acc[ai][1][m][0] * rs, acc[ai][1][m][1] * rs);
                }
        } break;
        case K_OUT: case K_FF2: {
            const GAS float *gate, *gmn; GAS float* stout;
            if (u.kind == K_OUT) { gate = (const GAS float*)(ws + WS_G1) + (size_t)l * NSLOT * DM; gmn = (const GAS float*)(ws + WS_GM2) + (size_t)l * NSLOT * DM; stout = (GAS float*)(ws + WS_ST2); }
            else { gate = (const GAS float*)(ws + WS_G2) + (size_t)l * NSLOT * DM; gmn = (l + 1 < DEPTH) ? (const GAS float*)(ws + WS_GM1) + (size_t)(l + 1) * NSLOT * DM : nullptr; stout = (GAS float*)(ws + WS_ST1); }
            const bool in32 = (u.kind == K_OUT && l == 0);
            const GAS float* xin = isctx ? xp : xs - (size_t)NCTX * DM;
            GAS bf16_t* xb = (GAS bf16_t*)(ws + WS_XB);
            bf16_t* xg = (bf16_t*)(ws + WS_XG);
            const unsigned cb = (unsigned)(u.pn * 256 + colw);
            const float* gp = gate + (size_t)s * DM + cb; const float* mp_ = gmn ? gmn + (size_t)s * DM + cb : gp;
            if (!in32) {
                GAS unsigned char* const XBB = (GAS unsigned char*)xb; GAS unsigned char* const XGB = (GAS unsigned char*)xg;
                float qa[8];
#pragma unroll
                for (int bj = 0; bj < 2; ++bj) {
                    asm volatile("" ::: "memory");
                    const f32x4 gtA = *(const f32x4*)(gp + bj * 128), gtB = *(const f32x4*)(gp + bj * 128 + 4), gmA = *(const f32x4*)(mp_ + bj * 128), gmB = *(const f32x4*)(mp_ + bj * 128 + 4);
                    u32x4 rb[8];
#pragma unroll
                    for (int r = 0; r < 8; ++r) { const unsigned eb = ((unsigned)(rowb + (r >> 2) * 128 + (r & 3) * 16) * (unsigned)DM + cb + (unsigned)(bj * 128)) * 2u; rb[r] = *(const GAS u32x4*)(XBB + eb); }
                    asm volatile("" ::: "memory");
#pragma unroll
                    for (int r = 0; r < 8; ++r) { const int ai = r >> 2, m = r & 3; const unsigned eb = ((unsigned)(rowb + ai * 128 + m * 16) * (unsigned)DM + cb + (unsigned)(bj * 128)) * 2u;
                        const u32x4 b = rb[r];
                        const f32x4 x0 = (f32x4){bf_lo(b.x), bf_hi(b.x), bf_lo(b.y), bf_hi(b.y)} + gtA * acc[ai][bj][m][0], x1 = (f32x4){bf_lo(b.z), bf_hi(b.z), bf_lo(b.w), bf_hi(b.w)} + gtB * acc[ai][bj][m][1];
                        if (!dry) *(GAS u32x4*)(XBB + eb) = pack8(x0, x1);
                        if (gmn && !dry) *(GAS u32x4*)(XGB + eb) = pack8(x0 * gmA, x1 * gmB);
                        float q_ = sq8(x0, x1); asm volatile("" : "+v"(q_));
                        if (bj == 0) qa[r] = q_;
                        else { const float q = fq_sum(qa[r] + q_); if (fq == 0 && !dry) stout[(size_t)(rowb + ai * 128 + m * 16) * 16 + u.pn * 4 + wc] = q; }
                        asm volatile("" ::: "memory"); }
                }
            } else {
            const f32x4 gt00 = *(const f32x4*)gp, gt01 = *(const f32x4*)(gp + 4), gt10 = *(const f32x4*)(gp + 128), gt11 = *(const f32x4*)(gp + 132);
#pragma unroll
            for (int ai = 0; ai < 2; ++ai)
#pragma unroll
                for (int mp = 0; mp < 2; ++mp) {
                    asm volatile("" ::: "memory");
                    const unsigned e0 = (unsigned)(rowb + ai * 128 + (2 * mp) * 16) * (unsigned)DM + cb, e1 = e0 + 16u * DM;
                    f32x4 r000, r001, r010, r011, r100, r101, r110, r111;
                    if (in32) {
                        r000 = *(const GAS f32x4*)(xin + e0); r001 = *(const GAS f32x4*)(xin + e0 + 4); r010 = *(const GAS f32x4*)(xin + e0 + 128); r011 = *(const GAS f32x4*)(xin + e0 + 132);
                        r100 = *(const GAS f32x4*)(xin + e1); r101 = *(const GAS f32x4*)(xin + e1 + 4); r110 = *(const GAS f32x4*)(xin + e1 + 128); r111 = *(const GAS f32x4*)(xin + e1 + 132);
                    } else {
                        const u32x4 b00 = *(const GAS u32x4*)(xb + e0), b01 = *(const GAS u32x4*)(xb + e0 + 128), b10 = *(const GAS u32x4*)(xb + e1), b11 = *(const GAS u32x4*)(xb + e1 + 128);
                        r000 = (f32x4){bf_lo(b00.x), bf_hi(b00.x), bf_lo(b00.y), bf_hi(b00.y)}; r001 = (f32x4){bf_lo(b00.z), bf_hi(b00.z), bf_lo(b00.w), bf_hi(b00.w)};
                        r010 = (f32x4){bf_lo(b01.x), bf_hi(b01.x), bf_lo(b01.y), bf_hi(b01.y)}; r011 = (f32x4){bf_lo(b01.z), bf_hi(b01.z), bf_lo(b01.w), bf_hi(b01.w)};
                        r100 = (f32x4){bf_lo(b10.x), bf_hi(b10.x), bf_lo(b10.y), bf_hi(b10.y)}; r101 = (f32x4){bf_lo(b10.z), bf_hi(b10.z), bf_lo(b10.w), bf_hi(b10.w)};
                        r110 = (f32x4){bf_lo(b11.x), bf_hi(b11.x), bf_lo(b11.y), bf_hi(b11.y)}; r111 = (f32x4){bf_lo(b11.z), bf_hi(b11.z), bf_lo(b11.w), bf_hi(b11.w)};
                    }
                    const f32x4 gm00 = *(const f32x4*)mp_, gm01 = *(const f32x4*)(mp_ + 4), gm10 = *(const f32x4*)(mp_ + 128), gm11 = *(const f32x4*)(mp_ + 132);
                    {   const int m = 2 * mp;
                        const f32x4 x00 = r000 + gt00 * acc[ai][0][m][0], x01 = r001 + gt01 * acc[ai][0][m][1], x10 = r010 + gt10 * acc[ai][1][m][0], x11 = r011 + gt11 * acc[ai][1][m][1];
                        if (!dry) { *(GAS u32x4*)(xb + e0) = pack8(x00, x01); *(GAS u32x4*)(xb + e0 + 128) = pack8(x10, x11); }
                        if (gmn && !dry) { *(u32x4*)(xg + e0) = pack8(x00 * gm00, x01 * gm01); *(u32x4*)(xg + e0 + 128) = pack8(x10 * gm10, x11 * gm11); }
                        float q = sq8(x00, x01) + sq8(x10, x11); q = fq_sum(q);
                        if (fq == 0 && !dry) stout[(size_t)(rowb + ai * 128 + m * 16) * 16 + u.pn * 4 + wc] = q; }
                    {   const int m = 2 * mp + 1;
                        const f32x4 x00 = r100 + gt00 * acc[ai][0][m][0], x01 = r101 + gt01 * acc[ai][0][m][1], x10 = r110 + gt10 * acc[ai][1][m][0], x11 = r111 + gt11 * acc[ai][1][m][1];
                        if (!dry) { *(GAS u32x4*)(xb + e1) = pack8(x00, x01); *(GAS u32x4*)(xb + e1 + 128) = pack8(x10, x11); }
                        if (gmn && !dry) { *(u32x4*)(xg + e1) = pack8(x00 * gm00, x01 * gm01); *(u32x4*)(xg + e1 + 128) = pack8(x10 * gm10, x11 * gm11); }
                        float q = sq8(x00, x01) + sq8(x10, x11); q = fq_sum(q);
                        if (fq == 0 && !dry) stout[(size_t)(rowb + ai * 128 + m * 16) * 16 + u.pn * 4 + wc] = q; }
                }
            }
        } break;
        case K_FF1: {
            const GAS float* shw = (const GAS float*)(ws + WS_SHW2) + (size_t)l * NSLOT * DFF; const int ldshw = DFF;
            f32x4 sw[2][2];
#pragma unroll
            for (int bj = 0; bj < 2; ++bj) { const float* p = shw + (size_t)s * ldshw + u.pn * 256 + bj * 128 + colw; sw[bj][0] = *(const f32x4*)p; sw[bj][1] = *(const f32x4*)(p + 4); }
            bf16_t* dst = (bf16_t*)(ws + SPLIT(isctx, HID));
#pragma unroll
            for (int ai = 0; ai < 2; ++ai)
#pragma unroll
                for (int m = 0; m < 4; ++m) {
                    asm volatile("" ::: "memory");
                    const int row = rowb + ai * 128 + m * 16;
                    const float rs = tab[rl0 + ai * 128 + m * 16];
#pragma unroll
                    for (int bj = 0; bj < 2; ++bj) {
                        f32x4 v0 = acc[ai][bj][m][0] * rs + sw[bj][0], v1 = acc[ai][bj][m][1] * rs + sw[bj][1];
#pragma unroll
                        for (int j = 0; j < 4; ++j) { const float a = fmaxf(v0[j], 0.f), b = fmaxf(v1[j], 0.f); v0[j] = a * a; v1[j] = b * b; }
                        *(u32x4*)(dst + (size_t)row * DFF + u.pn * 256 + bj * 128 + colw) = pack8(v0, v1);
                    }
                }
        } break;
        default: break;
        }
    }
};

struct GList { size_t aoff, boff; int K, nM, nN, pm0, kind, l, n0, q0, q1; };
#define GL_(ao, bo, K_, nM_, nN_, pm0_, kind_, l_, n0_, q0_, q1_) do { g.aoff = (ao); g.boff = (bo); g.K = (K_); g.nM = (nM_); g.nN = (nN_); g.pm0 = (pm0_); g.kind = (kind_); g.l = (l_); g.n0 = (n0_); g.q0 = (q0_); g.q1 = (q1_); return true; } while (0)
__device__ __forceinline__ bool slot_list(int sub, int j, int l, GList& g) {
    const size_t oWIN = WS_WIN + (size_t)l * INP * DM * 2, oWUQ = WS_WUQ + (size_t)l * QW * QRANK * 2, oWKVF = WS_WKVF + (size_t)l * KVW * KVRANK * 2, oWKVC = WS_WKVC + (size_t)l * KVW * KVRANK * 2;
    const size_t oWOUT = WS_WOUT + (size_t)l * DM * DM * 2, oWF1 = WS_WF1 + (size_t)l * DFF * DM * 2, oWF2 = WS_WF2 + (size_t)l * DM * DFF * 2;
    switch (sub) {
    case -1: if (j == 0) GL_(WS_XG, oWIN, DM, 16, 6, 0, -1, 0, 12, 1, 0); break;
    case 0:  if (j == 0) GL_(WS_XG, oWIN, DM, 64, 6, 16, -1, l, 16, -2, 1);
             if (j == 1) GL_(CQ_C, oWUQ, QRANK, 16, 3, 0, K_Q, l, 16, 0, 1);
             if (j == 2) GL_(CKVR_C, oWKVF, KVRANK, 16, 4, 0, K_KV, l, 22, 0, 1); break;
    case 1:  if (j == 0) GL_(CQ_L, oWUQ, QRANK, 64, 3, 16, K_Q, l, 24, 1, 0);
             if (j == 1) GL_(CKVR_L, oWKVF, KVRANK, 64, 4, 16, K_KV, l, 32, 1, 0);
             if (j == 2) GL_(WS_CCKV + (size_t)l * NLATB * PAST * KVRANK * 2, oWKVC, KVRANK, 8, 4, 0, K_KVC, l, 4, 1, 0); break;
    case 2:  if (j == 0) GL_(YCAT_C, oWOUT, DM, 16, 4, 0, K_OUT, l, 8, 1, 0); break;
    case 3:  if (j == 0) GL_(YCAT_L, oWOUT, DM, 64, 4, 16, K_OUT, l, 32, 1, 0);
             if (j == 1) GL_(WS_XG, oWF1, DM, 16, 16, 0, K_FF1, l, 32, 1, 0); break;
    case 4:  if (j == 0) GL_(HID_C, oWF2, DFF, 16, 4, 0, K_FF2, l, 8, 1, 0);
             if (j == 1) GL_(WS_XG, oWF1, DM, 64, 16, 16, K_FF1, l, 8, 1, -5); break;
    default: if (j == 0) GL_(HID_L, oWF2, DFF, 64, 4, 16, K_FF2, l, 32, 1, 0);
             if (j == 1 && l + 1 < DEPTH) GL_(WS_XG, oWIN + (size_t)INP * DM * 2, DM, 16, 6, 0, -1, l + 1, 12, 1, 0); break;
    }
    return false;
}
#undef GL_
struct SchedSlot {
    const GAS unsigned char* ws; int c, G, sub, l;
    __device__ __forceinline__ bool next(int i, GUnit& u) const {
        int k = i;
        const int x = c >> 5, li = c & 31;
#pragma unroll
        for (int j = 0; j < 3; ++j) {
            GList g; if (!slot_list(sub, (sub == 3 && (c & 1)) ? (j ^ 1) : j, l, g)) { if (sub == 3 && j < 2) continue; return false; }
            int pm, pn; bool hit = false;
            if (G == 256) {
                const int rM = g.nM >> 3, n = rM * g.nN;
                if (g.q0 < 0 || g.q1 < 0) {
                    const int qa0 = g.q0 < 0 ? -g.q0 : g.q0, qa1 = g.q1 < 0 ? -g.q1 : g.q1, t = li - g.n0, qe = li < g.n0 ? qa0 : qa1;
                    const int pnn = li < g.n0 ? (li / rM) * qa0 + k : (g.n0 / rM) * qa0 + (t / rM) * qa1 + k;
                    if (k < qe && pnn < g.nN) { pm = g.pm0 + rM * x + (li < g.n0 ? li % rM : t % rM); pn = pnn; hit = true; } else k -= qe;
                } else {
                const int q = li < g.n0 ? g.q0 : g.q1, start = li < g.n0 ? li * g.q0 : g.n0 * g.q0 + (li - g.n0) * g.q1;
                int qe = n - start; qe = qe < 0 ? 0 : (qe < q ? qe : q);
                if (k < qe) { const int lidx = start + k; pm = g.pm0 + rM * x + (lidx % rM); pn = lidx / rM; hit = true; } else k -= qe;
                }
            } else {
                const int n = g.nM * g.nN, q = (n + G - 1) / G, start = c * q;
                int qe = n - start; qe = qe < 0 ? 0 : (qe < q ? qe : q);
                if (k < qe) { const int idx = start + k; pm = g.pm0 + idx % g.nM; pn = idx / g.nM; hit = true; } else k -= qe;
            }
            if (hit) { u.A = (unsigned)(g.aoff + (size_t)pm * 256 * g.K * 2); u.B = (unsigned)(g.boff + (size_t)pn * 256 * g.K * 2); u.K = g.K; u.pm = pm; u.pn = pn; u.kind = g.kind < 0 ? pn : g.kind; u.l = g.l; return true; }
        }
        return false;
    }
};

#define KSWZ(row, colB) ((row) * 256 + ((colB) ^ (((row) & 15) << 4)))
#define KRSWZ(row, colB) ((row) * 128 + ((colB) ^ ((((row) >> 1) & 7) << 4)))
__device__ __forceinline__ int crow(int r, int hi) { return (r & 3) + 8 * (r >> 2) + 4 * hi; }
__device__ __forceinline__ int v_rd_base(int lane) { return ((lane & 3) << 3) | (((lane >> 2) & 3) << 6) | (((lane >> 4) & 1) << 5) | (((lane >> 5) & 1) << 8); }
constexpr int v_rd_off(int d0, int ks, int half) { return d0 * 512 + ks * 4096 + half * 2048; }
template <int OFF> __device__ __forceinline__ s16x4 tr_read(int vb) { s16x4 r; asm volatile("ds_read_b64_tr_b16 %0, %1 offset:%2" : "=&v"(r) : "v"(vb), "i"(OFF) : "memory"); return r; }
struct VFrag { s16x4 l0, h0, l1, h1, l2, h2, l3, h3; };
template <int D0> __device__ __forceinline__ void pv_read(VFrag& f, int vb) {
    f.l0 = tr_read<v_rd_off(D0, 0, 0)>(vb); f.h0 = tr_read<v_rd_off(D0, 0, 1)>(vb); f.l1 = tr_read<v_rd_off(D0, 1, 0)>(vb); f.h1 = tr_read<v_rd_off(D0, 1, 1)>(vb);
    f.l2 = tr_read<v_rd_off(D0, 2, 0)>(vb); f.h2 = tr_read<v_rd_off(D0, 2, 1)>(vb); f.l3 = tr_read<v_rd_off(D0, 3, 0)>(vb); f.h3 = tr_read<v_rd_off(D0, 3, 1)>(vb);
}
__device__ __forceinline__ void pv_wait(VFrag& f) {
    asm volatile("s_waitcnt lgkmcnt(0)" : "+v"(f.l0), "+v"(f.h0), "+v"(f.l1), "+v"(f.h1), "+v"(f.l2), "+v"(f.h2), "+v"(f.l3), "+v"(f.h3) :: "memory"); SBAR();
}
__device__ __forceinline__ void pv_mma(f32x16& od, const VFrag& f, bf16x8 pa0, bf16x8 pa1, bf16x8 pa2, bf16x8 pa3) {
#define PK(L, H) (bf16x8){L[0], L[1], L[2], L[3], H[0], H[1], H[2], H[3]}
    od = __builtin_amdgcn_mfma_f32_32x32x16_bf16(pa0, PK(f.l0, f.h0), od, 0, 0, 0);
    od = __builtin_amdgcn_mfma_f32_32x32x16_bf16(pa1, PK(f.l1, f.h1), od, 0, 0, 0);
    od = __builtin_amdgcn_mfma_f32_32x32x16_bf16(pa2, PK(f.l2, f.h2), od, 0, 0, 0);
    od = __builtin_amdgcn_mfma_f32_32x32x16_bf16(pa3, PK(f.l3, f.h3), od, 0, 0, 0);
#undef PK
}
constexpr int A_V = 0, A_KN = 32768, A_KR = 65536, A_WS = 81920, A_OST = 0;
constexpr float ATT_THR = 6.0f;
__device__ __forceinline__ void attn_unit(LAS unsigned char* ldsb, const GAS bf16_t* __restrict__ Qb, const GAS bf16_t* __restrict__ Kh, const GAS bf16_t* __restrict__ Vh, GAS bf16_t* __restrict__ Ob, int seq) {
    int tid_ = threadIdx.x; asm volatile("" : "+v"(tid_));
    const int tid = tid_, wid = __builtin_amdgcn_readfirstlane(tid >> 6), lane = tid & 63, r32 = lane & 31, hi = lane >> 5;
    char* lds = (char*)ldsb;
    char* Kn_lds = lds + A_KN; char* Kr_lds = lds + A_KR;
    float* wsf = (float*)(lds + A_WS) + wid * 64; float* li_l = wsf; float* al_l = wsf + 32;
    float m_reg = -1e30f, l_reg = 0.f; f32x16 o[4] = {}; bf16x8 qr[12];
    const GAS bf16_t* Qw = Qb + (size_t)(wid * 32 + r32) * QW + hi * 8;
#pragma unroll
    for (int d0 = 0; d0 < 12; ++d0) qr[d0] = *(const GAS bf16x8*)(Qw + d0 * 16);
#pragma unroll
    for (int d0 = 0; d0 < 12; ++d0) asm volatile("" : "+v"(qr[d0]));
    unsigned gk0, gk1, gkr, gv0, gv1;
    { int r = 4 * wid + (lane >> 4), c = (lane & 15) ^ (r & 15); gk0 = (unsigned)(r * 192 + c * 8);
      r = 4 * (wid + 8) + (lane >> 4); c = (lane & 15) ^ (r & 15); gk1 = (unsigned)(r * 192 + c * 8);
      r = 8 * wid + (lane >> 3); c = (lane & 7) ^ ((r >> 1) & 7); gkr = (unsigned)(r * 192 + 128 + c * 8);
      int p = wid, kk = (p >> 1) * 8 + ((lane & 31) >> 2), k = (kk & ~0xC) | ((kk & 4) << 1) | ((kk & 8) >> 1); gv0 = (unsigned)(k * 128 + (2 * (p & 1) + (lane >> 5)) * 32 + (lane & 3) * 8);
      p = wid + 8; kk = (p >> 1) * 8 + ((lane & 31) >> 2); k = (kk & ~0xC) | ((kk & 4) << 1) | ((kk & 8) >> 1); gv1 = (unsigned)(k * 128 + (2 * (p & 1) + (lane >> 5)) * 32 + (lane & 3) * 8); }
    const int vb0 = (int)(uintptr_t)(lds + A_V) + v_rd_base(lane);
#define ADMA(k0, b) do { const GAS bf16_t* kt = Kh + (size_t)(k0) * 192; const GAS bf16_t* vt = Vh + (size_t)(k0) * 128; \
        __builtin_amdgcn_global_load_lds((const GAS unsigned*)(kt + gk0), (LAS unsigned*)(ldsb + A_KN + (b) * 16384 + wid * 1024), 16, 0, 0); \
        __builtin_amdgcn_global_load_lds((const GAS unsigned*)(kt + gk1), (LAS unsigned*)(ldsb + A_KN + (b) * 16384 + (wid + 8) * 1024), 16, 0, 0); \
        __builtin_amdgcn_global_load_lds((const GAS unsigned*)(kt + gkr), (LAS unsigned*)(ldsb + A_KR + (b) * 8192 + wid * 1024), 16, 0, 0); \
        __builtin_amdgcn_global_load_lds((const GAS unsigned*)(vt + gv0), (LAS unsigned*)(ldsb + A_V + (b) * 16384 + wid * 1024), 16, 0, 0); \
        __builtin_amdgcn_global_load_lds((const GAS unsigned*)(vt + gv1), (LAS unsigned*)(ldsb + A_V + (b) * 16384 + (wid + 8) * 1024), 16, 0, 0); } while (0)
#define AWAITBAR() do { asm volatile("s_waitcnt vmcnt(0) lgkmcnt(0)" ::: "memory"); __builtin_amdgcn_s_barrier(); asm volatile("" ::: "memory"); } while (0)
    const int NT = seq / 64;
    ADMA(0, 0); AWAITBAR();
    for (int j = 0; j < NT; ++j) {
        const int cb = j & 1;
        if (j + 1 < NT) ADMA((j + 1) * 64, cb ^ 1);
        f32x16 p0 = {}, p1 = {};
        { const char* Kn = Kn_lds + cb * 16384; const char* Kr = Kr_lds + cb * 8192;
#define KFRAG(G, I, ROWOFF) ((G) < 4 ? *(const bf16x8*)(Kn + KSWZ((ROWOFF) + r32, ((2 * (G) + (I)) * 16 + hi * 8) * 2)) : *(const bf16x8*)(Kr + KRSWZ((ROWOFF) + r32, ((2 * ((G) - 4) + (I)) * 16 + hi * 8) * 2)))
#define KLOADG(G, X0, X1, Y0, Y1) do { X0 = KFRAG(G, 0, 0); Y0 = KFRAG(G, 0, 32); X1 = KFRAG(G, 1, 0); Y1 = KFRAG(G, 1, 32); } while (0)
#define KPIN(X0, X1, Y0, Y1) asm volatile("" : "+v"(X0), "+v"(Y0), "+v"(X1), "+v"(Y1))
#define KMMAG(G, X0, X1, Y0, Y1) do { \
              p0 = __builtin_amdgcn_mfma_f32_32x32x16_bf16(X0, qr[2 * (G)], p0, 0, 0, 0); p1 = __builtin_amdgcn_mfma_f32_32x32x16_bf16(Y0, qr[2 * (G)], p1, 0, 0, 0); \
              p0 = __builtin_amdgcn_mfma_f32_32x32x16_bf16(X1, qr[2 * (G) + 1], p0, 0, 0, 0); p1 = __builtin_amdgcn_mfma_f32_32x32x16_bf16(Y1, qr[2 * (G) + 1], p1, 0, 0, 0); } while (0)
          bf16x8 fa0, fa1, fb0, fb1, ga0, ga1, gb0, gb1;
          KLOADG(0, fa0, fa1, fb0, fb1); SBAR(); KPIN(fa0, fa1, fb0, fb1); SBAR();
          KLOADG(1, ga0, ga1, gb0, gb1); SBAR(); KMMAG(0, fa0, fa1, fb0, fb1); SBAR(); KPIN(ga0, ga1, gb0, gb1); SBAR();
          KLOADG(2, fa0, fa1, fb0, fb1); SBAR(); KMMAG(1, ga0, ga1, gb0, gb1); SBAR(); KPIN(fa0, fa1, fb0, fb1); SBAR();
          KLOADG(3, ga0, ga1, gb0, gb1); SBAR(); KMMAG(2, fa0, fa1, fb0, fb1); SBAR(); KPIN(ga0, ga1, gb0, gb1); SBAR();
          KLOADG(4, fa0, fa1, fb0, fb1); SBAR(); KMMAG(3, ga0, ga1, gb0, gb1); SBAR(); KPIN(fa0, fa1, fb0, fb1); SBAR();
          KLOADG(5, ga0, ga1, gb0, gb1); SBAR(); KMMAG(4, fa0, fa1, fb0, fb1); SBAR(); KPIN(ga0, ga1, gb0, gb1); SBAR();
          KMMAG(5, ga0, ga1, gb0, gb1); SBAR();
#undef KPIN
#undef KFRAG
#undef KLOADG
#undef KMMAG
        }
        float pmax = p0[0];
#pragma unroll
        for (int r = 1; r < 16; ++r) pmax = fmaxf(pmax, p0[r]);
#pragma unroll
        for (int r = 0; r < 16; ++r) pmax = fmaxf(pmax, p1[r]);
        { auto rr = __builtin_amdgcn_permlane32_swap(__float_as_uint(pmax), __float_as_uint(pmax), false, false); pmax = fmaxf(__uint_as_float(rr[0]), __uint_as_float(rr[1])); }
        float alpha = 1.f;
        if (!__all(pmax - m_reg <= ATT_THR)) { const float mn = fmaxf(m_reg, pmax); alpha = __builtin_amdgcn_exp2f(m_reg - mn); m_reg = mn; }
        float ps = 0.f;
#pragma unroll
        for (int r = 0; r < 16; ++r) { p0[r] = __builtin_amdgcn_exp2f(p0[r] - m_reg); p1[r] = __builtin_amdgcn_exp2f(p1[r] - m_reg); ps += p0[r] + p1[r]; }
        { auto rr = __builtin_amdgcn_permlane32_swap(__float_as_uint(ps), __float_as_uint(ps), false, false); ps = __uint_as_float(rr[0]) + __uint_as_float(rr[1]); }
        l_reg = l_reg * alpha + ps;
        bf16x8 pa0, pa1, pa2, pa3;
#define PK4(P, BASE, OUT) do { unsigned a0 = cvt_pk_bf16(P[BASE + 0], P[BASE + 1]), a1 = cvt_pk_bf16(P[BASE + 2], P[BASE + 3]);   \
        unsigned b0 = cvt_pk_bf16(P[BASE + 4], P[BASE + 5]), b1 = cvt_pk_bf16(P[BASE + 6], P[BASE + 7]);                              \
        auto r0 = __builtin_amdgcn_permlane32_swap(a0, b0, false, false); auto r1 = __builtin_amdgcn_permlane32_swap(a1, b1, false, false); \
        u32x4 w = {r0[0], r1[0], r0[1], r1[1]}; OUT = *reinterpret_cast<bf16x8*>(&w); } while (0)
        PK4(p0, 0, pa0); PK4(p0, 8, pa1); PK4(p1, 0, pa2); PK4(p1, 8, pa3);
#undef PK4
        if (__any(alpha < 1.f)) { if (hi == 0) al_l[r32] = alpha; LDS_WAIT();
#pragma unroll
            for (int d = 0; d < 4; ++d)
#pragma unroll
                for (int r = 0; r < 16; ++r) o[d][r] *= al_l[crow(r, hi)]; }
        { const int vb = vb0 + cb * 16384;
          VFrag va, vc;
          pv_read<0>(va, vb); pv_wait(va);
          pv_read<1>(vc, vb); SBAR(); pv_mma(o[0], va, pa0, pa1, pa2, pa3); SBAR(); pv_wait(vc);
          pv_read<2>(va, vb); SBAR(); pv_mma(o[1], vc, pa0, pa1, pa2, pa3); SBAR(); pv_wait(va);
          pv_read<3>(vc, vb); SBAR(); pv_mma(o[2], va, pa0, pa1, pa2, pa3); SBAR(); pv_wait(vc);
          pv_mma(o[3], vc, pa0, pa1, pa2, pa3); SBAR(); }
        AWAITBAR();
    }
#undef ADMA
#undef AWAITBAR
    if (hi == 0) li_l[r32] = l_reg; LDS_WAIT();
    float rli[16];
#pragma unroll
    for (int r = 0; r < 16; ++r) rli[r] = __builtin_amdgcn_rcpf(li_l[crow(r, hi)]);
    bf16_t* stg = (bf16_t*)(lds + A_OST) + wid * 4096;
#pragma unroll
    for (int r = 0; r < 16; ++r) { const int orow = crow(r, hi);
#pragma unroll
        for (int d0 = 0; d0 < 4; ++d0) stg[orow * 128 + d0 * 32 + r32] = f2bf(o[d0][r] * rli[r]); }
    LDS_WAIT();
#pragma unroll
    for (int i = 0; i < 8; ++i) { const int id = lane + 64 * i, row = id >> 4, ch = id & 15; const u32x4 v = *(const u32x4*)(stg + row * 128 + ch * 8); *(GAS u32x4*)(Ob + (size_t)(wid * 32 + row) * DM + ch * 8) = v; }
    LDS_WAIT();
    __syncthreads();
}

__device__ __forceinline__ void pool_unit(const Ctx& F, int l, int pm_, int g0_, int g1_) {
    const int pm = __builtin_amdgcn_readfirstlane(pm_), g0 = __builtin_amdgcn_readfirstlane(g0_), g1 = __builtin_amdgcn_readfirstlane(g1_);
    char* lds = (char*)F.lds;
    int tid_ = threadIdx.x; asm volatile("" : "+v"(tid_));
    const int tid = tid_, lane = tid & 63, wid = __builtin_amdgcn_readfirstlane(tid >> 6), fr = lane & 15, fq = lane >> 4;
    const bool isctx0 = pm < 16;
    const bf16_t* HP = wsp<const bf16_t>(F, SPLIT(isctx0, HP)); bf16_t* Y = wsp<bf16_t>(F, SPLIT(isctx0, YCAT));
    const bf16_t* WPT = wsp<const bf16_t>(F, WS_WPT) + (size_t)l * 4 * 4096;
    const float* pscale = GIN(11) + (size_t)l * 256;
    const int row0 = pm * 256; const bool isctx = pm < 16;
    const int L = isctx ? LCTX : LLAT, t0 = isctx ? 0 : ((pm - 16) & 7) * 256, seq0 = row0 - t0;
    bf16_t* hbuf = (bf16_t*)lds; bf16_t* abuf = (bf16_t*)(lds + 36864);
    for (int g_ = g0; g_ < g1; ++g_) {
        const int g = __builtin_amdgcn_readfirstlane(g_);
        const int w = 2 << g, hw = w >> 1;
        u32x4 hv[5];
#pragma unroll
        for (int i = 0; i < 5; ++i) { const int id = tid + 512 * i, rr = id >> 3, ch = id & 7, t = t0 - 8 + rr;
            hv[i] = (u32x4){0u, 0u, 0u, 0u}; if (id < 272 * 8 && t >= 0 && t < L) hv[i] = *(const u32x4*)(HP + (size_t)(seq0 + t) * 256 + g * 64 + ch * 8); }
        bf16x8 xa[2][4]; f32x4 psc[4];
#pragma unroll
        for (int ks = 0; ks < 2; ++ks)
#pragma unroll
            for (int nb = 0; nb < 4; ++nb) xa[ks][nb] = *(const bf16x8*)(WPT + (size_t)g * 4096 + (nb * 16 + fr) * 64 + ks * 32 + fq * 8);
#pragma unroll
        for (int nb = 0; nb < 4; ++nb) psc[nb] = *(const f32x4*)(pscale + g * 64 + nb * 16 + 4 * fq);
#pragma unroll
        for (int i = 0; i < 5; ++i) { const int id = tid + 512 * i, rr = id >> 3, ch = id & 7; if (id < 272 * 8) *(u32x4*)(hbuf + rr * 64 + ch * 8) = hv[i]; }
        __syncthreads();
#pragma unroll
        for (int it = 0; it < 4; ++it) { const int id = tid + 512 * it, tt = id >> 3, ch = id & 7, t = t0 + tt;
            const int lo = max(t - hw, 0), hiw = min(t + hw, L); float s[8] = {0, 0, 0, 0, 0, 0, 0, 0};
            for (int dq = -hw; dq < hw; ++dq) { const int q = t + dq; if (q >= lo && q < hiw) { const u32x4 v = *(const u32x4*)(hbuf + (tt + dq + 8) * 64 + ch * 8);
                s[0] += bf_lo(v.x); s[1] += bf_hi(v.x); s[2] += bf_lo(v.y); s[3] += bf_hi(v.y); s[4] += bf_lo(v.z); s[5] += bf_hi(v.z); s[6] += bf_lo(v.w); s[7] += bf_hi(v.w); } }
            const float ic = __builtin_amdgcn_rcpf((float)(hiw - lo)); const u32x4 c = *(const u32x4*)(hbuf + (tt + 8) * 64 + ch * 8);
            u32x4 o; o.x = cvt_pk_bf16(s[0] * ic - bf_lo(c.x), s[1] * ic - bf_hi(c.x)); o.y = cvt_pk_bf16(s[2] * ic - bf_lo(c.y), s[3] * ic - bf_hi(c.y));
            o.z = cvt_pk_bf16(s[4] * ic - bf_lo(c.z), s[5] * ic - bf_hi(c.z)); o.w = cvt_pk_bf16(s[6] * ic - bf_lo(c.w), s[7] * ic - bf_hi(c.w));
            *(u32x4*)(abuf + tt * 64 + ch * 8) = o; }
        __syncthreads();
        f32x4 acc[2][4];
#pragma unroll
        for (int mb = 0; mb < 2; ++mb)
#pragma unroll
            for (int nb = 0; nb < 4; ++nb) acc[mb][nb] = (f32x4){0.f, 0.f, 0.f, 0.f};
#pragma unroll
        for (int ks = 0; ks < 2; ++ks) {
            bf16x8 ya[2];
#pragma unroll
            for (int mb = 0; mb < 2; ++mb) ya[mb] = *(const bf16x8*)(abuf + (wid * 32 + mb * 16 + fr) * 64 + ks * 32 + fq * 8);
#pragma unroll
            for (int mb = 0; mb < 2; ++mb)
#pragma unroll
                for (int nb = 0; nb < 4; ++nb) acc[mb][nb] = __builtin_amdgcn_mfma_f32_16x16x32_bf16(xa[ks][nb], ya[mb], acc[mb][nb], 0, 0, 0);
        }
#pragma unroll
        for (int mb = 0; mb < 2; ++mb)
#pragma unroll
            for (int nb = 0; nb < 4; ++nb) { const int d = nb * 16 + 4 * fq; const f32x4 v = acc[mb][nb] * psc[nb];
                u32x2 o; o.x = cvt_pk_bf16(v[0], v[1]); o.y = cvt_pk_bf16(v[2], v[3]);
                *(u32x2*)(Y + (size_t)(row0 + wid * 32 + mb * 16 + fr) * DM + g * 64 + d) = o; }
        __syncthreads();
    }
}

__device__ __forceinline__ void gmlp_unit(const Ctx& F, int l, int chunk) {
    char* lds = (char*)F.lds;
    int tid_ = threadIdx.x; asm volatile("" : "+v"(tid_));
    const int tid = tid_, lane = tid & 63, wid = __builtin_amdgcn_readfirstlane(tid >> 6), fr = lane & 15, fq = lane >> 4;
    const bool isctx0 = chunk < 32;
    const bf16_t* GL = wsp<const bf16_t>(F, SPLIT(isctx0, GL)); const bf16_t* U = wsp<const bf16_t>(F, SPLIT(isctx0, U)); bf16_t* Y = wsp<bf16_t>(F, SPLIT(isctx0, YCAT));
    const float* STG = wsp<const float>(F, WS_STG);
    const bf16_t* WSB = wsp<const bf16_t>(F, WS_WSB) + (size_t)l * 4 * 16384;
    const float* gsgu = GIN(16) + (size_t)l * 256; const float* bs = GIN(18) + (size_t)l * 4 * 128;
    const int r0 = chunk * 128;
    float* rsg = (float*)lds; bf16_t* vT = (bf16_t*)(lds + 1024); constexpr int LDT = 136, VTG = 64 * LDT;
    u32x4 gv[4][2]; f32x4 g0v[4][2], g1v[4][2]; u32x2 uu[4][4]; float bp[4];
#pragma unroll
    for (int g = 0; g < 4; ++g)
#pragma unroll
        for (int i = 0; i < 2; ++i) { const int id = tid + 512 * i, q = id >> 3, cc = (id & 7) * 8;
            gv[g][i] = *(const u32x4*)(GL + (size_t)(r0 + q) * 256 + g * 64 + cc); g0v[g][i] = *(const f32x4*)(gsgu + g * 64 + cc); g1v[g][i] = *(const f32x4*)(gsgu + g * 64 + cc + 4); }
    const int p = wid * 16 + fr;
#pragma unroll
    for (int g = 0; g < 4; ++g) { bp[g] = bs[g * 128 + p];
#pragma unroll
        for (int nb = 0; nb < 4; ++nb) uu[g][nb] = *(const u32x2*)(U + (size_t)(r0 + p) * 256 + g * 64 + nb * 16 + 4 * fq); }
    if (tid < 128) { const f32x4 t = *(const f32x4*)(STG + (size_t)(r0 + tid) * 4); rsg[tid] = fast_rsqrt(sum4(t) * (1.0f / 256.0f) + EPS); }
    __syncthreads();
#pragma unroll
    for (int g = 0; g < 4; ++g)
#pragma unroll
        for (int i = 0; i < 2; ++i) { const int id = tid + 512 * i, q = id >> 3, cc = (id & 7) * 8; const float rs = rsg[q]; bf16_t* vt = vT + g * VTG; const u32x4 v = gv[g][i]; const f32x4 g0 = g0v[g][i], g1 = g1v[g][i];
            vt[(cc + 0) * LDT + q] = f2bf(bf_lo(v.x) * rs * g0[0]); vt[(cc + 1) * LDT + q] = f2bf(bf_hi(v.x) * rs * g0[1]);
            vt[(cc + 2) * LDT + q] = f2bf(bf_lo(v.y) * rs * g0[2]); vt[(cc + 3) * LDT + q] = f2bf(bf_hi(v.y) * rs * g0[3]);
            vt[(cc + 4) * LDT + q] = f2bf(bf_lo(v.z) * rs * g1[0]); vt[(cc + 5) * LDT + q] = f2bf(bf_hi(v.z) * rs * g1[1]);
            vt[(cc + 6) * LDT + q] = f2bf(bf_lo(v.w) * rs * g1[2]); vt[(cc + 7) * LDT + q] = f2bf(bf_hi(v.w) * rs * g1[3]); }
    __syncthreads();
#pragma unroll
    for (int g = 0; g < 4; ++g) {
        bf16x8 ya[4];
#pragma unroll
        for (int ks = 0; ks < 4; ++ks) ya[ks] = *(const bf16x8*)(WSB + (size_t)g * 16384 + (wid * 16 + fr) * 128 + ks * 32 + fq * 8);
        f32x4 acc[4];
#pragma unroll
        for (int nb = 0; nb < 4; ++nb) acc[nb] = (f32x4){0.f, 0.f, 0.f, 0.f};
#pragma unroll
        for (int ks = 0; ks < 4; ++ks)
#pragma unroll
            for (int nb = 0; nb < 4; ++nb) { const bf16x8 xa = *(const bf16x8*)(vT + g * VTG + (nb * 16 + fr) * LDT + ks * 32 + fq * 8);
                acc[nb] = __builtin_amdgcn_mfma_f32_16x16x32_bf16(xa, ya[ks], acc[nb], 0, 0, 0); }
#pragma unroll
        for (int nb = 0; nb < 4; ++nb) { const int c = nb * 16 + 4 * fq; const u32x2 u2 = uu[g][nb];
            u32x2 o; o.x = cvt_pk_bf16(bf_lo(u2.x) * (acc[nb][0] + bp[g]), bf_hi(u2.x) * (acc[nb][1] + bp[g])); o.y = cvt_pk_bf16(bf_lo(u2.y) * (acc[nb][2] + bp[g]), bf_hi(u2.y) * (acc[nb][3] + bp[g]));
            *(u32x2*)(Y + (size_t)(r0 + p) * DM + 768 + g * 64 + c) = o; }
    }
    __syncthreads();
}

enum MapKind { MAP_ID = 0, MAP_WIN = 1, MAP_WUQ = 2 };
__device__ __forceinline__ int colmap(int kind, int n) {
    if (kind == MAP_ID) return n;
    if (kind == MAP_WIN) {
        if (n < 256) return n;
        if (n < 512) return 640 + (n - 256);
        if (n < 768) return 960 + (n - 512);
        if (n < 1024) return 1216 + (n - 768);
        if (n < 1280) return 256 + (n - 1024);
        if (n < 1408) return 512 + (n - 1280);
        if (n < 1472) { const int p = n - 1408, i = p >> 1; return (p & 1) ? 896 + 32 + i : 896 + i; }
        return -1;
    }
    { const int hh = n / 192, w = n % 192; if (w < 128) return hh * 192 + w; const int p = w - 128, i = p >> 1; return hh * 192 + 128 + ((p & 1) ? 32 + i : i); }
}
template <bool WTHRU = false>
__device__ __forceinline__ void transpose_item(const float* W, int K, int Nsrc, int Ndst, bf16_t* WT, int mapk, const float* kscale, LAS float* scr, int item, int lane) {
    const int nblk = Ndst / 64, kb = item / nblk, nb = item % nblk, k0 = 64 * kb, n0 = 64 * nb;
    const int srcA = colmap(mapk, n0 + (lane & 31)), srcB = colmap(mapk, n0 + 32 + (lane & 31));
    float tvA[32], tvB[32];
    const int sa = srcA >= 0 ? srcA : 0, sb = srcB >= 0 ? srcB : 0;
#pragma unroll
    for (int i = 0; i < 32; ++i) { const int kk = 2 * i + (lane >> 5); const float* wr_ = W + (size_t)(k0 + kk) * Nsrc; tvA[i] = wr_[sa]; tvB[i] = wr_[sb]; }
    if (kscale) {
#pragma unroll
        for (int i = 0; i < 32; ++i) { const float ks = kscale[k0 + 2 * i + (lane >> 5)]; tvA[i] *= ks; tvB[i] *= ks; } }
    const int c = lane & 7;
#pragma unroll
    for (int h = 0; h < 2; ++h) {
#pragma unroll
        for (int i = 0; i < 32; ++i) { const int kk = 2 * i + (lane >> 5); scr[kk * 33 + (lane & 31)] = h == 0 ? (srcA >= 0 ? tvA[i] : 0.f) : (srcB >= 0 ? tvB[i] : 0.f); }
        LDS_WAIT(); asm volatile("" ::: "memory");
#pragma unroll
        for (int j = 0; j < 4; ++j) { const int n = (lane >> 3) + 8 * j; const LAS float* sp = scr + (8 * c) * 33 + n;
            u32x4 o; o.x = cvt_pk_bf16(sp[0 * 33], sp[1 * 33]); o.y = cvt_pk_bf16(sp[2 * 33], sp[3 * 33]); o.z = cvt_pk_bf16(sp[4 * 33], sp[5 * 33]); o.w = cvt_pk_bf16(sp[6 * 33], sp[7 * 33]);
            bf16_t* dp = WT + (size_t)(n0 + 32 * h + n) * K + k0 + 8 * c;
            if (WTHRU) asm volatile("global_store_dwordx4 %0, %1, off sc0 sc1" :: "v"((GAS u32x4*)dp), "v"(o) : "memory");
            else *(u32x4*)dp = o; }
        LDS_WAIT(); asm volatile("" ::: "memory");
    }
}
__device__ __forceinline__ float silu(float x) { return x / (1.0f + __expf(-x)); }

__device__ __forceinline__ void phase_p0a(const Ctx& F, int part = 0, int widx = 0, int nW = 1) {
    LAS float* scr = (LAS float*)(F.lds + F.wave * 16384);
    const int gw = F.vcu * 8 + F.wave, NGW = F.G * 8, lane = lane_now();
    constexpr int I_WIN = (DM / 64) * (INP / 64), I_WUQ = (QRANK / 64) * (QW / 64), I_WKV = (KVRANK / 64) * (KVW / 64), I_WOUT = (DM / 64) * (DM / 64), I_WF1 = (DM / 64) * (DFF / 64), I_WF2 = (DFF / 64) * (DM / 64), I_WP = 1;
    constexpr int PER_L = I_WIN + I_WUQ + 2 * I_WKV + I_WOUT + I_WF1 + I_WF2 + 4 * I_WP;
    constexpr int N_T = DEPTH * PER_L, N_MOD = 96 * 16, N_WS = (DEPTH * 4 * 128 * 128) / 512, N_CK = (DEPTH * NLATB * PAST * KVRANK) / 512, N_ROPE = 16;
    constexpr int NITEMS = N_MOD + N_T + N_WS + N_CK + N_ROPE;
    const bool spread = (F.G == 256);
    volatile LAS unsigned* MISCq = (volatile LAS unsigned*)(F.lds + MISC_OFF);
    if (tid_now() == 0) MISCq[40] = 0u;
    __syncthreads();
    constexpr int NB_L = I_WUQ + 2 * I_WKV + I_WOUT + 4 * I_WP, NB_G = I_WUQ + 2 * I_WKV + I_WOUT, NFF = I_WF1 + I_WF2, NFFL = DEFER_FF ? 1 : DEPTH;
    bool first = true;
    for (int it = gw; ; it += NGW) {
        int r;
        if (spread) {
            if (part == 0 && first && F.wave < 6) r = F.vcu * 6 + F.wave;
            else { unsigned j = 0u; if (lane == 0) j = __hip_atomic_fetch_add((LAS unsigned*)(F.lds + MISC_OFF) + 40, 1u, __ATOMIC_RELAXED, __HIP_MEMORY_SCOPE_WORKGROUP);
                   j = (unsigned)__builtin_amdgcn_readfirstlane((int)j);
                   int d = part == 0 ? F.vcu + (int)j * F.G : widx * 8 + ((int)j & 7) + ((int)j >> 3) * nW * 8; r = -1;
                   if (part == 0) { if (d < DEPTH * I_WIN) r = N_MOD + (d / I_WIN) * PER_L + d % I_WIN; else if (d < DEPTH * I_WIN + N_ROPE) r = NITEMS - N_ROPE + (d - DEPTH * I_WIN); }
                   else { if (d < NFFL * NB_L) { const int q = d % NB_L; r = N_MOD + (d / NB_L) * PER_L + I_WIN + (q < NB_G ? q : q + NFF); }
                          else if ((d -= NFFL * NB_L) < NFFL * NFF) r = N_MOD + (d / NFF) * PER_L + I_WIN + NB_G + d % NFF;
                          else if ((d -= NFFL * NFF) < N_WS + N_CK) r = N_MOD + N_T + d; }
                   if (r < 0) break; }
            first = false;
        } else { if (part != 0) break; r = it; if (r >= NITEMS) break; }
        if (r < N_MOD) {
            const int cg = r >> 4, kc = r & 15, n = cg * 256 + lane * 4, l = n / MODW, nn = n % MODW;
            { float cv[NSLOT]; const int k = kc * 64 + lane;
#pragma unroll
              for (int s = 0; s < NSLOT; ++s) cv[s] = (s == 0) ? GIN(5)[k] : GIN(4)[(size_t)(s - 1) * DM + k];
#pragma unroll
              for (int s = 0; s < NSLOT; ++s) scr[s * 64 + lane] = silu(cv[s]); }
            LDS_WAIT(); asm volatile("" ::: "memory");
            f32x4 a[NSLOT];
#pragma unroll
            for (int s = 0; s < NSLOT; ++s) a[s] = (f32x4){0.f, 0.f, 0.f, 0.f};
            const float* wp = GIN(6) + ((size_t)l * DM + kc * 64) * MODW + nn;
#pragma unroll 32
            for (int kk = 0; kk < 64; ++kk) { const f32x4 w = *(const f32x4*)(wp + (size_t)kk * MODW);
#pragma unroll
                for (int s = 0; s < NSLOT; ++s) a[s] += w * scr[s * 64 + kk]; }
            float* mp = wsp<float>(F, WS_MODP);
#pragma unroll
            for (int s = 0; s < NSLOT; ++s) *(f32x4*)(mp + ((size_t)(kc * NSLOT + s)) * (DEPTH * MODW) + n) = a[s];
            LDS_WAIT(); asm volatile("" ::: "memory");
            continue;
        }
        r -= N_MOD;
        if (r < N_T) {
            const int l = r / PER_L; int q = r % PER_L;
            if (q < I_WIN) { transpose_item(GIN(9) + (size_t)l * DM * INW, DM, INW, INP, wsp<bf16_t>(F, WS_WIN) + (size_t)l * INP * DM, MAP_WIN, nullptr, scr, q, lane); continue; } q -= I_WIN;
            if (q < I_WUQ) { transpose_item(GIN(13) + (size_t)l * QRANK * QW, QRANK, QW, QW, wsp<bf16_t>(F, WS_WUQ) + (size_t)l * QW * QRANK, MAP_WUQ, GIN(12) + (size_t)l * QRANK, scr, q, lane); continue; } q -= I_WUQ;
            if (q < I_WKV) { transpose_item(GIN(15) + (size_t)l * KVRANK * KVW, KVRANK, KVW, KVW, wsp<bf16_t>(F, WS_WKVF) + (size_t)l * KVW * KVRANK, MAP_ID, GIN(14) + (size_t)l * KVRANK, scr, q, lane); continue; } q -= I_WKV;
            if (q < I_WKV) { transpose_item(GIN(15) + (size_t)l * KVRANK * KVW, KVRANK, KVW, KVW, wsp<bf16_t>(F, WS_WKVC) + (size_t)l * KVW * KVRANK, MAP_ID, nullptr, scr, q, lane); continue; } q -= I_WKV;
            if (q < I_WOUT) { transpose_item(GIN(19) + (size_t)l * DM * DM, DM, DM, DM, wsp<bf16_t>(F, WS_WOUT) + (size_t)l * DM * DM, MAP_ID, nullptr, scr, q, lane); continue; } q -= I_WOUT;
            if (DEFER_FF && spread && l >= 1 && q < I_WF1 + I_WF2) continue;
            if (q < I_WF1) { transpose_item(GIN(21) + (size_t)l * DM * DFF, DM, DFF, DFF, wsp<bf16_t>(F, WS_WF1) + (size_t)l * DFF * DM, MAP_ID, nullptr, scr, q, lane); continue; } q -= I_WF1;
            if (q < I_WF2) { transpose_item(GIN(22) + (size_t)l * DFF * DM, DFF, DM, DM, wsp<bf16_t>(F, WS_WF2) + (size_t)l * DM * DFF, MAP_ID, nullptr, scr, q, lane); continue; } q -= I_WF2;
            { const int g = q / I_WP, it2 = q % I_WP; transpose_item(GIN(10) + ((size_t)l * 4 + g) * 4096, 64, 64, 64, wsp<bf16_t>(F, WS_WPT) + ((size_t)l * 4 + g) * 4096, MAP_ID, nullptr, scr, it2, lane); continue; }
        }
        r -= N_T;
        if (r < N_WS) {
            const float* src = GIN(17) + (size_t)r * 512 + lane * 8; const f32x4 a = *(const f32x4*)src, b = *(const f32x4*)(src + 4);
            *(u32x4*)(wsp<bf16_t>(F, WS_WSB) + (size_t)r * 512 + lane * 8) = pack8(a, b); continue;
        }
        r -= N_WS;
        if (r < N_CK) {
            const size_t e = (size_t)r * 512 + lane * 8; const int c = (int)(e % 256), j = (int)((e / 256) % 256), l = (int)((e / 65536) % 4), b = (int)(e / 262144);
            const float* src = GIN(2) + e; const f32x4 a = *(const f32x4*)src, bb = *(const f32x4*)(src + 4);
            *(u32x4*)(wsp<bf16_t>(F, WS_CCKV) + ((size_t)(l * NLATB + b) * PAST + j) * KVRANK + c) = pack8(a, bb); continue;
        }
        r -= N_CK;
        { const int id = r * 64 + lane, pos = id >> 4, j = id & 15;
          const double inv = (double)__builtin_amdgcn_exp2f(-(float)j * (13.287712379549449f / 16.0f));
          const double ang = (double)pos * inv, rev = ang * 0.15915494309189535;
          const float fr_ = (float)(rev - (double)(long long)rev);
          wsp<f32x2>(F, WS_ROPE)[id] = (f32x2){__builtin_amdgcn_cosf(fr_), __builtin_amdgcn_sinf(fr_)}; }
    }
}
__device__ __forceinline__ void ff_convert(const Ctx& F, int l) {
    constexpr int I_WF1 = (DM / 64) * (DFF / 64), I_WF2 = (DFF / 64) * (DM / 64);
    const int li = F.vcu & 31, x = F.vcu >> 5; if (li < 12) return;
    asm volatile("s_waitcnt vmcnt(0)" ::: "memory"); __syncthreads();
    LAS float* scr = (LAS float*)(F.lds + F.wave * 16384);
    const int gw = (x * 20 + (li - 12)) * 8 + F.wave, NGW = 160 * 8, lane = lane_now();
    constexpr int I_WUQ = (QRANK / 64) * (QW / 64), I_WKV = (KVRANK / 64) * (KVW / 64), I_WOUT = (DM / 64) * (DM / 64), I_WP = 1;
    constexpr int NREST = I_WUQ + 2 * I_WKV + I_WOUT + 4 * I_WP;
    for (int it = gw; it < I_WF1 + I_WF2 + NREST; it += NGW) {
        const float* W; const float* ks = nullptr; bf16_t* WT; int K, Nsrc, Ndst, mapk = MAP_ID, item;
        int q = it;
        if (q < I_WF1) { W = GIN(21) + (size_t)l * DM * DFF; K = DM; Nsrc = DFF; Ndst = DFF; WT = wsp<bf16_t>(F, WS_WF1) + (size_t)l * DFF * DM; item = q; }
        else if ((q -= I_WF1) < I_WF2) { W = GIN(22) + (size_t)l * DFF * DM; K = DFF; Nsrc = DM; Ndst = DM; WT = wsp<bf16_t>(F, WS_WF2) + (size_t)l * DM * DFF; item = q; }
        else if ((q -= I_WF2) < I_WUQ) { W = GIN(13) + (size_t)l * QRANK * QW; K = QRANK; Nsrc = QW; Ndst = QW; WT = wsp<bf16_t>(F, WS_WUQ) + (size_t)l * QW * QRANK; mapk = MAP_WUQ; ks = GIN(12) + (size_t)l * QRANK; item = q; }
        else if ((q -= I_WUQ) < I_WKV) { W = GIN(15) + (size_t)l * KVRANK * KVW; K = KVRANK; Nsrc = KVW; Ndst = KVW; WT = wsp<bf16_t>(F, WS_WKVF) + (size_t)l * KVW * KVRANK; ks = GIN(14) + (size_t)l * KVRANK; item = q; }
        else if ((q -= I_WKV) < I_WKV) { W = GIN(15) + (size_t)l * KVRANK * KVW; K = KVRANK; Nsrc = KVW; Ndst = KVW; WT = wsp<bf16_t>(F, WS_WKVC) + (size_t)l * KVW * KVRANK; item = q; }
        else if ((q -= I_WKV) < I_WOUT) { W = GIN(19) + (size_t)l * DM * DM; K = DM; Nsrc = DM; Ndst = DM; WT = wsp<bf16_t>(F, WS_WOUT) + (size_t)l * DM * DM; item = q; }
        else { q -= I_WOUT; const int g = q / I_WP; W = GIN(10) + ((size_t)l * 4 + g) * 4096; K = 64; Nsrc = 64; Ndst = 64; WT = wsp<bf16_t>(F, WS_WPT) + ((size_t)l * 4 + g) * 4096; item = q % I_WP; }
        transpose_item<true>(W, K, Nsrc, Ndst, WT, mapk, ks, scr, item, lane);
    }
}
__device__ __forceinline__ void phase_p0b(const Ctx& F) {
    const int gt = F.vcu * 512 + tid_now(), NT = F.G * 512;
    const float* mp = wsp<const float>(F, WS_MODP);
    for (int id = gt; id < DEPTH * NSLOT * MODW; id += NT) {
        const int nn = id % MODW, s = (id / MODW) % NSLOT, l = id / (MODW * NSLOT);
        float v = GIN(7)[(size_t)l * MODW + nn];
#pragma unroll
        for (int kc = 0; kc < 16; ++kc) v += mp[((size_t)(kc * NSLOT + s)) * (DEPTH * MODW) + (size_t)l * MODW + nn];
        const int part = nn >> 10, k = nn & 1023; const size_t o = ((size_t)l * NSLOT + s) * DM + k;
        if (part == 0) wsp<float>(F, WS_SH1)[o] = v;
        else if (part == 1) wsp<float>(F, WS_GM1)[o] = GIN(8)[(size_t)l * DM + k] * (1.0f + v);
        else if (part == 2) wsp<float>(F, WS_G1)[o] = v;
        else if (part == 3) wsp<float>(F, WS_SH2)[o] = v;
        else if (part == 4) wsp<float>(F, WS_GM2)[o] = GIN(20)[(size_t)l * DM + k] * (1.0f + v);
        else wsp<float>(F, WS_G2)[o] = v;
    }
}
template <bool WTHRU>
__device__ __forceinline__ void shw_item(const float* SH, const GAS bf16_t* WT, float* out, int ldo, int n0, int lane) {
    const int r16 = lane & 15, kg = lane >> 4; const bool live = r16 < NSLOT;
    f32x4 acc = (f32x4){0.f, 0.f, 0.f, 0.f};
    const GAS bf16_t* bp = WT + (size_t)(n0 + r16) * DM + kg * 8;
    const float* ap = SH + (size_t)(live ? r16 : 0) * DM + kg * 8;
    for (int k0 = 0; k0 < DM; k0 += 256) {
        u32x4 b[8]; f32x4 a0[8], a1[8];
#pragma unroll
        for (int j = 0; j < 8; ++j) { b[j] = *(const GAS u32x4*)(bp + k0 + 32 * j); a0[j] = *(const f32x4*)(ap + k0 + 32 * j); a1[j] = *(const f32x4*)(ap + k0 + 32 * j + 4); }
#pragma unroll
        for (int j = 0; j < 8; ++j) {
            u32x4 hi, lo;
            hi.x = cvt_pk_bf16(a0[j][0], a0[j][1]); hi.y = cvt_pk_bf16(a0[j][2], a0[j][3]); hi.z = cvt_pk_bf16(a1[j][0], a1[j][1]); hi.w = cvt_pk_bf16(a1[j][2], a1[j][3]);
            lo.x = cvt_pk_bf16(a0[j][0] - bf_lo(hi.x), a0[j][1] - bf_hi(hi.x)); lo.y = cvt_pk_bf16(a0[j][2] - bf_lo(hi.y), a0[j][3] - bf_hi(hi.y));
            lo.z = cvt_pk_bf16(a1[j][0] - bf_lo(hi.z), a1[j][1] - bf_hi(hi.z)); lo.w = cvt_pk_bf16(a1[j][2] - bf_lo(hi.w), a1[j][3] - bf_hi(hi.w));
            if (!live) { hi = (u32x4){0u, 0u, 0u, 0u}; lo = hi; }
            const bf16x8 bv = __builtin_bit_cast(bf16x8, b[j]);
            acc = __builtin_amdgcn_mfma_f32_16x16x32_bf16(__builtin_bit_cast(bf16x8, hi), bv, acc, 0, 0, 0);
            acc = __builtin_amdgcn_mfma_f32_16x16x32_bf16(__builtin_bit_cast(bf16x8, lo), bv, acc, 0, 0, 0);
        }
    }
#pragma unroll
    for (int r = 0; r < 4; ++r) { const int sr = 4 * kg + r;
        if (sr < NSLOT) { float* o = out + (size_t)sr * ldo + n0 + r16;
            if (WTHRU) __hip_atomic_store(o, acc[r], __ATOMIC_RELAXED, __HIP_MEMORY_SCOPE_AGENT); else *o = acc[r]; } }
}
__device__ __forceinline__ void shw2_deferred(const Ctx& F, int l) {
    const int li = F.vcu & 31, x = F.vcu >> 5; if (li < 4 || li >= 16) return;
    const int item = (x * 12 + (li - 4)) * 8 + F.wave;
    if (item < DFF / 16) shw_item<true>(wsp<const float>(F, WS_SH2) + (size_t)l * NSLOT * DM, wsp<const bf16_t>(F, WS_WF1) + (size_t)l * DFF * DM, wsp<float>(F, WS_SHW2) + (size_t)l * NSLOT * DFF, DFF, item * 16, lane_now());
}
__device__ __forceinline__ const float* xrow_in(const Ctx& F, int row) { return row < NCTX ? GIN(0) + (size_t)row * DM : GIN(1) + (size_t)(row - NCTX) * DM; }
__device__ __forceinline__ void xg_rows(const Ctx& F, int lo, int hi, int gw, int NGW) {
    const int lane = lane_now();
    const float* GM = wsp<const float>(F, WS_GM1);
    bf16_t* XG = wsp<bf16_t>(F, WS_XG); float* ST1 = wsp<float>(F, WS_ST1);
    constexpr int RB = 5;
    for (int row0 = lo + gw; row0 < hi; row0 += NGW * RB) {
        f32x4 v[RB][4];
#pragma unroll
        for (int i = 0; i < RB; ++i) { const int row = row0 + i * NGW; const f32x4* xr = (const f32x4*)xrow_in(F, row < hi ? row : row0) + lane;
            if (row < hi) {
#pragma unroll
                for (int j = 0; j < 4; ++j) v[i][j] = xr[64 * j]; } }
#pragma unroll
        for (int i = 0; i < RB; ++i) { const int row = row0 + i * NGW;
            if (row < hi) {
                const int s = slot_of_tile(row >> 8); const f32x4* gr = (const f32x4*)(GM + (size_t)s * DM) + lane;
                float q = 0.f;
#pragma unroll
                for (int j = 0; j < 4; ++j) { const f32x4 vv = v[i][j], g = gr[64 * j]; q += (vv[0] * vv[0] + vv[1] * vv[1]) + (vv[2] * vv[2] + vv[3] * vv[3]); const f32x4 y = vv * g;
                    u32x2 o; o.x = cvt_pk_bf16(y[0], y[1]); o.y = cvt_pk_bf16(y[2], y[3]); *(u32x2*)(XG + (size_t)row * DM + (64 * j + lane) * 4) = o; }
                q = wave_sum(q);
                if (lane < 16) ST1[(size_t)row * 16 + lane] = (lane == 0) ? q : 0.f;
            } }
    }
}
__device__ __forceinline__ void phase_p0c(const Ctx& F) {
    const int lane = lane_now(), wid = F.wave, tid = tid_now();
    {
        constexpr int I1 = INP / 16, I2 = DFF / 16;
        const bool defer = F.G == 256;
        const int n2 = defer ? 0 : DEPTH, total = DEPTH * I1 + n2 * I2;
        for (int it = F.vcu * 8 + wid; it < total; it += F.G * 8) {
            if (it < DEPTH * I1) { const int l = it / I1, c = it % I1;
                shw_item<false>(wsp<const float>(F, WS_SH1) + (size_t)l * NSLOT * DM, wsp<const bf16_t>(F, WS_WIN) + (size_t)l * INP * DM, wsp<float>(F, WS_SHW1) + (size_t)l * NSLOT * INP, INP, c * 16, lane); }
            else { const int q = it - DEPTH * I1, l = q / I2, c = q % I2;
                shw_item<false>(wsp<const float>(F, WS_SH2) + (size_t)l * NSLOT * DM, wsp<const bf16_t>(F, WS_WF1) + (size_t)l * DFF * DM, wsp<float>(F, WS_SHW2) + (size_t)l * NSLOT * DFF, DFF, c * 16, lane); }
        }
    }
    if (F.G == 256) { xg_rows(F, 0, NCTX, F.vcu * 8 + wid, F.G * 8); __syncthreads(); phase_p0a(F, 1, F.vcu, 256); }
    else xg_rows(F, 0, MROWS, F.vcu * 8 + wid, F.G * 8);
}
__device__ __forceinline__ void final_tile(const Ctx& F, int pm, int pn) {
    asm volatile("s_waitcnt vmcnt(0)" ::: "memory");
    __syncthreads();
    if (tid_now() == 0) {
        unsigned* bar = (unsigned*)((gu32*)(F.ws + WS_CTL) + CW_BAR); unsigned* cw = (unsigned*)((gu32*)(F.ws + WS_CTL) + CW_FIN + 32 * pm);
        __builtin_amdgcn_fence(__ATOMIC_RELEASE, "agent");
        asm volatile("s_waitcnt vmcnt(0)" ::: "memory");
        xb_add(cw, 1u);
        XB_SPIN(xb_ld(cw) < 4u, bar);
        __builtin_amdgcn_fence(__ATOMIC_ACQUIRE, "agent");
        asm volatile("s_waitcnt vmcnt(0)" ::: "memory");
    }
    __syncthreads();
    __builtin_amdgcn_fence(__ATOMIC_ACQUIRE, "workgroup");
    LAS float* S = (LAS float*)(F.lds + RING_BYTES + 2048);
    int t_ = tid_now(); asm volatile("" : "+v"(t_));
    if (t_ == 0) *(volatile LAS int*)(S + 256) = 0;
    if (t_ < 256) { const GAS f32x4* sp = (const GAS f32x4*)(wsp<const float>(F, WS_ST1) + (size_t)(pm * 256 + t_) * 16);
        S[t_] = fast_rsqrt(((sum4(sp[0]) + sum4(sp[1])) + (sum4(sp[2]) + sum4(sp[3]))) * (1.0f / DM) + EPS); }
    __syncthreads();
    const int c16 = t_ & 31, r0 = t_ >> 5;
    const GAS float* gf = GIN(23) + pn * 256 + c16 * 8; const f32x4 g0 = *(const GAS f32x4*)gf, g1 = *(const GAS f32x4*)(gf + 4);
    const GAS bf16_t* xb = wsp<const bf16_t>(F, WS_XB) + (size_t)(pm * 256 + r0) * DM + pn * 256 + c16 * 8;
    GAS float* y = F.out + OUT_X + (size_t)(pm * 256 + r0) * DM + pn * 256 + c16 * 8;
    u32x4 b[16];
#pragma unroll
    for (int p = 0; p < 16; ++p) b[p] = *(const GAS u32x4*)(xb + (size_t)p * 16 * DM);
#pragma unroll
    for (int p = 0; p < 16; ++p) { const float rs = S[p * 16 + r0]; GAS float* yr = y + (size_t)p * 16 * DM; const u32x4 v = b[p];
        *(GAS f32x4*)yr = (f32x4){bf_lo(v.x), bf_hi(v.x), bf_lo(v.y), bf_hi(v.y)} * rs * g0; *(GAS f32x4*)(yr + 4) = (f32x4){bf_lo(v.z), bf_hi(v.z), bf_lo(v.w), bf_hi(v.w)} * rs * g1; }
}
__device__ __forceinline__ void phase_final(const Ctx& F) {
    const int gw = F.vcu * 8 + F.wave, NGW = F.G * 8, lane = lane_now();
    const float* ST1 = wsp<const float>(F, WS_ST1); const f32x4* gf = (const f32x4*)GIN(23) + lane;
    const GAS bf16_t* XB = wsp<const bf16_t>(F, WS_XB);
    for (int row = gw; row < MROWS; row += NGW) {
        const f32x4* sp = (const f32x4*)(ST1 + (size_t)row * 16);
        const float rs = fast_rsqrt(((sum4(sp[0]) + sum4(sp[1])) + (sum4(sp[2]) + sum4(sp[3]))) * (1.0f / DM) + EPS);
        const GAS u32x2* xr = (const GAS u32x2*)(XB + (size_t)row * DM) + lane;
        f32x4* yr = (f32x4*)(F.out + OUT_X + (size_t)row * DM) + lane;
#pragma unroll
        for (int j = 0; j < 4; ++j) { const u32x2 b = xr[64 * j]; const f32x4 v = (f32x4){bf_lo(b.x), bf_hi(b.x), bf_lo(b.y), bf_hi(b.y)}; yr[64 * j] = v * rs * gf[64 * j]; }
    }
}

#ifdef DIS_ATTN
#define ATTN_CALL(...) do {} while (0)
#else
#define ATTN_CALL(...) attn_unit(__VA_ARGS__)
#endif
#ifdef DIS_POOL
#define POOL_CALL(...) do {} while (0)
#else
#define POOL_CALL(...) pool_unit(__VA_ARGS__)
#endif
#ifdef DIS_GMLP
#define GMLP_CALL(...) do {} while (0)
#else
#define GMLP_CALL(...) gmlp_unit(__VA_ARGS__)
#endif
__device__ __forceinline__ void mix_fix(const Ctx& F, int l, int L, bool dry) {
    if (dry) return;
    const float* STKV = wsp<const float>(F, WS_STKV); const float* gkv = GIN(14) + (size_t)l * KVRANK;
    float* o = F.out + OUT_CKV + ((size_t)(L * DEPTH + l) * LCTX) * KVRANK;
    int tid0_ = threadIdx.x; asm volatile("" : "+v"(tid0_));
    const int c4 = (tid0_ & 63) * 4; const f32x4 g = *(const f32x4*)(gkv + c4);
    for (int t0 = tid0_ >> 6; t0 < LCTX; t0 += 64) {
        f32x4 st[8], v[8];
#pragma unroll
        for (int k = 0; k < 8; ++k) { const int t = t0 + 8 * k; st[k] = *(const f32x4*)(STKV + (size_t)(L * LCTX + t) * 4); v[k] = *(const f32x4*)(o + (size_t)t * KVRANK + c4); }
#pragma unroll
        for (int k = 0; k < 8; ++k) { const int t = t0 + 8 * k; const float rs = fast_rsqrt(sum4(st[k]) * (1.0f / KVRANK) + EPS); *(f32x4*)(o + (size_t)t * KVRANK + c4) = v[k] * rs * g; }
    }
}
__device__ __forceinline__ void mix_attn_ctx(const Ctx& F, int b, int h) {
    const GAS bf16_t* Q = wsp<const bf16_t>(F, Q_C); GAS bf16_t* Y = wsp<bf16_t>(F, YCAT_C);
    const int L = b * 4 + h; const size_t row0 = (size_t)b * LCTX;
    ATTN_CALL(F.lds, Q + row0 * QW + h * 192, wsp<const bf16_t>(F, WS_KC) + (size_t)L * LCTX * 192, wsp<const bf16_t>(F, WS_VC) + (size_t)L * LCTX * 128, Y + row0 * DM + 256 + h * 128, LCTX);
}
__device__ __forceinline__ void mix_ctx(const Ctx& F, int l, bool dry) {
    if (F.G == 256) { int vc_ = F.vcu; asm volatile("" : "+s"(vc_)); const int x = vc_ >> 5, li = vc_ & 31;
        if (li >= 16 && li < 24) { const int m = li - 16; mix_attn_ctx(F, 2 * x + (m >> 2), m & 3); }
        else if (li >= 24 && li < 28) { const int m = li - 24; POOL_CALL(F, l, 2 * x, m, m + 1); GMLP_CALL(F, l, 4 * x + m); }
        else if (li >= 28) { const int m = li - 28; POOL_CALL(F, l, 2 * x + 1, m, m + 1); if (m < 2) mix_fix(F, l, 2 * x + m, dry); }
    } else for (int j = F.vcu; j < 128; j += F.G) { const int x = j >> 4, m = j & 15;
        if (m < 2) POOL_CALL(F, l, 2 * x + m, 0, 4); else if (m < 10) mix_attn_ctx(F, 2 * x + ((m - 2) >> 2), (m - 2) & 3); else if (m < 14) GMLP_CALL(F, l, 4 * x + (m - 10)); else mix_fix(F, l, 2 * x + (m - 14), dry); }
}
__device__ __forceinline__ void mix_lat_attn(const Ctx& F) {
    const GAS bf16_t* Q = wsp<const bf16_t>(F, Q_L); GAS bf16_t* Y = wsp<bf16_t>(F, YCAT_L);
    for (int L = F.vcu; L < 256; L += F.G) {
        const int bh = L >> 3, qb = L & 7, b = bh >> 2, h = bh & 3; const size_t row0 = (size_t)NCTX + (size_t)b * LLAT + qb * 256;
        ATTN_CALL(F.lds, Q + row0 * QW + h * 192, wsp<const bf16_t>(F, WS_KL) + (size_t)bh * LKEY * 192, wsp<const bf16_t>(F, WS_VL) + (size_t)bh * LKEY * 128, Y + row0 * DM + 256 + h * 128, LKEY);
    }
}
__device__ __forceinline__ void mix_lat_small(const Ctx& F, int l) {
    if (F.G == 256) { int vc_ = F.vcu; asm volatile("" : "+s"(vc_)); const int x = vc_ >> 5, li = vc_ & 31;
        if (li >= 8 && li < 24) { const int m = li - 8; POOL_CALL(F, l, 16 + 8 * x + (m >> 1), 2 * (m & 1), 2 * (m & 1) + 2); }
        else if (li >= 24) { const int m = li - 24; GMLP_CALL(F, l, 32 + 16 * x + 2 * m); GMLP_CALL(F, l, 32 + 16 * x + 2 * m + 1); } }
    else for (int j = F.vcu; j < 192; j += F.G) { if (j < 64) POOL_CALL(F, l, 16 + j, 0, 4); else GMLP_CALL(F, l, 32 + (j - 64)); }
}

#ifdef DIS_GEMM
#define GEMM_CALL(a, b, c) do { (void)(b); (void)(c); } while (0)
#else
#define GEMM_CALL(a, b, c) gemm_phase(a, b, c)
#endif
constexpr int SL_P0A = 0, SL_P0B = 1, SL_P0C = 2, SL_PRE = 3, SL_L0 = 4, SL_PER_L = 6, SL_FINAL = SL_L0 + DEPTH * SL_PER_L, N_PHASES = SL_FINAL + 1;

__global__ void __launch_bounds__(512, 2) mega_fwd(const Args args) {
    extern __shared__ __attribute__((aligned(16))) unsigned char lds_raw[];
    Ctx F;
    F.a = &args; F.out = (GAS float*)args.out; F.ws = (GAS unsigned char*)args.ws; F.lds = (LAS unsigned char*)lds_raw;
    F.tid = threadIdx.x; F.lane = F.tid & 63; F.wave = __builtin_amdgcn_readfirstlane(F.tid >> 6);
    F.G = gridDim.x; { const int bx = blockIdx.x; F.vcu = (F.G % 8 == 0) ? (bx % 8) * (F.G / 8) + bx / 8 : bx; }
    volatile LAS unsigned* MISC = (volatile LAS unsigned*)(F.lds + MISC_OFF);
    for (int u = tid_now(); u < (LDS_BYTES - RING_BYTES) / 4; u += 512) ((LAS unsigned*)(F.lds + RING_BYTES))[u] = 0u;
    __syncthreads();
    gu32* ctl = (gu32*)(F.ws + WS_CTL);
    XcdBarrier bar; bar.bar = (unsigned*)(ctl + CW_BAR); bar.x = 0; bar.st = nullptr;
#if !MK_PER_PHASE
    bar = xcd_barrier_post((unsigned*)(ctl + CW_BAR), MISC + 8);
    if (threadIdx.x == 0) __hip_atomic_store(ctl + CW_XCC + F.vcu, xb_xcc_id() + 1u, RLX_AGENT);
#endif
    const int lo = args.ph_lo, hi = (FUSE_FINAL && F.G == 256 && args.ph_hi == N_PHASES) ? (int)SL_FINAL : args.ph_hi;
    for (int ph = lo; ph < hi; ++ph) {
      int reps = 1;
      if (PROBE_PHASE >= 0) { const int key = ph == SL_P0A ? 10 : ph == SL_P0B ? 11 : ph == SL_P0C ? 12 : ph == SL_FINAL ? 13 : ph == SL_PRE ? 9 : (ph - SL_L0) % SL_PER_L; if (key == PROBE_PHASE) reps += PROBE_REP; }
      for (int rep = 0; rep < reps; ++rep) {
        const bool dry = rep > 0;
        if (PROBE_PHASE == 13 && dry) break;
#if PROBE_FLUSH && !MK_PER_PHASE
        if (dry) {
            GAS u32x4* z = (GAS u32x4*)(F.ws + WS_OVL); const size_t n16 = (size_t)180 * 1024 * 1024 / 16;
            for (size_t i = (size_t)F.vcu * 512 + threadIdx.x; i < n16; i += (size_t)F.G * 512) z[i] = (u32x4){0u, 0u, 0u, 0u};
            GAS u32x4* z2 = (GAS u32x4*)(F.out); const size_t m16 = (size_t)100 * 1024 * 1024 / 16;
            for (size_t i = (size_t)F.vcu * 512 + threadIdx.x; i < m16; i += (size_t)F.G * 512) z2[i] = (u32x4){0u, 0u, 0u, 0u};
            xcd_barrier(bar);
        }
#endif
        { int t_ = threadIdx.x; asm volatile("" : "+v"(t_)); F.tid = t_; F.lane = t_ & 63; F.wave = __builtin_amdgcn_readfirstlane(t_ >> 6);
          unsigned char* w_ = args.ws; asm volatile("" : "+s"(w_)); F.ws = (GAS unsigned char*)w_; float* o_ = args.out; asm volatile("" : "+s"(o_)); F.out = (GAS float*)o_; }
#ifndef DIS_P0
        if (ph == SL_P0A) phase_p0a(F);
        else if (ph == SL_P0B) { phase_p0b(F);
            { int t_ = threadIdx.x; asm volatile("" : "+v"(t_)); const GAS u32x4* src = (const GAS u32x4*)(F.ws + WS_ROPE); LAS u32x4* dl = (LAS u32x4*)(F.lds + RING_BYTES + 4096); dl[t_] = src[t_]; } }
        else if (ph == SL_P0C) phase_p0c(F);
        else if (ph == SL_FINAL) phase_final(F);
#else
        if (ph < SL_PRE || ph == SL_FINAL) {}
#endif
        else {
            Epi E; E.ws = F.ws; E.out = F.out; E.xp = GIN(0); E.xs = GIN(1); E.dry = dry;
            const int l = ph == SL_PRE ? 0 : (ph - SL_L0) / SL_PER_L, sub = ph == SL_PRE ? -1 : (ph - SL_L0) % SL_PER_L;
            if (sub == 1) {
                const GAS float* ck = GIN(3); GAS bf16_t* KL = wsp<bf16_t>(F, WS_KL);
                const bool loc = (F.G == 256);
                for (int id0 = loc ? (F.vcu & 31) * 512 + tid_now() : F.vcu * 512 + tid_now(); id0 < (loc ? PAST * 8 : NLATB * PAST * 8); id0 += (loc ? 32 : F.G) * 512) {
                    const int id = loc ? ((F.vcu >> 5) << 11) + id0 : id0;
                    const int ch = id & 7, j = (id >> 3) & 255, b = id >> 11, i0 = ch * 4;
                    const GAS float* src = ck + ((size_t)(b * DEPTH + l) * PAST + j) * 64;
                    const f32x4 a = *(const GAS f32x4*)(src + i0), c = *(const GAS f32x4*)(src + 32 + i0);
                    u32x4 w; w.x = cvt_pk_bf16(a[0], c[0]); w.y = cvt_pk_bf16(a[1], c[1]); w.z = cvt_pk_bf16(a[2], c[2]); w.w = cvt_pk_bf16(a[3], c[3]);
                    GAS bf16_t* kd = KL + ((size_t)(b * NH) * LKEY + j) * 192 + 128 + ch * 8;
#pragma unroll
                    for (int h = 0; h < NH; ++h) *(GAS u32x4*)(kd + (size_t)h * LKEY * 192) = w;
                }
            }
            if (sub == 2) { mix_lat_attn(F); if (PROBE_PHASE == 21) for (int r2 = 0; r2 < PROBE_REP; ++r2) mix_lat_attn(F); }
            { SchedSlot S; S.ws = F.ws; S.c = F.vcu; S.G = F.G; S.sub = sub; S.l = l; GEMM_CALL(F.lds, S, E); }
            if (DEFER_FF && sub == 5 && F.G == 256 && l + 1 < DEPTH && !dry) ff_convert(F, l + 1);
            if (FUSE_FINAL && F.G == 256 && l == DEPTH - 1 && sub >= 4 && !dry) {
                SchedSlot S; S.ws = F.ws; S.c = F.vcu; S.G = F.G; S.sub = sub; S.l = l; GUnit u0;
                if (S.next(0, u0) && u0.kind == K_FF2) final_tile(F, u0.pm, u0.pn);
            }
            if (sub == -1 && F.G == 256 && !dry && (F.vcu & 31) >= 12) { asm volatile("s_waitcnt vmcnt(0)" ::: "memory"); __syncthreads(); xg_rows(F, NCTX, MROWS, ((F.vcu >> 5) * 20 + (F.vcu & 31) - 12) * 8 + F.wave, 160 * 8); }
            if (sub == 1) mix_ctx(F, l, dry);
            if (sub == 1 && F.G == 256 && !dry) shw2_deferred(F, l);
            if (sub == 2) mix_lat_small(F, l);
        }
#if !MK_PER_PHASE
        if (threadIdx.x == 0) MISC[11] = (LOCAL_BAR && MISC[20] != 0u && ph >= SL_L0 && ph < SL_FINAL && ((ph - SL_L0) % SL_PER_L <= 1 || (ph - SL_L0) % SL_PER_L == 3)) ? 1u : 0u;
        if (threadIdx.x == 0) MISC[10] = (MISC[20] != 0u && ph >= SL_L0 && ph + 1 < SL_FINAL) ? 1u : 0u;
        if (ph + 1 < hi || rep + 1 < reps) xcd_barrier(bar);
        if (ph == SL_P0A && rep == 0) {
            int bad = 0; int tq_ = threadIdx.x; asm volatile("" : "+v"(tq_));
            if (F.G != 256) bad = 1;
            else if (tq_ < 256) { gu32* cc = (gu32*)(F.ws + WS_CTL); const unsigned v = __hip_atomic_load(cc + CW_XCC + tq_, RLX_AGENT), h = __hip_atomic_load(cc + CW_XCC + (tq_ & ~31), RLX_AGENT); bad = (v == 0u || v != h); }
            const bool wbad = __ballot(bad) != 0ull;
            if ((tq_ & 63) == 0) MISC[24 + (tq_ >> 6)] = wbad ? 1u : 0u;
            __syncthreads();
            if (tq_ == 0) { unsigned a = 0u;
#pragma unroll
                for (int w8 = 0; w8 < 8; ++w8) a |= MISC[24 + w8];
                MISC[20] = a ? 0u : 1u; }
            __syncthreads();
        }
        if (PROBE_PHASE == 20 && ph >= SL_L0 && ph < SL_FINAL) { for (int r2 = 0; r2 < PROBE_REP; ++r2) xcd_barrier(bar); }
#endif
      }
    }
}

extern "C" void kernel_launch(void* const* d_in, const int* in_sizes, int n_in, void* d_out, int out_size, void* d_ws, size_t ws_size, hipStream_t stream) {
    static int grid = 0;
    if (grid == 0) {
        if (n_in != 24 || out_size != (int)OUT_END || ws_size < WS_END) { fprintf(stderr, "kernel_launch: unexpected shapes: n_in %d out %d ws %zu (need %zu)\n", n_in, out_size, ws_size, (size_t)WS_END); grid = -1; return; }
        int dev = 0, cus = 0, per_cu = 0;
        if (hipGetDevice(&dev) != hipSuccess || hipDeviceGetAttribute(&cus, hipDeviceAttributeMultiprocessorCount, dev) != hipSuccess) { grid = -1; return; }
        if (hipFuncSetAttribute((const void*)mega_fwd, hipFuncAttributeMaxDynamicSharedMemorySize, LDS_BYTES) != hipSuccess) { fprintf(stderr, "kernel_launch: hipFuncSetAttribute failed\n"); grid = -1; return; }
        if (hipOccupancyMaxActiveBlocksPerMultiprocessor(&per_cu, (const void*)mega_fwd, 512, LDS_BYTES) != hipSuccess || per_cu < 1) { fprintf(stderr, "kernel_launch: occupancy query says %d\n", per_cu); per_cu = 1; }
        (void)hipGetLastError();
        grid = cus;
    }
    if (grid < 0) return;
    (void)hipMemsetAsync((char*)d_ws + WS_CTL, 0, CTL_ZERO_BYTES, stream);
    Args a{};
    for (int i = 0; i < 24; ++i) a.in[i] = (const float*)d_in[i];
    a.out = (float*)d_out; a.ws = (unsigned char*)d_ws;
#if MK_PER_PHASE
    for (int ph = 0; ph < N_PHASES; ++ph) { a.ph_lo = ph; a.ph_hi = ph + 1; hipLaunchKernelGGL(mega_fwd, dim3(grid), dim3(512), LDS_BYTES, stream, a); }
#else
    a.ph_lo = 0; a.ph_hi = N_PHASES; hipLaunchKernelGGL(mega_fwd, dim3(grid), dim3(512), LDS_BYTES, stream, a);
#endif
    const hipError_t le = hipPeekAtLastError();
    if (le != hipSuccess) fprintf(stderr, "kernel_launch: launch failed: %s\n", hipGetErrorName(le));
}
```
